# Optimizing an MI355X kernel written in HIP

```python
import math, functools
import jax, jax.numpy as jnp
from jax import lax
import numpy as np

D_MODEL = 1024
BATCH = 8
SEQ = 4096
DEPTH = 1

CTX_LEN = 256
GRID_W = 64
D_MIX = 2 * D_MODEL
HG_WIDTH = D_MODEL // 1
HG_HEADS = 8
HG_F = 128
HG_V = HG_WIDTH // HG_HEADS
HG_F_WIDTH = HG_HEADS * HG_F
HG_CHUNK = 64
SSD_WIDTH = D_MIX - HG_WIDTH
SSD_HEADDIM = 64
SSD_HEADS = SSD_WIDTH // SSD_HEADDIM
SSD_GROUPS = 4
SSD_HPG = SSD_HEADS // SSD_GROUPS
SSD_STATE = 128
SSD_CONV = 5
SSD_CHUNK = 128
SSD_CONV_CH = SSD_WIDTH + 2 * SSD_GROUPS * SSD_STATE
D_FF = ((8 * D_MODEL // 3 + 255) // 256) * 256
N_MOD = 6
EPS = 1e-6
IN_SPLITS = (HG_F_WIDTH, 2 * HG_F_WIDTH, HG_WIDTH, HG_WIDTH,
             SSD_WIDTH, SSD_CONV_CH, 2 * SSD_HEADS)
D_IN = sum(IN_SPLITS)

kernel_name = "hgrn2_ssd_parallel_heads_dit_layer"


def split_cols(p, sizes):
    idx = np.cumsum(sizes)[:-1].tolist()
    return jnp.split(p, idx, axis=-1)


def rms_norm(x, w):
    xf = x.astype(jnp.float32)
    y = xf * lax.rsqrt(jnp.mean(xf * xf, axis=-1, keepdims=True) + EPS)
    return (y * w.astype(jnp.float32)).astype(x.dtype)


def modulate(u, shift, scale):
    return u * (1.0 + scale) + shift


def swiglu(u, w_gate, w_up, w_down):
    return (jax.nn.silu(u @ w_gate) * (u @ w_up)) @ w_down


def centred_dwconv(u, w, b):
    pad = SSD_CONV // 2
    length = u.shape[-2]
    up = jnp.pad(u, [(0, 0)] * (u.ndim - 2) + [(pad, pad), (0, 0)])
    return sum(w[k] * up[..., k:k + length, :] for k in range(SSD_CONV)) + b


def lower_tri(n):
    return jnp.tril(jnp.ones((n, n), dtype=bool))


def gla_chunk_scan(q, k, v, log_f, s0):
    bsz, length, heads = q.shape[:3]
    nc = length // HG_CHUNK
    q, k, v, log_f = (t.reshape(bsz, nc, HG_CHUNK, heads, t.shape[-1]) for t in (q, k, v, log_f))
    cum = jnp.cumsum(log_f, axis=2)
    q_dec = q * jnp.exp(cum)
    k_inv = k * jnp.exp(-cum)
    scores = jnp.where(lower_tri(HG_CHUNK), jnp.einsum('bcihf,bcjhf->bchij', q_dec, k_inv), 0.0)
    o_intra = jnp.einsum('bchij,bcjhv->bcihv', scores, v)
    k_end = k * jnp.exp(cum[:, :, -1:] - cum)
    chunk_states = jnp.einsum('bcjhf,bcjhv->bchfv', k_end, v)
    chunk_decay = jnp.exp(cum[:, :, -1]).astype(chunk_states.dtype)

    def step(s, inp):
        dec, ds = inp
        return (dec[..., None] * s + ds).astype(ds.dtype), s

    s_final, s_prev = lax.scan(step, s0.astype(chunk_states.dtype),
                               (jnp.moveaxis(chunk_decay, 1, 0), jnp.moveaxis(chunk_states, 1, 0)))
    s_prev = jnp.moveaxis(s_prev, 0, 1)
    o = o_intra + jnp.einsum('bcihf,bchfv->bcihv', q_dec, s_prev)
    return o.reshape(bsz, length, heads, -1), s_final


def ssd_chunk_scan(x, dt, bm, cm, s0, a):
    bsz, length = x.shape[:2]
    nc = length // SSD_CHUNK
    x, dt, bm, cm = (t.reshape((bsz, nc, SSD_CHUNK) + t.shape[2:]) for t in (x, dt, bm, cm))
    cum = jnp.cumsum(jnp.moveaxis(dt * a, 2, -1), axis=-1)
    seg = cum[..., :, None] - cum[..., None, :]
    decay = jnp.exp(jnp.where(lower_tri(SSD_CHUNK), seg, -jnp.inf))
    dtx = dt[..., None] * x
    scores = jnp.einsum('bcign,bcjgn->bcgij', cm, bm)
    y = jnp.einsum('bcgij,bcghij,bcjghp->bcighp', scores, decay, dtx)
    decay_to_end = jnp.exp(cum[..., -1:] - cum)
    chunk_states = jnp.einsum('bcjgn,bcghj,bcjghp->bcghpn', bm, decay_to_end, dtx)
    chunk_decay = jnp.exp(cum[..., -1]).astype(chunk_states.dtype)

    def step(s, inp):
        dec, ds = inp
        return (dec[..., None, None] * s + ds).astype(ds.dtype), s

    s_final, s_prev = lax.scan(step, s0.astype(chunk_states.dtype),
                               (jnp.moveaxis(chunk_decay, 1, 0), jnp.moveaxis(chunk_states, 1, 0)))
    s_prev = jnp.moveaxis(s_prev, 0, 1)
    y = y + jnp.einsum('bcign,bcghi,bcghpn->bcighp', cm, jnp.exp(cum), s_prev)
    return y.reshape((bsz, length) + y.shape[3:]), s_final


def prefix_scan(scan_fn, ctx_args, lat_args, s0, reverse):
    flip = (lambda t: jnp.flip(t, axis=1)) if reverse else (lambda t: t)
    y_ctx, s_ctx = scan_fn(*[flip(t) for t in ctx_args], s0)
    y_lat, _ = scan_fn(*[flip(t) for t in lat_args], s_ctx)
    return flip(y_ctx), flip(y_lat)


def hgrn2_inputs(q, f_raw, i, lb):
    bsz, length = q.shape[:2]
    q = jax.nn.silu(q).reshape(bsz, length, HG_HEADS, HG_F) * HG_F ** -0.5
    lb = lb.reshape(2, HG_HEADS, HG_F)
    f = lb + (1.0 - lb) * jax.nn.sigmoid(
        f_raw.astype(jnp.float32).reshape(bsz, length, 2, HG_HEADS, HG_F))
    v = i.reshape(bsz, length, HG_HEADS, HG_V)
    return q, 1.0 - f, jnp.log(f), v


def hgrn2_readout(o, g, norm_w):
    bsz, length = o.shape[:2]
    return rms_norm(o, norm_w).reshape(bsz, length, HG_WIDTH) * jax.nn.silu(g)


def hgrn2_mixer(ctx_cols, lat_cols, lb, norm_w, with_ctx_out):
    qc, kc, lfc, vc = hgrn2_inputs(*ctx_cols[:3], lb)
    ql, kl, lfl, vl = hgrn2_inputs(*lat_cols[:3], lb)
    s0 = jnp.zeros((qc.shape[0], HG_HEADS, HG_F, HG_V), jnp.float32)
    outs = [prefix_scan(gla_chunk_scan,
                        (qc, kc[:, :, d], vc, lfc[:, :, d]),
                        (ql, kl[:, :, d], vl, lfl[:, :, d]), s0, d == 1) for d in range(2)]
    y_lat = hgrn2_readout(outs[0][1] + outs[1][1], lat_cols[3], norm_w)
    y_ctx = hgrn2_readout(outs[0][0] + outs[1][0], ctx_cols[3], norm_w) if with_ctx_out else None
    return y_ctx, y_lat


def ssd_inputs(xbc, dt_raw, dt_bias):
    bsz, length = xbc.shape[:2]
    xs, bm, cm = split_cols(xbc, (SSD_WIDTH, SSD_GROUPS * SSD_STATE, SSD_GROUPS * SSD_STATE))
    xs = xs.reshape(bsz, length, SSD_GROUPS, SSD_HPG, SSD_HEADDIM)
    bm = bm.reshape(bsz, length, SSD_GROUPS, SSD_STATE)
    cm = cm.reshape(bsz, length, SSD_GROUPS, SSD_STATE)
    dt = jax.nn.softplus(dt_raw.astype(jnp.float32).reshape(bsz, length, 2, SSD_GROUPS, SSD_HPG)
                         + dt_bias.astype(jnp.float32).reshape(2, SSD_GROUPS, SSD_HPG))
    return xs, dt, bm, cm


def ssd_mixer(ctx_cols, lat_cols, rows, conv_w, conv_b, a_log, dt_bias, d_skip, norm_w, with_ctx_out):
    z_c, xbc_c, dt_c = ctx_cols
    z_l, xbc_l, dt_l = lat_cols
    bsz = xbc_l.shape[0]
    xbc_c = jax.nn.silu(centred_dwconv(xbc_c, conv_w, conv_b))
    xbc_l = jax.nn.silu(centred_dwconv(xbc_l.reshape(bsz, rows, GRID_W, SSD_CONV_CH), conv_w, conv_b)
                        ).reshape(bsz, rows * GRID_W, SSD_CONV_CH)
    xc, dtc, bc, cc = ssd_inputs(xbc_c, dt_c, dt_bias)
    xl, dtl, bl, cl = ssd_inputs(xbc_l, dt_l, dt_bias)
    a = -jnp.exp(a_log.astype(jnp.float32)).reshape(2, SSD_GROUPS, SSD_HPG)
    s0 = jnp.zeros((bsz, SSD_GROUPS, SSD_HPG, SSD_HEADDIM, SSD_STATE), jnp.float32)
    outs = [prefix_scan(functools.partial(ssd_chunk_scan, a=a[d]),
                        (xc, dtc[:, :, d], bc, cc),
                        (xl, dtl[:, :, d], bl, cl), s0, d == 1) for d in range(2)]
    d_h = d_skip.reshape(SSD_GROUPS, SSD_HPG, 1)

    def readout(y, xs, z):
        b, length = z.shape[:2]
        u = (y + d_h * xs).reshape(b, length, SSD_WIDTH) * jax.nn.silu(z)
        u = rms_norm(u.reshape(b, length, SSD_GROUPS, SSD_WIDTH // SSD_GROUPS),
                     norm_w.reshape(SSD_GROUPS, -1))
        return u.reshape(b, length, SSD_WIDTH)

    y_lat = readout(outs[0][1] + outs[1][1], xl, z_l)
    y_ctx = readout(outs[0][0] + outs[1][0], xc, z_c) if with_ctx_out else None
    return y_ctx, y_lat


def token_mixing(u_ctx, u_lat, rows, w_in, conv_w, conv_b, a_log, dt_bias, d_skip, ssd_norm_w,
                 lb, hgrn_norm_w, w_out, with_ctx_out):
    pc = split_cols(u_ctx @ w_in, IN_SPLITS)
    pl = split_cols(u_lat @ w_in, IN_SPLITS)
    hg_c, hg_l = hgrn2_mixer(tuple(pc[:4]), tuple(pl[:4]), lb, hgrn_norm_w, with_ctx_out)
    ss_c, ss_l = ssd_mixer(tuple(pc[4:]), tuple(pl[4:]), rows, conv_w, conv_b, a_log, dt_bias,
                           d_skip, ssd_norm_w, with_ctx_out)
    y_lat = jnp.concatenate([hg_l, ss_l], axis=-1) @ w_out
    y_ctx = jnp.concatenate([hg_c, ss_c], axis=-1) @ w_out if with_ctx_out else None
    return y_ctx, y_lat


def setup_inputs(seed: int = 0) -> dict:
    key = jax.random.key(seed)
    ks = jax.random.split(key, 24)
    nrm = lambda k, shape, s: jax.random.normal(k, shape, jnp.float32) * s
    gain = lambda k, shape: 1.0 + 0.01 * jax.random.normal(k, shape, jnp.float32)
    dt0 = jnp.exp(jax.random.uniform(ks[10], (DEPTH, 2, SSD_HEADS), jnp.float32)
                  * (math.log(0.1) - math.log(0.001)) + math.log(0.001))
    return {
        "x": nrm(ks[0], (BATCH, SEQ, D_MODEL), 1.0),
        "c": nrm(ks[1], (BATCH, D_MODEL), 1.0),
        "ctx": nrm(ks[2], (BATCH, CTX_LEN, D_MODEL), 1.0),
        "c_ctx": nrm(ks[3], (D_MODEL,), 1.0),
        "w_ada": nrm(ks[4], (DEPTH, D_MODEL, N_MOD * D_MODEL), D_MODEL ** -0.5),
        "b_ada": nrm(ks[5], (DEPTH, N_MOD * D_MODEL), 0.01),
        "norm_mix": gain(ks[6], (DEPTH, D_MODEL)),
        "w_in": nrm(ks[7], (DEPTH, D_MODEL, D_IN), D_MODEL ** -0.5),
        "conv_w": nrm(ks[8], (DEPTH, SSD_CONV, SSD_CONV_CH), SSD_CONV ** -0.5),
        "conv_b": nrm(ks[9], (DEPTH, SSD_CONV_CH), 0.01),
        "ssd_a_log": jnp.log(jax.random.uniform(ks[11], (DEPTH, 2, SSD_HEADS), jnp.float32, 1.0, 16.0)),
        "ssd_dt_bias": dt0 + jnp.log(-jnp.expm1(-dt0)),
        "ssd_d": gain(ks[12], (DEPTH, SSD_HEADS)),
        "ssd_norm": gain(ks[13], (DEPTH, SSD_WIDTH)),
        "hgrn_lb_raw": nrm(ks[14], (DEPTH + 1, 2, HG_F_WIDTH), 0.1),
        "hgrn_norm": gain(ks[15], (DEPTH, HG_V)),
        "w_out": nrm(ks[16], (DEPTH, D_MIX, D_MODEL), D_MIX ** -0.5),
        "norm_ffn": gain(ks[17], (DEPTH, D_MODEL)),
        "w_gate": nrm(ks[18], (DEPTH, D_MODEL, D_FF), D_MODEL ** -0.5),
        "w_up": nrm(ks[19], (DEPTH, D_MODEL, D_FF), D_MODEL ** -0.5),
        "w_down": nrm(ks[20], (DEPTH, D_FF, D_MODEL), D_FF ** -0.5),
        "final_norm": gain(ks[21], (D_MODEL,)),
    }


def reference(x, c, ctx, c_ctx, w_ada, b_ada, norm_mix, w_in, conv_w, conv_b, ssd_a_log,
              ssd_dt_bias, ssd_d, ssd_norm, hgrn_lb_raw, hgrn_norm, w_out, norm_ffn,
              w_gate, w_up, w_down, final_norm):
    rows = x.shape[1] // GRID_W
    lbs = jnp.cumsum(jax.nn.softmax(hgrn_lb_raw.astype(jnp.float32), axis=0), axis=0)
    c_act = jax.nn.silu(c)
    cc_act = jax.nn.silu(c_ctx)
    h, hc = x, ctx
    for layer in range(DEPTH):
        with_ctx_out = layer < DEPTH - 1
        mod_lat = (c_act @ w_ada[layer] + b_ada[layer])[:, None, :]
        mod_ctx = cc_act @ w_ada[layer] + b_ada[layer]
        sh1, sc1, g1, sh2, sc2, g2 = jnp.split(mod_lat, N_MOD, axis=-1)
        csh1, csc1, cg1, csh2, csc2, cg2 = jnp.split(mod_ctx, N_MOD, axis=-1)
        u_lat = modulate(rms_norm(h, norm_mix[layer]), sh1, sc1)
        u_ctx = modulate(rms_norm(hc, norm_mix[layer]), csh1, csc1)
        y_ctx, y_lat = token_mixing(u_ctx, u_lat, rows, w_in[layer], conv_w[layer], conv_b[layer],
                                    ssd_a_log[layer], ssd_dt_bias[layer], ssd_d[layer],
                                    ssd_norm[layer], lbs[layer], hgrn_norm[layer], w_out[layer],
                                    with_ctx_out)
        h = (h + g1 * y_lat).astype(x.dtype)
        u = modulate(rms_norm(h, norm_ffn[layer]), sh2, sc2)
        h = (h + g2 * swiglu(u, w_gate[layer], w_up[layer], w_down[layer])).astype(x.dtype)
        if with_ctx_out:
            hc = (hc + cg1 * y_ctx).astype(ctx.dtype)
            uc = modulate(rms_norm(hc, norm_ffn[layer]), csh2, csc2)
            hc = (hc + cg2 * swiglu(uc, w_gate[layer], w_up[layer], w_down[layer])).astype(ctx.dtype)
    return rms_norm(h, final_norm)
```

```cpp
#include <hip/hip_runtime.h>
#include <hip/hip_cooperative_groups.h>
#include <cstdio>
namespace cg = cooperative_groups;
__device__ __forceinline__ int opaque_tid() { int t = threadIdx.x; asm volatile("" : "+v"(t)); return t; }
namespace pg8 {
#define PG8_LAS __attribute__((address_space(3)))
typedef unsigned short bf16_t;
typedef short bf16x8 __attribute__((ext_vector_type(8)));
typedef float f32x4 __attribute__((ext_vector_type(4)));
typedef unsigned u32x4 __attribute__((ext_vector_type(4)));
constexpr int BM = 256, BK = 64, HALF = 128, HTB = HALF * BK * 2  , STAGE_BYTES = 8 * HTB, NXCD = 8, WGM = 8;

__host__ __device__ __forceinline__ int lds_byte(int r, int c) { const int st = (r >> 4) * 2 + (c >> 5), rr = r & 15, cc = c & 31, ob = rr * 64 + cc * 2; return st * 1024 + (ob ^ (((ob >> 9) & 1) << 5)); }
__host__ __device__ __forceinline__ void stage_rc(int b, int& R, int& C) { const int st = b / 1024, sb = b % 1024, swz = sb ^ (((sb >> 9) & 1) << 5); R = (st >> 1) * 16 + swz / 64; C = (st & 1) * 32 + (swz % 64) / 2; }
__host__ __device__ __forceinline__ int perm32(int rho) { const int n = rho >> 4, i = rho & 15; return 8 * (i >> 2) + 4 * n + (i & 3); }

struct Unit { int pm, pn; };
struct Gemm { const bf16_t* A; const bf16_t* Bt; int M, N, K; };

struct StaticOrder {
    int nM, nN, nwg, G, c;
    __host__ __device__ void init(int M, int N, int G_, int c_) { nM = M / BM; nN = N / BM; nwg = nM * nN; G = G_; c = c_; }
    __host__ __device__ bool next(int i, Unit& u) const {
        const long L = (long)i * G + c; if (L >= nwg) return false;
        int wgid = (int)L; { const int q = nwg / NXCD, r = nwg % NXCD, xcd = wgid % NXCD, off = wgid / NXCD; wgid = (xcd < r ? xcd * (q + 1) : r * (q + 1) + (xcd - r) * q) + off; }
        const int nig = WGM * nN, gid = wgid / nig, fm = gid * WGM, gsz = (nM - fm) < WGM ? (nM - fm) : WGM;
        u.pm = fm + ((wgid % nig) % gsz); u.pn = (wgid % nig) / gsz; return true;
    }
    __device__ __forceinline__ void a_ready(const Unit&) const {}
    __device__ __forceinline__ void done(const Unit&) const {}
};
typedef __bf16 bf16v2_t __attribute__((ext_vector_type(2)));
typedef float f32v2_t __attribute__((ext_vector_type(2)));
__device__ __forceinline__ unsigned cvt_pk_bf16(float lo, float hi) { f32v2_t v = {lo, hi}; bf16v2_t r = __builtin_convertvector(v, bf16v2_t); return __builtin_bit_cast(unsigned, r); }
typedef float f32x2 __attribute__((ext_vector_type(2)));
template <class Epi, class Sched, bool STAMP = false>
__device__ __forceinline__ void gemm_phase(PG8_LAS unsigned char* lds, const Gemm g, const Sched& S, const Epi& E, unsigned long long* stamps) {
    const int tid = opaque_tid(), wid = __builtin_amdgcn_readfirstlane(tid >> 6), lane = tid & 63, wr = wid >> 2, wc = wid & 3, fr = lane & 15, fq = lane >> 4;
    const int K = g.K, nt = K / BK;
    int ts_lo = 0, ts_hi = 0, nts = 0; const unsigned long long rt_entry = STAMP ? (unsigned long long)wall_clock64() : 0ull;
#define PG8_STAMP() do { if (STAMP && wid == 0 && nts < 64) { const unsigned long long _c = (unsigned long long)clock64(); \
        ts_lo = (lane == nts) ? (int)(unsigned)_c : ts_lo; ts_hi = (lane == nts) ? (int)(unsigned)(_c >> 32) : ts_hi; ++nts; } } while (0)
    PG8_STAMP();
    unsigned voffA[2], voffB[2];
#pragma unroll
    for (int i = 0; i < 2; ++i) { int R, C; stage_rc(tid * 16 + i * 8192, R, C); const int Rb = Epi::PERM ? ((R & ~31) + perm32(R & 31)) : R;
        voffA[i] = (unsigned)(R * K + C) * 2u; voffB[i] = (unsigned)(Rb * K + C) * 2u; }
    const size_t kstep = (size_t)(BK * 2);
    const size_t hstep = (size_t)HALF * K * 2;
    const size_t tstep = 2 * hstep;
    const unsigned ldsw = (unsigned)wid * 1024u;
    const int aoff = lds_byte(wr * 64 + fr, fq * 8), boff = lds_byte(wc * 32 + fr, fq * 8);
#define PG8_SA(b, h) (((b) * 2 + (h)) * HTB)
#define PG8_SB(b, h) ((4 + (b) * 2 + (h)) * HTB)
#define PG8_STAGE(bufoff, gbase, voff) do { _Pragma("unroll") for (int _i = 0; _i < 2; ++_i) \
        __builtin_amdgcn_global_load_lds((const unsigned*)((const char*)(gbase) + (voff)[_i]), (PG8_LAS unsigned*)(lds + (bufoff) + ldsw + _i * 8192), 16, 0, 0); } while (0)
#define PG8_LDA(dst, b, h) do { _Pragma("unroll") for (int m = 0; m < 4; ++m) _Pragma("unroll") for (int k = 0; k < 2; ++k) dst[m][k] = *(const PG8_LAS bf16x8*)(lds + PG8_SA(b, h) + aoff + m * 2048 + k * 1024); } while (0)
#define PG8_LDB(dst, b, h) do { _Pragma("unroll") for (int n = 0; n < 2; ++n) _Pragma("unroll") for (int k = 0; k < 2; ++k) dst[n][k] = *(const PG8_LAS bf16x8*)(lds + PG8_SB(b, h) + boff + n * 2048 + k * 1024); } while (0)
#define PG8_MMA(ai, bj, At, Bt) do { __builtin_amdgcn_s_setprio(1); _Pragma("unroll") for (int m = 0; m < 4; ++m) _Pragma("unroll") for (int n = 0; n < 2; ++n) _Pragma("unroll") for (int k = 0; k < 2; ++k) \
        acc[ai][bj][m][n] = __builtin_amdgcn_mfma_f32_16x16x32_bf16(Bt[n][k], At[m][k], acc[ai][bj][m][n], 0, 0, 0); __builtin_amdgcn_s_setprio(0); } while (0)
#define PG8_WAIT_V(n) asm volatile("s_waitcnt vmcnt(" #n ")" ::: "memory")
#define PG8_WAIT_L(n) asm volatile("s_waitcnt lgkmcnt(" #n ")" ::: "memory")
#define PG8_BAR __builtin_amdgcn_s_barrier()
#define PG8_SCHED __builtin_amdgcn_sched_barrier(0)
    Unit cur, nxt; int ui = 0;
    if (!S.next(0, cur)) return;
    f32x4 acc[2][2][4][2];
#pragma unroll
    for (int a = 0; a < 2; ++a)
#pragma unroll
        for (int b = 0; b < 2; ++b)
#pragma unroll
            for (int m = 0; m < 4; ++m)
#pragma unroll
                for (int n = 0; n < 2; ++n) acc[a][b][m][n] = (f32x4){0.f, 0.f, 0.f, 0.f};
    bf16x8 At[4][2], B0[2][2], B1[2][2];
    const char* cA = (const char*)g.A + (size_t)cur.pm * tstep; const char* cB = (const char*)g.Bt + (size_t)cur.pn * tstep;
    S.a_ready(cur);
    PG8_STAGE(PG8_SB(0, 0), cB, voffB); PG8_STAGE(PG8_SA(0, 0), cA, voffA); PG8_STAGE(PG8_SB(0, 1), cB + hstep, voffB); PG8_STAGE(PG8_SA(0, 1), cA + hstep, voffA);
    if (wr == 1) PG8_BAR;
    PG8_WAIT_V(4); PG8_BAR;
    PG8_STAGE(PG8_SB(1, 0), cB + kstep, voffB); PG8_STAGE(PG8_SA(1, 0), cA + kstep, voffA); PG8_STAGE(PG8_SB(1, 1), cB + hstep + kstep, voffB);
    PG8_WAIT_V(6); PG8_BAR;
    PG8_STAMP();
    for (;;) {
        const bool has_next = S.next(ui + 1, nxt);
        const char* nA = has_next ? (const char*)g.A + (size_t)nxt.pm * tstep : cA; const char* nB = has_next ? (const char*)g.Bt + (size_t)nxt.pn * tstep : cB;
        for (int t = 0; t < nt; t += 2) {
            const bool last = (t == nt - 2);
            const char* a1 = cA + (size_t)(t + 1) * kstep;
            const char* a2 = last ? nA : cA + (size_t)(t + 2) * kstep; const char* b2 = last ? nB : cB + (size_t)(t + 2) * kstep;
            const char* a3 = a2 + kstep; const char* b3 = b2 + kstep;
            if (last && has_next) S.a_ready(nxt);
            PG8_LDB(B0, 0, 0); PG8_SCHED; PG8_LDA(At, 0, 0); PG8_STAGE(PG8_SA(1, 1), a1 + hstep, voffA);
            PG8_WAIT_L(8); PG8_BAR; PG8_WAIT_L(0); PG8_MMA(0, 0, At, B0); PG8_BAR; PG8_SCHED;
            PG8_LDB(B1, 0, 1); PG8_STAGE(PG8_SB(0, 0), b2, voffB);
            PG8_BAR; PG8_WAIT_L(0); PG8_MMA(0, 1, At, B1); PG8_BAR;
            PG8_LDA(At, 0, 1); PG8_STAGE(PG8_SA(0, 0), a2, voffA);
            PG8_BAR; PG8_WAIT_L(0); PG8_MMA(1, 0, At, B0); PG8_BAR; PG8_SCHED;
            PG8_STAGE(PG8_SB(0, 1), b2 + hstep, voffB);
            PG8_WAIT_V(6); PG8_BAR; PG8_MMA(1, 1, At, B1); PG8_BAR;
            PG8_LDB(B0, 1, 0); PG8_SCHED; PG8_LDA(At, 1, 0); PG8_STAGE(PG8_SA(0, 1), a2 + hstep, voffA);
            PG8_WAIT_L(8); PG8_BAR; PG8_WAIT_L(0); PG8_MMA(0, 0, At, B0); PG8_BAR; PG8_SCHED;
            PG8_LDB(B1, 1, 1); PG8_STAGE(PG8_SB(1, 0), b3, voffB);
            PG8_BAR; PG8_WAIT_L(0); PG8_MMA(0, 1, At, B1); PG8_BAR;
            PG8_LDA(At, 1, 1); PG8_STAGE(PG8_SA(1, 0), a3, voffA);
            PG8_BAR; PG8_WAIT_L(0); PG8_MMA(1, 0, At, B0); PG8_BAR; PG8_SCHED;
            PG8_STAGE(PG8_SB(1, 1), b3 + hstep, voffB);
            PG8_WAIT_V(6); PG8_BAR; PG8_MMA(1, 1, At, B1); PG8_BAR;
        }
        PG8_STAMP();
        if constexpr (!Epi::AFTER_DRAIN) { E(acc, cur, wr, wc, fr, fq); S.done(cur); }
        PG8_STAMP();
        if (!has_next) break;
#pragma unroll
        for (int a = 0; a < 2; ++a)
#pragma unroll
            for (int b = 0; b < 2; ++b)
#pragma unroll
                for (int m = 0; m < 4; ++m)
#pragma unroll
                    for (int n = 0; n < 2; ++n) acc[a][b][m][n] = (f32x4){0.f, 0.f, 0.f, 0.f};
        cur = nxt; cA = nA; cB = nB; ++ui;
    }
    PG8_WAIT_V(0);
    if (wr == 0) PG8_BAR;
    PG8_BAR;
    if constexpr (Epi::AFTER_DRAIN) { E.fused(acc, cur, wr, wc, fr, fq, lds, wid, lane); S.done(cur); }
    PG8_STAMP();
    if (STAMP && wid == 0) { stamps[lane] = lane < nts ? (((unsigned long long)(unsigned)ts_hi << 32) | (unsigned)ts_lo) : 0ull;
        if (lane == 62) stamps[62] = rt_entry; if (lane == 63) stamps[63] = (unsigned long long)wall_clock64(); }
#undef PG8_STAMP
#undef PG8_SA
#undef PG8_SB
#undef PG8_STAGE
#undef PG8_LDA
#undef PG8_LDB
#undef PG8_MMA
#undef PG8_WAIT_V
#undef PG8_WAIT_L
#undef PG8_BAR
#undef PG8_SCHED
}
}

namespace mk {
using pg8::bf16_t; using pg8::bf16x8; using pg8::f32x4; using pg8::u32x4; using pg8::Unit;
#define LAS __attribute__((address_space(3)))
typedef unsigned u32x2 __attribute__((ext_vector_type(2)));
typedef _Float16 f16;

constexpr int D = 1024, NB = 8, SEQ = 4096, CTX = 256, DIN = 8224, NPAD = 8448, DFF = 2816;
constexpr int BP = 4;
constexpr int NPASS = NB / BP;
constexpr int ML = BP * SEQ;
constexpr int MC = BP * CTX;
constexpr int MP = ML + MC;
constexpr float EPS = 1e-6f;
constexpr int NT = 512;
constexpr int LDS_BYTES = 131072;

constexpr size_t SZ_WIN = (size_t)NPAD * D * 2, SZ_WOUT = (size_t)D * 2048 * 2, SZ_WGU = (size_t)2 * DFF * D * 2, SZ_WD = (size_t)D * DFF * 2;
constexpr size_t OFF_WIN = 0, OFF_WOUT = OFF_WIN + SZ_WIN, OFF_WGU = OFF_WOUT + SZ_WOUT, OFF_WD = OFF_WGU + SZ_WGU;
constexpr size_t OFF_MOD = OFF_WD + SZ_WD;
constexpr size_t OFF_LB = OFF_MOD + 9 * 6144 * 4;
constexpr size_t OFF_BAR = OFF_LB + 2048 * 4;
constexpr size_t OFF_Q = OFF_BAR + 256;
constexpr size_t OFF_FR = OFF_Q + (size_t)MP * 1024 * 2;
constexpr size_t OFF_V = OFF_FR + (size_t)MP * 2048 * 2;
constexpr size_t OFF_DT = OFF_V + (size_t)MP * 1024 * 2;
constexpr size_t OFF_G = OFF_DT + (size_t)MP * 32 * 4;
constexpr size_t OFF_Z = OFF_G + (size_t)ML * 1024 * 2;
constexpr size_t OFF_XC = OFF_Z + (size_t)ML * 1024 * 2;
constexpr size_t OFF_X1 = OFF_XC + (size_t)MP * 2048 * 2;
constexpr size_t OFF_U = OFF_X1;
constexpr size_t OFF_XR = OFF_X1 + (size_t)MP * 1024 * 2;
constexpr size_t OFF_OH = OFF_X1;
constexpr size_t OFF_OS = OFF_X1 + (size_t)2 * ML * 1024 * 2;
constexpr size_t WS_END = OFF_X1 + (size_t)4 * ML * 1024 * 2;
constexpr size_t OFF_A2 = OFF_Q;
constexpr size_t OFF_H1 = OFF_X1;
constexpr size_t OFF_U2 = OFF_V;
constexpr size_t OFF_ACT = OFF_G;
static_assert((size_t)ML * 2048 * 2 <= (size_t)MP * 1024 * 2 + (size_t)MP * 2048 * 2, "A2 overlay");
static_assert((size_t)ML * DFF * 2 <= (size_t)2 * ML * 1024 * 2 + (size_t)MP * 2048 * 2, "ACT overlay");
static_assert((size_t)MP * 1024 * 2 + (size_t)MP * 2048 * 2 <= (size_t)4 * ML * 1024 * 2, "U+XR in X1");

struct Params {
    const float *x, *c, *ctx, *c_ctx, *w_ada, *b_ada, *norm_mix, *w_in, *conv_w, *conv_b, *a_log, *dt_bias, *ssd_d, *ssd_norm,
                *lb_raw, *hgrn_norm, *w_out, *norm_ffn, *w_gate, *w_up, *w_down, *final_norm;
    float* out; unsigned char* ws;
};

__device__ __forceinline__ float bf2f(unsigned short b) { return __uint_as_float(((unsigned)b) << 16); }
__device__ __forceinline__ float bflo(unsigned w) { return __uint_as_float(w << 16); }
__device__ __forceinline__ float bfhi(unsigned w) { return __uint_as_float(w & 0xffff0000u); }
__device__ __forceinline__ unsigned pk2(float lo, float hi) { return pg8::cvt_pk_bf16(lo, hi); }
__device__ __forceinline__ unsigned short f2bf(float f) { return (unsigned short)(pk2(f, 0.f) & 0xffffu); }
__device__ __forceinline__ float siluf(float v) { return v / (1.0f + __expf(-v)); }
__device__ __forceinline__ float wave_sum(float v) {
#pragma unroll
    for (int o = 1; o < 64; o <<= 1) v += __shfl_xor(v, o);
    return v;
}

__device__ __forceinline__ void p0_transpose_item(const float* W, int K, int N, bf16_t* WT, int k0, int n0, int drow0, LAS float* scr, int lane) {
#pragma unroll 8
    for (int i = 0; i < 32; ++i) { const int kk = 2 * i + (lane >> 5); scr[kk * 33 + (lane & 31)] = W[(size_t)(k0 + kk) * N + n0 + (lane & 31)]; }
    asm volatile("s_waitcnt vmcnt(0) lgkmcnt(0)" ::: "memory");
    const int c = lane & 7;
#pragma unroll
    for (int j = 0; j < 4; ++j) { const int n = (lane >> 3) + 8 * j; const LAS float* s = scr + (8 * c) * 33 + n;
        u32x4 o; o.x = pk2(s[0 * 33], s[1 * 33]); o.y = pk2(s[2 * 33], s[3 * 33]); o.z = pk2(s[4 * 33], s[5 * 33]); o.w = pk2(s[6 * 33], s[7 * 33]);
        *(u32x4*)(WT + (size_t)(drow0 + n) * K + k0 + 8 * c) = o; }
    asm volatile("s_waitcnt lgkmcnt(0)" ::: "memory");
}

__device__ __forceinline__ void phase_prep(const Params& P, LAS unsigned char* lds) {
    const int tid = opaque_tid(), lane = tid & 63, wave = tid >> 6;
    unsigned char* ws = P.ws;
    float* mod = (float*)(ws + OFF_MOD);
    for (int item = blockIdx.x; item < 96; item += gridDim.x) {
        const int col = item * 64 + lane;
        float acc[9];
#pragma unroll
        for (int r = 0; r < 9; ++r) acc[r] = 0.f;
        for (int kk = 0; kk < 128; ++kk) {
            const int k = wave * 128 + kk;
            const float wv = P.w_ada[(size_t)k * 6144 + col];
#pragma unroll
            for (int r = 0; r < 9; ++r) { const float cv = (r < 8) ? P.c[r * 1024 + k] : P.c_ctx[k]; acc[r] += siluf(cv) * wv; }
        }
        LAS float* red = (LAS float*)lds;
#pragma unroll
        for (int r = 0; r < 9; ++r) red[(wave * 9 + r) * 64 + lane] = acc[r];
        __syncthreads();
        for (int e = tid; e < 9 * 64; e += NT) { const int r = e >> 6, l = e & 63; float s = 0.f;
#pragma unroll
            for (int w = 0; w < 8; ++w) s += red[(w * 9 + r) * 64 + l];
            mod[r * 6144 + item * 64 + l] = s + P.b_ada[item * 64 + l]; }
        __syncthreads();
    }
    float* lbv = (float*)(ws + OFF_LB);
    for (int j = blockIdx.x * NT + tid; j < 2048; j += gridDim.x * NT) { const float r0 = P.lb_raw[j], r1 = P.lb_raw[2048 + j]; lbv[j] = 1.0f / (1.0f + __expf(r1 - r0)); }
    { u32x4* z = (u32x4*)(ws + OFF_WIN + (size_t)DIN * D * 2); const int n16 = (NPAD - DIN) * D * 2 / 16;
      for (int j = blockIdx.x * NT + tid; j < n16; j += gridDim.x * NT) z[j] = (u32x4){0u, 0u, 0u, 0u}; }
    LAS float* scr = (LAS float*)(lds + 32768 + wave * 8704);
    bf16_t* WinT = (bf16_t*)(ws + OFF_WIN); bf16_t* WoutT = (bf16_t*)(ws + OFF_WOUT); bf16_t* WguT = (bf16_t*)(ws + OFF_WGU); bf16_t* WdT = (bf16_t*)(ws + OFF_WD);
    constexpr int I_IN = (D / 64) * (DIN / 32), I_OUT = (2048 / 64) * (D / 32), I_G = (D / 64) * (DFF / 32), I_D = (DFF / 64) * (D / 32);
    constexpr int NITEMS = I_IN + I_OUT + 2 * I_G + I_D;
    const int gw = blockIdx.x * 8 + wave, NGW = gridDim.x * 8;
    for (int it = gw; it < NITEMS; it += NGW) {
        int r = it;
        if (r < I_IN) { const int nblk = DIN / 32, kb = r / nblk, nb = r % nblk; p0_transpose_item(P.w_in, D, DIN, WinT, 64 * kb, 32 * nb, 32 * nb, scr, lane); continue; } r -= I_IN;
        if (r < I_OUT) { const int nblk = D / 32, kb = r / nblk, nb = r % nblk; p0_transpose_item(P.w_out, 2048, D, WoutT, 64 * kb, 32 * nb, 32 * nb, scr, lane); continue; } r -= I_OUT;
        if (r < I_G) { const int nblk = DFF / 32, kb = r / nblk, nb = r % nblk, n0 = 32 * nb; p0_transpose_item(P.w_gate, D, DFF, WguT, 64 * kb, n0, (n0 >> 7) * 256 + (n0 & 127), scr, lane); continue; } r -= I_G;
        if (r < I_G) { const int nblk = DFF / 32, kb = r / nblk, nb = r % nblk, n0 = 32 * nb; p0_transpose_item(P.w_up, D, DFF, WguT, 64 * kb, n0, (n0 >> 7) * 256 + 128 + (n0 & 127), scr, lane); continue; } r -= I_G;
        { const int nblk = D / 32, kb = r / nblk, nb = r % nblk; p0_transpose_item(P.w_down, DFF, D, WdT, 64 * kb, 32 * nb, 32 * nb, scr, lane); }
    }
}

template <int MODE>
__device__ __forceinline__ void phase_norm(const Params& P, int pass) {
    const int tid_ = opaque_tid(); const int lane = tid_ & 63, wave = tid_ >> 6;
    const float* mod = (const float*)(P.ws + OFF_MOD);
    const int nrows = MODE == 0 ? MP : ML;
    bf16_t* outp = (bf16_t*)(P.ws + (MODE == 0 ? OFF_U : OFF_U2));
    const float* nw = MODE == 0 ? P.norm_mix : P.norm_ffn;
    for (int r = blockIdx.x * 8 + wave; r < nrows; r += gridDim.x * 8) {
        const float* src; int mrow;
        if (MODE == 0) {
            if (r < ML) { src = P.x + ((size_t)pass * ML + r) * D; mrow = pass * BP + (r >> 12); }
            else { const int rc = r - ML; src = P.ctx + ((size_t)pass * MC + rc) * D; mrow = 8; }
        } else { src = (const float*)(P.ws + OFF_H1) + (size_t)r * D; mrow = pass * BP + (r >> 12); }
        const float* sh = mod + mrow * 6144 + (MODE == 0 ? 0 : 3072); const float* sc = sh + 1024;
        f32x4 v[4]; float ss = 0.f;
#pragma unroll
        for (int j = 0; j < 4; ++j) { v[j] = *(const f32x4*)(src + 256 * j + 4 * lane); ss += (v[j].x * v[j].x + v[j].y * v[j].y) + (v[j].z * v[j].z + v[j].w * v[j].w); }
        const float rstd = rsqrtf(wave_sum(ss) * (1.0f / D) + EPS);
#pragma unroll
        for (int j = 0; j < 4; ++j) { const int c0 = 256 * j + 4 * lane;
            const f32x4 w = *(const f32x4*)(nw + c0), s1 = *(const f32x4*)(sc + c0), s0 = *(const f32x4*)(sh + c0);
            const f32x4 o = (v[j] * rstd * w) * (1.0f + s1) + s0;
            u32x2 pk; pk.x = pk2(o.x, o.y); pk.y = pk2(o.z, o.w);
            *(u32x2*)(outp + (size_t)r * D + c0) = pk; }
    }
}

__device__ __forceinline__ void phase_final_norm(const Params& P, int pass) {
    const int tid_ = opaque_tid(); const int lane = tid_ & 63, wave = tid_ >> 6;
    for (int r = blockIdx.x * 8 + wave; r < ML; r += gridDim.x * 8) {
        float* row = P.out + ((size_t)pass * ML + r) * D;
        f32x4 v[4]; float ss = 0.f;
#pragma unroll
        for (int j = 0; j < 4; ++j) { v[j] = *(const f32x4*)(row + 256 * j + 4 * lane); ss += (v[j].x * v[j].x + v[j].y * v[j].y) + (v[j].z * v[j].z + v[j].w * v[j].w); }
        const float rstd = rsqrtf(wave_sum(ss) * (1.0f / D) + EPS);
#pragma unroll
        for (int j = 0; j < 4; ++j) { const int c0 = 256 * j + 4 * lane; const f32x4 w = *(const f32x4*)(P.final_norm + c0);
            *(f32x4*)(row + c0) = v[j] * rstd * w; }
    }
}

struct EpiIn {
    static constexpr bool PERM = true, AFTER_DRAIN = false;
    unsigned char* ws; const float* dt_bias;
    __device__ __forceinline__ void operator()(const f32x4 (&acc)[2][2][4][2], const Unit& u, int wr, int wc, int fr, int fq) const {
        const int pn = u.pn; const bool lat = u.pm < (ML / 256);
        int kind, ld, cofs; size_t off;
        float scale = 1.0f;
        if (pn < 4) { kind = lat ? 0 : 4; off = OFF_Q; ld = 1024; cofs = 0; scale = 0.08838834764831845f; }
        else if (pn < 12) { kind = 2; off = OFF_FR; ld = 2048; cofs = 1024; }
        else if (pn < 16) { kind = 1; off = OFF_V; ld = 1024; cofs = 3072; }
        else if (pn < 20) { kind = lat ? 0 : 4; off = OFF_G; ld = 1024; cofs = 4096; }
        else if (pn < 24) { kind = lat ? 0 : 4; off = OFF_Z; ld = 1024; cofs = 5120; }
        else if (pn < 32) { kind = 1; off = OFF_XR; ld = 2048; cofs = 6144; }
        else { kind = 3; off = OFF_DT; ld = 32; cofs = 8192; }
        if (kind == 4) return;
        const int row0 = u.pm * 256 + wr * 64 + fr;
        if (kind == 3) {
            if (wc != 0) return;
            float* DT = (float*)(ws + off);
            const f32x4 b0 = *(const f32x4*)(dt_bias + 8 * fq), b1 = *(const f32x4*)(dt_bias + 8 * fq + 4);
#pragma unroll
            for (int ai = 0; ai < 2; ++ai)
#pragma unroll
                for (int m = 0; m < 4; ++m) { const int row = row0 + ai * 128 + m * 16;
                    f32x4 v0 = acc[ai][0][m][0] + b0, v1 = acc[ai][0][m][1] + b1;
#pragma unroll
                    for (int j = 0; j < 4; ++j) { v0[j] = v0[j] > 20.f ? v0[j] : log1pf(__expf(v0[j])); v1[j] = v1[j] > 20.f ? v1[j] : log1pf(__expf(v1[j])); }
                    *(f32x4*)(DT + (size_t)row * 32 + 8 * fq) = v0; *(f32x4*)(DT + (size_t)row * 32 + 8 * fq + 4) = v1; }
            return;
        }
        unsigned short* O = (unsigned short*)(ws + off);
        const int col0 = pn * 256 - cofs + wc * 32 + 8 * fq;
#pragma unroll
        for (int ai = 0; ai < 2; ++ai)
#pragma unroll
            for (int m = 0; m < 4; ++m) { unsigned short* rowp = O + (size_t)(row0 + ai * 128 + m * 16) * ld + col0;
#pragma unroll
                for (int bj = 0; bj < 2; ++bj) { f32x4 v0 = acc[ai][bj][m][0], v1 = acc[ai][bj][m][1]; u32x4 w;
                    if (kind == 0) {
#pragma unroll
                        for (int j = 0; j < 4; ++j) { v0[j] = siluf(v0[j]) * scale; v1[j] = siluf(v1[j]) * scale; } }
                    if (kind == 2) {
                        typedef f16 h2 __attribute__((ext_vector_type(2)));
                        h2 a = {(f16)v0[0], (f16)v0[1]}, b = {(f16)v0[2], (f16)v0[3]}, c = {(f16)v1[0], (f16)v1[1]}, d = {(f16)v1[2], (f16)v1[3]};
                        w.x = __builtin_bit_cast(unsigned, a); w.y = __builtin_bit_cast(unsigned, b); w.z = __builtin_bit_cast(unsigned, c); w.w = __builtin_bit_cast(unsigned, d);
                    } else { w.x = pk2(v0[0], v0[1]); w.y = pk2(v0[2], v0[3]); w.z = pk2(v1[0], v1[1]); w.w = pk2(v1[2], v1[3]); }
                    *(u32x4*)(rowp + bj * 128) = w; } }
    }
};
struct EpiOut {
    static constexpr bool PERM = false, AFTER_DRAIN = false;
    const float* x; const float* mod; float* H1; int pass;
    __device__ __forceinline__ void operator()(const f32x4 (&acc)[2][2][4][2], const Unit& u, int wr, int wc, int fr, int fq) const {
        const int row0 = u.pm * 256 + wr * 64 + fr, col0 = u.pn * 256 + wc * 32 + 4 * fq;
        const float* g1 = mod + (size_t)(pass * BP + (u.pm >> 4)) * 6144 + 2048;
        f32x4 gv[2][2];
#pragma unroll
        for (int bj = 0; bj < 2; ++bj)
#pragma unroll
            for (int n = 0; n < 2; ++n) gv[bj][n] = *(const f32x4*)(g1 + col0 + bj * 128 + n * 16);
#pragma unroll
        for (int ai = 0; ai < 2; ++ai)
#pragma unroll
            for (int m = 0; m < 4; ++m) { const int row = row0 + ai * 128 + m * 16; const float* xr = x + ((size_t)pass * ML + row) * D + col0; float* hr = H1 + (size_t)row * D + col0;
#pragma unroll
                for (int bj = 0; bj < 2; ++bj)
#pragma unroll
                    for (int n = 0; n < 2; ++n) *(f32x4*)(hr + bj * 128 + n * 16) = *(const f32x4*)(xr + bj * 128 + n * 16) + gv[bj][n] * acc[ai][bj][m][n]; }
    }
};
struct EpiGU {
    static constexpr bool PERM = true, AFTER_DRAIN = false;
    bf16_t* ACT;
    __device__ __forceinline__ void operator()(const f32x4 (&acc)[2][2][4][2], const Unit& u, int wr, int wc, int fr, int fq) const {
        const int row0 = u.pm * 256 + wr * 64 + fr, col0 = u.pn * 128 + wc * 32 + 8 * fq;
#pragma unroll
        for (int ai = 0; ai < 2; ++ai)
#pragma unroll
            for (int m = 0; m < 4; ++m) { bf16_t* rowp = ACT + (size_t)(row0 + ai * 128 + m * 16) * DFF + col0;
                f32x4 g0 = acc[ai][0][m][0], g1 = acc[ai][0][m][1]; const f32x4 u0 = acc[ai][1][m][0], u1 = acc[ai][1][m][1];
#pragma unroll
                for (int j = 0; j < 4; ++j) { g0[j] = siluf(g0[j]) * u0[j]; g1[j] = siluf(g1[j]) * u1[j]; }
                u32x4 w; w.x = pk2(g0[0], g0[1]); w.y = pk2(g0[2], g0[3]); w.z = pk2(g1[0], g1[1]); w.w = pk2(g1[2], g1[3]);
                *(u32x4*)rowp = w; }
    }
};
struct EpiDown {
    static constexpr bool PERM = false, AFTER_DRAIN = false;
    const float* H1; const float* mod; float* out; int pass;
    __device__ __forceinline__ void operator()(const f32x4 (&acc)[2][2][4][2], const Unit& u, int wr, int wc, int fr, int fq) const {
        const int row0 = u.pm * 256 + wr * 64 + fr, col0 = u.pn * 256 + wc * 32 + 4 * fq;
        const float* g2 = mod + (size_t)(pass * BP + (u.pm >> 4)) * 6144 + 5120;
        f32x4 gv[2][2];
#pragma unroll
        for (int bj = 0; bj < 2; ++bj)
#pragma unroll
            for (int n = 0; n < 2; ++n) gv[bj][n] = *(const f32x4*)(g2 + col0 + bj * 128 + n * 16);
#pragma unroll
        for (int ai = 0; ai < 2; ++ai)
#pragma unroll
            for (int m = 0; m < 4; ++m) { const int row = row0 + ai * 128 + m * 16; const float* hr = H1 + (size_t)row * D + col0; float* orow = out + ((size_t)pass * ML + row) * D + col0;
#pragma unroll
                for (int bj = 0; bj < 2; ++bj)
#pragma unroll
                    for (int n = 0; n < 2; ++n) *(f32x4*)(orow + bj * 128 + n * 16) = *(const f32x4*)(hr + bj * 128 + n * 16) + gv[bj][n] * acc[ai][bj][m][n]; }
    }
};

__device__ __forceinline__ void phase_conv(const Params& P) {
    const bf16_t* XR = (const bf16_t*)(P.ws + OFF_XR); bf16_t* XC = (bf16_t*)(P.ws + OFF_XC);
    constexpr int SEGL = 32, NSEG = MP / SEGL, NITEM = NSEG * 256;
    for (int it = blockIdx.x * NT + opaque_tid(); it < NITEM; it += gridDim.x * NT) {
        const int seg = it >> 8, cg8 = (it & 255) * 8, r0 = seg * SEGL;
        int L0, L1;
        if (r0 < ML) { L0 = r0 & ~63; L1 = L0 + 64; } else { const int rc = r0 - ML; L0 = ML + (rc & ~255); L1 = L0 + 256; }
        float w[5][8], bias[8];
#pragma unroll
        for (int k = 0; k < 5; ++k) { const f32x4 a = *(const f32x4*)(P.conv_w + k * 2048 + cg8), b = *(const f32x4*)(P.conv_w + k * 2048 + cg8 + 4);
            w[k][0] = a.x; w[k][1] = a.y; w[k][2] = a.z; w[k][3] = a.w; w[k][4] = b.x; w[k][5] = b.y; w[k][6] = b.z; w[k][7] = b.w; }
        { const f32x4 a = *(const f32x4*)(P.conv_b + cg8), b = *(const f32x4*)(P.conv_b + cg8 + 4);
          bias[0] = a.x; bias[1] = a.y; bias[2] = a.z; bias[3] = a.w; bias[4] = b.x; bias[5] = b.y; bias[6] = b.z; bias[7] = b.w; }
        u32x4 win[5];
        const u32x4 zero4 = {0u, 0u, 0u, 0u};
#pragma unroll
        for (int k = 0; k < 4; ++k) { const int r = r0 - 2 + k; win[k] = (r >= L0 && r < L1) ? *(const u32x4*)(XR + (size_t)r * 2048 + cg8) : zero4; }
        for (int t = 0; t < SEGL; ++t) {
            const int r = r0 + t + 2; win[4] = (r >= L0 && r < L1) ? *(const u32x4*)(XR + (size_t)r * 2048 + cg8) : zero4;
            float o[8];
#pragma unroll
            for (int e = 0; e < 8; ++e) o[e] = bias[e];
#pragma unroll
            for (int k = 0; k < 5; ++k) {
                o[0] += w[k][0] * bflo(win[k].x); o[1] += w[k][1] * bfhi(win[k].x); o[2] += w[k][2] * bflo(win[k].y); o[3] += w[k][3] * bfhi(win[k].y);
                o[4] += w[k][4] * bflo(win[k].z); o[5] += w[k][5] * bfhi(win[k].z); o[6] += w[k][6] * bflo(win[k].w); o[7] += w[k][7] * bfhi(win[k].w); }
            u32x4 pk; pk.x = pk2(siluf(o[0]), siluf(o[1])); pk.y = pk2(siluf(o[2]), siluf(o[3])); pk.z = pk2(siluf(o[4]), siluf(o[5])); pk.w = pk2(siluf(o[6]), siluf(o[7]));
            *(u32x4*)(XC + (size_t)(r0 + t) * 2048 + cg8) = pk;
            win[0] = win[1]; win[1] = win[2]; win[2] = win[3]; win[3] = win[4];
        }
    }
}

constexpr int L_AQ = 0, L_AK = 17408, L_KET = 34816, L_VVT = 53248, L_SC = 62464, L_ST = 71680, L_SEG = 89088, L_DEC = 91136, L_CUM = 91648, L_DTV = 91904;
constexpr int PA = 272, PB = 144;

#define MFMA16(a, b, c) __builtin_amdgcn_mfma_f32_16x16x32_bf16((a), (b), (c), 0, 0, 0)

template <bool SSD>
__device__ __forceinline__ void scan_item(const Params& P, LAS unsigned char* lds, int pass, int it) {
    const int tid = opaque_tid(), lane = tid & 63, wave = __builtin_amdgcn_readfirstlane(tid >> 6);
    const int l15 = lane & 15, lq = lane >> 4;
    unsigned char* ws = P.ws;
    int bl, dir, head, vh = 0;
    if (!SSD) { bl = it >> 5; dir = (it >> 4) & 1; head = (it >> 1) & 7; vh = it & 1; }
    else { bl = it >> 5; dir = (it >> 4) & 1; head = it & 15; }
    const unsigned short *srcA, *srcB, *srcV; int ldA, ldB, ldV;
    if (!SSD) { srcA = (const unsigned short*)(ws + OFF_Q) + head * 128; ldA = 1024;
                srcB = (const unsigned short*)(ws + OFF_FR) + dir * 1024 + head * 128; ldB = 2048;
                srcV = (const unsigned short*)(ws + OFF_V) + head * 128 + vh * 64; ldV = 1024; }
    else { const int g = head >> 2;
           srcA = (const unsigned short*)(ws + OFF_XC) + 1536 + g * 128; ldA = 2048;
           srcB = (const unsigned short*)(ws + OFF_XC) + 1024 + g * 128; ldB = 2048;
           srcV = (const unsigned short*)(ws + OFF_XC) + head * 64; ldV = 2048; }
    const float* DT = (const float*)(ws + OFF_DT) + dir * 16 + head;
    unsigned short* Oout = SSD ? (unsigned short*)(ws + OFF_OS) + (size_t)dir * ML * 1024 + head * 64
                               : (unsigned short*)(ws + OFF_OH) + (size_t)dir * ML * 1024 + head * 128 + vh * 64;
    const int f = tid & 127, seg = tid >> 7;
    const int pv = tid & 63, tseg = tid >> 6;
    float lb = 0.f, a_neg = 0.f;
    if (!SSD) lb = ((const float*)(ws + OFF_LB))[dir * 1024 + head * 128 + f];
    else a_neg = -__expf(P.a_log[dir * 16 + head]);

    f32x4 sacc[4];
#pragma unroll
    for (int t = 0; t < 4; ++t) sacc[t] = (f32x4){0.f, 0.f, 0.f, 0.f};

    unsigned short ra[16], rb[16], rv[8]; float rdt = 0.f;
    auto chunk_base = [&](int step) -> int {
        if (step < 4) { const int c = dir ? 3 - step : step; return ML + bl * CTX + c * 64; }
        const int c = dir ? 63 - (step - 4) : step - 4; return bl * SEQ + c * 64; };
    auto load_chunk = [&](int step) {
        const int base = chunk_base(step);
#pragma unroll
        for (int ii = 0; ii < 16; ++ii) { const int i = seg * 16 + ii; const int row = base + (dir ? 63 - i : i);
            ra[ii] = srcA[(size_t)row * ldA + f]; rb[ii] = srcB[(size_t)row * ldB + f]; }
#pragma unroll
        for (int ii = 0; ii < 8; ++ii) { const int i = tseg * 8 + ii; const int row = base + (dir ? 63 - i : i); rv[ii] = srcV[(size_t)row * ldV + pv]; }
        if (SSD && wave == 0) { const int row = base + (dir ? 63 - lane : lane); rdt = DT[(size_t)row * 32]; }
    };
    load_chunk(0);

    LAS float* SEGs = (LAS float*)(lds + L_SEG); LAS float* DEC = (LAS float*)(lds + L_DEC); LAS float* CUM = (LAS float*)(lds + L_CUM); LAS float* DTV = (LAS float*)(lds + L_DTV);

    for (int step = 0; step < 68; ++step) {
        const bool isctx = step < 4;
        const int base = chunk_base(step);
        float cumv[16], kk[16], qq[16];
        if (!SSD) {
            float run = 0.f;
#pragma unroll
            for (int ii = 0; ii < 16; ++ii) {
                const float fr = fminf(fmaxf((float)__builtin_bit_cast(f16, rb[ii]), -30.f), 30.f);
                const float e = __expf(-fr); const float s = 1.0f / (1.0f + e);
                const float fg = lb + (1.0f - lb) * s;
                kk[ii] = (1.0f - lb) * (e * s);
                run += __logf(fg); cumv[ii] = run; qq[ii] = bf2f(ra[ii]);
            }
            SEGs[seg * 128 + f] = run;
        } else {
            if (wave == 0) {
                float c = rdt * a_neg;
#pragma unroll
                for (int o = 1; o < 64; o <<= 1) { const float t = __shfl_up(c, o); if (lane >= o) c += t; }
                CUM[lane] = c; DTV[lane] = rdt;
            }
        }
        __syncthreads();
        if (!SSD) {
            float offs = 0.f, tot = 0.f;
#pragma unroll
            for (int s = 0; s < 4; ++s) { const float t = SEGs[s * 128 + f]; tot += t; if (s < seg) offs += t; }
            u32x4 ke[2]; unsigned kep[8];
#pragma unroll
            for (int ii = 0; ii < 16; ++ii) { const int i = seg * 16 + ii; const float cu = offs + cumv[ii];
                const float eq = __expf(cu), ek = __expf(-cu), ee = __expf(tot - cu);
                *(LAS unsigned short*)(lds + L_AQ + i * PA + f * 2) = f2bf(qq[ii] * eq);
                *(LAS unsigned short*)(lds + L_AK + i * PA + f * 2) = f2bf(kk[ii] * ek);
                kk[ii] = kk[ii] * ee; }
#pragma unroll
            for (int j = 0; j < 8; ++j) kep[j] = pk2(kk[2 * j], kk[2 * j + 1]);
            ke[0] = (u32x4){kep[0], kep[1], kep[2], kep[3]}; ke[1] = (u32x4){kep[4], kep[5], kep[6], kep[7]};
            *(LAS u32x4*)(lds + L_KET + f * PB + seg * 32) = ke[0]; *(LAS u32x4*)(lds + L_KET + f * PB + seg * 32 + 16) = ke[1];
            if (seg == 0) DEC[f] = __expf(tot);
            unsigned vp[4];
#pragma unroll
            for (int j = 0; j < 4; ++j) vp[j] = (unsigned)rv[2 * j] | ((unsigned)rv[2 * j + 1] << 16);
            *(LAS u32x4*)(lds + L_VVT + pv * PB + tseg * 16) = (u32x4){vp[0], vp[1], vp[2], vp[3]};
        } else {
            const float tot = CUM[63];
            unsigned kep[8]; float kv[16];
#pragma unroll
            for (int ii = 0; ii < 16; ++ii) { const int i = seg * 16 + ii; const float ee = __expf(tot - CUM[i]);
                *(LAS unsigned short*)(lds + L_AQ + i * PA + f * 2) = ra[ii];
                *(LAS unsigned short*)(lds + L_AK + i * PA + f * 2) = rb[ii];
                kv[ii] = bf2f(rb[ii]) * ee; }
#pragma unroll
            for (int j = 0; j < 8; ++j) kep[j] = pk2(kv[2 * j], kv[2 * j + 1]);
            *(LAS u32x4*)(lds + L_KET + f * PB + seg * 32) = (u32x4){kep[0], kep[1], kep[2], kep[3]};
            *(LAS u32x4*)(lds + L_KET + f * PB + seg * 32 + 16) = (u32x4){kep[4], kep[5], kep[6], kep[7]};
            if (seg == 0) DEC[f] = __expf(tot);
            unsigned vp[4];
#pragma unroll
            for (int j = 0; j < 4; ++j) { const int i = tseg * 8 + 2 * j; vp[j] = pk2(bf2f(rv[2 * j]) * DTV[i], bf2f(rv[2 * j + 1]) * DTV[i + 1]); }
            *(LAS u32x4*)(lds + L_VVT + pv * PB + tseg * 16) = (u32x4){vp[0], vp[1], vp[2], vp[3]};
        }
        if (step + 1 < 68) load_chunk(step + 1);
        __syncthreads();
        if (!isctx) {
            const int ti = wave >> 1, t0 = (wave & 1) * 2;
            bf16x8 bq[4];
#pragma unroll
            for (int k = 0; k < 4; ++k) bq[k] = *(const LAS bf16x8*)(lds + L_AQ + (ti * 16 + l15) * PA + k * 64 + lq * 16);
#pragma unroll
            for (int tt = 0; tt < 2; ++tt) { const int tj = t0 + tt; const int i = ti * 16 + l15, j0 = tj * 16 + lq * 4;
                u32x2 w = {0u, 0u};
                if (tj <= ti) {
                    f32x4 a = {0.f, 0.f, 0.f, 0.f};
#pragma unroll
                    for (int k = 0; k < 4; ++k) { const bf16x8 ak = *(const LAS bf16x8*)(lds + L_AK + (tj * 16 + l15) * PA + k * 64 + lq * 16); a = MFMA16(ak, bq[k], a); }
                    float ci = 0.f; if (SSD) ci = CUM[i];
#pragma unroll
                    for (int jj = 0; jj < 4; ++jj) { const int j = j0 + jj; float v = a[jj];
                        if (SSD) v *= __expf(fminf(ci - CUM[j], 0.f));
                        a[jj] = (j <= i) ? v : 0.f; }
                    w.x = pk2(a[0], a[1]); w.y = pk2(a[2], a[3]);
                }
                *(LAS u32x2*)(lds + L_SC + i * PB + j0 * 2) = w; }
            __syncthreads();
            bf16x8 bs[2];
#pragma unroll
            for (int k = 0; k < 2; ++k) bs[k] = *(const LAS bf16x8*)(lds + L_SC + (ti * 16 + l15) * PB + k * 64 + lq * 16);
            const int i = ti * 16 + l15; const int row = base + (dir ? 63 - i : i);
            float rs = 1.0f; if (SSD) rs = __expf(CUM[i]);
#pragma unroll
            for (int tt = 0; tt < 2; ++tt) { const int tv = t0 + tt;
                f32x4 a1 = {0.f, 0.f, 0.f, 0.f}, a2 = {0.f, 0.f, 0.f, 0.f};
#pragma unroll
                for (int k = 0; k < 2; ++k) { const bf16x8 av = *(const LAS bf16x8*)(lds + L_VVT + (tv * 16 + l15) * PB + k * 64 + lq * 16); a1 = MFMA16(av, bs[k], a1); }
#pragma unroll
                for (int k = 0; k < 4; ++k) { const bf16x8 as = *(const LAS bf16x8*)(lds + L_ST + (tv * 16 + l15) * PA + k * 64 + lq * 16); a2 = MFMA16(as, bq[k], a2); }
                const f32x4 o = a1 + a2 * rs;
                u32x2 w; w.x = pk2(o[0], o[1]); w.y = pk2(o[2], o[3]);
                *(u32x2*)(Oout + (size_t)row * 1024 + tv * 16 + lq * 4) = w; }
        }
        __syncthreads();
        {
            const f32x4 dv = *(const LAS f32x4*)(lds + L_DEC + (wave * 16 + lq * 4) * 4);
            bf16x8 ak[2];
#pragma unroll
            for (int k = 0; k < 2; ++k) ak[k] = *(const LAS bf16x8*)(lds + L_KET + (wave * 16 + l15) * PB + k * 64 + lq * 16);
#pragma unroll
            for (int tv = 0; tv < 4; ++tv) { f32x4 s = sacc[tv] * dv;
#pragma unroll
                for (int k = 0; k < 2; ++k) { const bf16x8 bv = *(const LAS bf16x8*)(lds + L_VVT + (tv * 16 + l15) * PB + k * 64 + lq * 16); s = MFMA16(ak[k], bv, s); }
                sacc[tv] = s;
                u32x2 w; w.x = pk2(s[0], s[1]); w.y = pk2(s[2], s[3]);
                *(LAS u32x2*)(lds + L_ST + (tv * 16 + l15) * PA + (wave * 16 + lq * 4) * 2) = w; }
        }
    }
    __syncthreads();
}

__device__ __forceinline__ void phase_scan(const Params& P, LAS unsigned char* lds, int pass) {
    for (int it = blockIdx.x; it < 256; it += gridDim.x) {
        if (it < 128) scan_item<false>(P, lds, pass, it); else scan_item<true>(P, lds, pass, it - 128);
    }
}

__device__ __forceinline__ void unpack8(const u32x4 w, float (&o)[8]) { o[0] = bflo(w.x); o[1] = bfhi(w.x); o[2] = bflo(w.y); o[3] = bfhi(w.y); o[4] = bflo(w.z); o[5] = bfhi(w.z); o[6] = bflo(w.w); o[7] = bfhi(w.w); }
__device__ __forceinline__ void phase_readout(const Params& P) {
    const int tid_ = opaque_tid(); const int lane = tid_ & 63, wave = tid_ >> 6;
    unsigned char* ws = P.ws;
    const bf16_t* OH = (const bf16_t*)(ws + OFF_OH); const bf16_t* OS = (const bf16_t*)(ws + OFF_OS);
    const bf16_t* G = (const bf16_t*)(ws + OFF_G); const bf16_t* Z = (const bf16_t*)(ws + OFF_Z); const bf16_t* XC = (const bf16_t*)(ws + OFF_XC);
    bf16_t* A2 = (bf16_t*)(ws + OFF_A2);
    const int c0 = lane * 16;
    float hw[16], sw[16];
#pragma unroll
    for (int e = 0; e < 16; ++e) { hw[e] = P.hgrn_norm[(c0 + e) & 127]; sw[e] = P.ssd_norm[c0 + e]; }
    const float dsk = P.ssd_d[lane >> 2];
    for (int r = blockIdx.x * 8 + wave; r < ML; r += gridDim.x * 8) {
        float o[16], t[8];
        { const u32x4* p0 = (const u32x4*)(OH + (size_t)r * 1024 + c0); const u32x4* p1 = (const u32x4*)(OH + ((size_t)ML + r) * 1024 + c0); const u32x4* pg = (const u32x4*)(G + (size_t)r * 1024 + c0);
          const u32x4 a0 = p0[0], a1 = p0[1], b0 = p1[0], b1 = p1[1], g0 = pg[0], g1 = pg[1];
          unpack8(a0, t);
#pragma unroll
          for (int e = 0; e < 8; ++e) o[e] = t[e];
          unpack8(a1, t);
#pragma unroll
          for (int e = 0; e < 8; ++e) o[8 + e] = t[e];
          unpack8(b0, t);
#pragma unroll
          for (int e = 0; e < 8; ++e) o[e] += t[e];
          unpack8(b1, t);
#pragma unroll
          for (int e = 0; e < 8; ++e) o[8 + e] += t[e];
          float ss = 0.f;
#pragma unroll
          for (int e = 0; e < 16; ++e) ss += o[e] * o[e];
          ss += __shfl_xor(ss, 1); ss += __shfl_xor(ss, 2); ss += __shfl_xor(ss, 4);
          const float rstd = rsqrtf(ss * (1.0f / 128.0f) + EPS);
          float gg[16]; unpack8(g0, t);
#pragma unroll
          for (int e = 0; e < 8; ++e) gg[e] = t[e];
          unpack8(g1, t);
#pragma unroll
          for (int e = 0; e < 8; ++e) gg[8 + e] = t[e];
#pragma unroll
          for (int e = 0; e < 16; ++e) o[e] = o[e] * rstd * hw[e] * gg[e];
          u32x4 w0, w1; w0.x = pk2(o[0], o[1]); w0.y = pk2(o[2], o[3]); w0.z = pk2(o[4], o[5]); w0.w = pk2(o[6], o[7]);
          w1.x = pk2(o[8], o[9]); w1.y = pk2(o[10], o[11]); w1.z = pk2(o[12], o[13]); w1.w = pk2(o[14], o[15]);
          u32x4* po = (u32x4*)(A2 + (size_t)r * 2048 + c0); po[0] = w0; po[1] = w1; }
        { const u32x4* p0 = (const u32x4*)(OS + (size_t)r * 1024 + c0); const u32x4* p1 = (const u32x4*)(OS + ((size_t)ML + r) * 1024 + c0);
          const u32x4* pz = (const u32x4*)(Z + (size_t)r * 1024 + c0); const u32x4* px = (const u32x4*)(XC + (size_t)r * 2048 + c0);
          const u32x4 a0 = p0[0], a1 = p0[1], b0 = p1[0], b1 = p1[1], z0 = pz[0], z1 = pz[1], x0 = px[0], x1 = px[1];
          unpack8(a0, t);
#pragma unroll
          for (int e = 0; e < 8; ++e) o[e] = t[e];
          unpack8(a1, t);
#pragma unroll
          for (int e = 0; e < 8; ++e) o[8 + e] = t[e];
          unpack8(b0, t);
#pragma unroll
          for (int e = 0; e < 8; ++e) o[e] += t[e];
          unpack8(b1, t);
#pragma unroll
          for (int e = 0; e < 8; ++e) o[8 + e] += t[e];
          unpack8(x0, t);
#pragma unroll
          for (int e = 0; e < 8; ++e) o[e] += dsk * t[e];
          unpack8(x1, t);
#pragma unroll
          for (int e = 0; e < 8; ++e) o[8 + e] += dsk * t[e];
          unpack8(z0, t);
#pragma unroll
          for (int e = 0; e < 8; ++e) o[e] *= t[e];
          unpack8(z1, t);
#pragma unroll
          for (int e = 0; e < 8; ++e) o[8 + e] *= t[e];
          float ss = 0.f;
#pragma unroll
          for (int e = 0; e < 16; ++e) ss += o[e] * o[e];
          ss += __shfl_xor(ss, 1); ss += __shfl_xor(ss, 2); ss += __shfl_xor(ss, 4); ss += __shfl_xor(ss, 8);
          const float rstd = rsqrtf(ss * (1.0f / 256.0f) + EPS);
#pragma unroll
          for (int e = 0; e < 16; ++e) o[e] = o[e] * rstd * sw[e];
          u32x4 w0, w1; w0.x = pk2(o[0], o[1]); w0.y = pk2(o[2], o[3]); w0.z = pk2(o[4], o[5]); w0.w = pk2(o[6], o[7]);
          w1.x = pk2(o[8], o[9]); w1.y = pk2(o[10], o[11]); w1.z = pk2(o[12], o[13]); w1.w = pk2(o[14], o[15]);
          u32x4* po = (u32x4*)(A2 + (size_t)r * 2048 + 1024 + c0); po[0] = w0; po[1] = w1; }
    }
}

__device__ __forceinline__ void grid_barrier(unsigned* ctr, unsigned target) {
    __builtin_amdgcn_fence(__ATOMIC_RELEASE, "agent");
    __syncthreads();
    if (threadIdx.x == 0) {
        __hip_atomic_fetch_add(ctr, 1u, __ATOMIC_RELAXED, __HIP_MEMORY_SCOPE_AGENT);
        while (__hip_atomic_load(ctr, __ATOMIC_RELAXED, __HIP_MEMORY_SCOPE_AGENT) < target) __builtin_amdgcn_s_sleep(2);
    }
    __syncthreads();
    __builtin_amdgcn_fence(__ATOMIC_ACQUIRE, "agent");
}
#ifndef MK_PH_LO
#define MK_PH_LO 0
#endif
__global__ void __launch_bounds__(NT, 2) fwd_megakernel(Params P, int ph_lo, int ph_hi) {
    extern __shared__ __attribute__((aligned(16))) unsigned char lds_raw[];
    LAS unsigned char* lds = (LAS unsigned char*)lds_raw;
    cg::grid_group grid = cg::this_grid();
    unsigned char* ws = P.ws;
    const float* mod = (const float*)(ws + OFF_MOD);
    int ph = 0; unsigned nbar = 0; unsigned* barw = (unsigned*)(ws + OFF_BAR);
#if defined(MK_OWN_BARRIER)
    grid.sync();
#endif
#ifndef MK_MASK
#define MK_MASK 0xffff
#endif
#define PHASE_BEGIN() (ph >= ph_lo && ph < ph_hi)
#if defined(MK_OWN_BARRIER)
#define PHASE_END() do { ++ph; if (ph > ph_lo && ph < ph_hi) { ++nbar; grid_barrier(barw, nbar * gridDim.x); } } while (0)
#else
#define PHASE_END() do { ++ph; if (ph > ph_lo && ph < ph_hi) grid.sync(); } while (0)
#endif
    if ((MK_MASK & 1) && PHASE_BEGIN()) phase_prep(P, lds);
    PHASE_END();
    for (int pass = 0; pass < NPASS; ++pass) {
        if ((MK_MASK & 2) && PHASE_BEGIN()) phase_norm<0>(P, pass);
        PHASE_END();
        if ((MK_MASK & 4) && PHASE_BEGIN()) {
            pg8::Gemm g{(const bf16_t*)(ws + OFF_U), (const bf16_t*)(ws + OFF_WIN), MP, NPAD, D}; pg8::StaticOrder S; S.init(MP, NPAD, gridDim.x, blockIdx.x);
            EpiIn E{ws, P.dt_bias};
            pg8::gemm_phase<EpiIn, pg8::StaticOrder>(lds, g, S, E, nullptr);
        }
        PHASE_END();
        if ((MK_MASK & 8) && PHASE_BEGIN()) phase_conv(P);
        PHASE_END();
        if ((MK_MASK & 16) && PHASE_BEGIN()) phase_scan(P, lds, pass);
        PHASE_END();
        if ((MK_MASK & 32) && PHASE_BEGIN()) phase_readout(P);
        PHASE_END();
        if ((MK_MASK & 64) && PHASE_BEGIN()) {
            pg8::Gemm g{(const bf16_t*)(ws + OFF_A2), (const bf16_t*)(ws + OFF_WOUT), ML, D, 2048}; pg8::StaticOrder S; S.init(ML, D, gridDim.x, blockIdx.x);
            EpiOut E{P.x, mod, (float*)(ws + OFF_H1), pass};
            pg8::gemm_phase<EpiOut, pg8::StaticOrder>(lds, g, S, E, nullptr);
        }
        PHASE_END();
        if ((MK_MASK & 128) && PHASE_BEGIN()) phase_norm<1>(P, pass);
        PHASE_END();
        if ((MK_MASK & 256) && PHASE_BEGIN()) {
            pg8::Gemm g{(const bf16_t*)(ws + OFF_U2), (const bf16_t*)(ws + OFF_WGU), ML, 2 * DFF, D}; pg8::StaticOrder S; S.init(ML, 2 * DFF, gridDim.x, blockIdx.x);
            EpiGU E{(bf16_t*)(ws + OFF_ACT)};
            pg8::gemm_phase<EpiGU, pg8::StaticOrder>(lds, g, S, E, nullptr);
        }
        PHASE_END();
        if ((MK_MASK & 512) && PHASE_BEGIN()) {
            pg8::Gemm g{(const bf16_t*)(ws + OFF_ACT), (const bf16_t*)(ws + OFF_WD), ML, D, DFF}; pg8::StaticOrder S; S.init(ML, D, gridDim.x, blockIdx.x);
            EpiDown E{(const float*)(ws + OFF_H1), mod, P.out, pass};
            pg8::gemm_phase<EpiDown, pg8::StaticOrder>(lds, g, S, E, nullptr);
        }
        PHASE_END();
        if ((MK_MASK & 1024) && PHASE_BEGIN()) phase_final_norm(P, pass);
        ++ph;
    }
}
}

extern "C" void kernel_launch(void* const* d_in, const int* in_sizes, int n_in, void* d_out, int out_size, void* d_ws, size_t ws_size, hipStream_t stream) {
    static int grid_blocks = 0;
    if (grid_blocks == 0) {
        if (n_in != 22 || ws_size < mk::WS_END) { fprintf(stderr, "kernel_launch: unexpected n_in %d or ws_size %zu (< %zu)\n", n_in, ws_size, (size_t)mk::WS_END); }
        int dev = 0, cus = 0, per_cu = 0;
        hipGetDevice(&dev);
        hipDeviceGetAttribute(&cus, hipDeviceAttributeMultiprocessorCount, dev);
        if (hipFuncSetAttribute((const void*)mk::fwd_megakernel, hipFuncAttributeMaxDynamicSharedMemorySize, mk::LDS_BYTES) != hipSuccess) fprintf(stderr, "kernel_launch: hipFuncSetAttribute failed\n");
        hipOccupancyMaxActiveBlocksPerMultiprocessor(&per_cu, (const void*)mk::fwd_megakernel, mk::NT, mk::LDS_BYTES);
        if (per_cu < 1) { fprintf(stderr, "kernel_launch: occupancy query returned %d\n", per_cu); per_cu = 1; }
        grid_blocks = cus * 1;
        (void)hipGetLastError();
    }
#ifdef MK_ZERO_WS
    (void)hipMemsetAsync((char*)d_ws + mk::OFF_Q, 0, mk::WS_END - mk::OFF_Q, stream);
#endif
    (void)hipMemsetAsync((char*)d_ws + mk::OFF_BAR, 0, 256, stream);
    mk::Params p{};
    const float** pp = (const float**)&p;
    for (int i = 0; i < 22; ++i) pp[i] = (const float*)d_in[i];
    p.out = (float*)d_out; p.ws = (unsigned char*)d_ws;
    int ph_lo = 0, ph_hi = 1000;
    void* args[] = {&p, &ph_lo, &ph_hi};
    hipError_t e = hipLaunchCooperativeKernel((const void*)mk::fwd_megakernel, dim3(grid_blocks), dim3(mk::NT), args, mk::LDS_BYTES, stream);
    if (e != hipSuccess) fprintf(stderr, "cooperative launch failed: %s (grid %d)\n", hipGetErrorString(e), grid_blocks);
}
```

```cpp
#include <hip/hip_runtime.h>
#include <hip/hip_cooperative_groups.h>
#include <cstdio>
namespace cg = cooperative_groups;
__device__ __forceinline__ int opaque_tid() { int t = threadIdx.x; asm volatile("" : "+v"(t)); return t; }
namespace pg8 {
#define PG8_LAS __attribute__((address_space(3)))
typedef unsigned short bf16_t;
typedef short bf16x8 __attribute__((ext_vector_type(8)));
typedef float f32x4 __attribute__((ext_vector_type(4)));
typedef unsigned u32x4 __attribute__((ext_vector_type(4)));
constexpr int BM = 256, BK = 64, HALF = 128, HTB = HALF * BK * 2  , STAGE_BYTES = 8 * HTB, NXCD = 8, WGM = 8;

__host__ __device__ __forceinline__ int lds_byte(int r, int c) { const int st = (r >> 4) * 2 + (c >> 5), rr = r & 15, cc = c & 31, ob = rr * 64 + cc * 2; return st * 1024 + (ob ^ (((ob >> 9) & 1) << 5)); }
__host__ __device__ __forceinline__ void stage_rc(int b, int& R, int& C) { const int st = b / 1024, sb = b % 1024, swz = sb ^ (((sb >> 9) & 1) << 5); R = (st >> 1) * 16 + swz / 64; C = (st & 1) * 32 + (swz % 64) / 2; }
__host__ __device__ __forceinline__ int perm32(int rho) { const int n = rho >> 4, i = rho & 15; return 8 * (i >> 2) + 4 * n + (i & 3); }

struct Unit { int pm, pn; };
struct Gemm { const bf16_t* A; const bf16_t* Bt; int M, N, K; };

struct StaticOrder {
    int nM, nN, nwg, G, c;
    __host__ __device__ void init(int M, int N, int G_, int c_) { nM = M / BM; nN = N / BM; nwg = nM * nN; G = G_; c = c_; }
    __host__ __device__ bool next(int i, Unit& u) const {
        const long L = (long)i * G + c; if (L >= nwg) return false;
        int wgid = (int)L; { const int q = nwg / NXCD, r = nwg % NXCD, xcd = wgid % NXCD, off = wgid / NXCD; wgid = (xcd < r ? xcd * (q + 1) : r * (q + 1) + (xcd - r) * q) + off; }
        const int nig = WGM * nN, gid = wgid / nig, fm = gid * WGM, gsz = (nM - fm) < WGM ? (nM - fm) : WGM;
        u.pm = fm + ((wgid % nig) % gsz); u.pn = (wgid % nig) / gsz; return true;
    }
    __device__ __forceinline__ void a_ready(const Unit&) const {}
    __device__ __forceinline__ void done(const Unit&) const {}
};
typedef __bf16 bf16v2_t __attribute__((ext_vector_type(2)));
typedef float f32v2_t __attribute__((ext_vector_type(2)));
__device__ __forceinline__ unsigned cvt_pk_bf16(float lo, float hi) { f32v2_t v = {lo, hi}; bf16v2_t r = __builtin_convertvector(v, bf16v2_t); return __builtin_bit_cast(unsigned, r); }
typedef float f32x2 __attribute__((ext_vector_type(2)));
template <class Epi, class Sched, bool STAMP = false>
__device__ __forceinline__ void gemm_phase(PG8_LAS unsigned char* lds, const Gemm g, const Sched& S, const Epi& E, unsigned long long* stamps) {
    const int tid = opaque_tid(), wid = __builtin_amdgcn_readfirstlane(tid >> 6), lane = tid & 63, wr = wid >> 2, wc = wid & 3, fr = lane & 15, fq = lane >> 4;
    const int K = g.K, nt = K / BK;
    int ts_lo = 0, ts_hi = 0, nts = 0; const unsigned long long rt_entry = STAMP ? (unsigned long long)wall_clock64() : 0ull;
#define PG8_STAMP() do { if (STAMP && wid == 0 && nts < 64) { const unsigned long long _c = (unsigned long long)clock64(); \
        ts_lo = (lane == nts) ? (int)(unsigned)_c : ts_lo; ts_hi = (lane == nts) ? (int)(unsigned)(_c >> 32) : ts_hi; ++nts; } } while (0)
    PG8_STAMP();
    unsigned voffA[2], voffB[2];
#pragma unroll
    for (int i = 0; i < 2; ++i) { int R, C; stage_rc(tid * 16 + i * 8192, R, C); const int Rb = Epi::PERM ? ((R & ~31) + perm32(R & 31)) : R;
        voffA[i] = (unsigned)(R * K + C) * 2u; voffB[i] = (unsigned)(Rb * K + C) * 2u; }
    const size_t kstep = (size_t)(BK * 2);
    const size_t hstep = (size_t)HALF * K * 2;
    const size_t tstep = 2 * hstep;
    const unsigned ldsw = (unsigned)wid * 1024u;
    const int aoff = lds_byte(wr * 64 + fr, fq * 8), boff = lds_byte(wc * 32 + fr, fq * 8);
#define PG8_SA(b, h) (((b) * 2 + (h)) * HTB)
#define PG8_SB(b, h) ((4 + (b) * 2 + (h)) * HTB)
#define PG8_STAGE(bufoff, gbase, voff) do { _Pragma("unroll") for (int _i = 0; _i < 2; ++_i) \
        __builtin_amdgcn_global_load_lds((const unsigned*)((const char*)(gbase) + (voff)[_i]), (PG8_LAS unsigned*)(lds + (bufoff) + ldsw + _i * 8192), 16, 0, 0); } while (0)
#define PG8_LDA(dst, b, h) do { _Pragma("unroll") for (int m = 0; m < 4; ++m) _Pragma("unroll") for (int k = 0; k < 2; ++k) dst[m][k] = *(const PG8_LAS bf16x8*)(lds + PG8_SA(b, h) + aoff + m * 2048 + k * 1024); } while (0)
#define PG8_LDB(dst, b, h) do { _Pragma("unroll") for (int n = 0; n < 2; ++n) _Pragma("unroll") for (int k = 0; k < 2; ++k) dst[n][k] = *(const PG8_LAS bf16x8*)(lds + PG8_SB(b, h) + boff + n * 2048 + k * 1024); } while (0)
#define PG8_MMA(ai, bj, At, Bt) do { __builtin_amdgcn_s_setprio(1); _Pragma("unroll") for (int m = 0; m < 4; ++m) _Pragma("unroll") for (int n = 0; n < 2; ++n) _Pragma("unroll") for (int k = 0; k < 2; ++k) \
        acc[ai][bj][m][n] = __builtin_amdgcn_mfma_f32_16x16x32_bf16(Bt[n][k], At[m][k], acc[ai][bj][m][n], 0, 0, 0); __builtin_amdgcn_s_setprio(0); } while (0)
#define PG8_WAIT_V(n) asm volatile("s_waitcnt vmcnt(" #n ")" ::: "memory")
#define PG8_WAIT_L(n) asm volatile("s_waitcnt lgkmcnt(" #n ")" ::: "memory")
#define PG8_BAR __builtin_amdgcn_s_barrier()
#define PG8_SCHED __builtin_amdgcn_sched_barrier(0)
    Unit cur, nxt; int ui = 0;
    if (!S.next(0, cur)) return;
    f32x4 acc[2][2][4][2];
#pragma unroll
    for (int a = 0; a < 2; ++a)
#pragma unroll
        for (int b = 0; b < 2; ++b)
#pragma unroll
            for (int m = 0; m < 4; ++m)
#pragma unroll
                for (int n = 0; n < 2; ++n) acc[a][b][m][n] = (f32x4){0.f, 0.f, 0.f, 0.f};
    bf16x8 At[4][2], B0[2][2], B1[2][2];
    const char* cA = (const char*)g.A + (size_t)cur.pm * tstep; const char* cB = (const char*)g.Bt + (size_t)cur.pn * tstep;
    S.a_ready(cur);
    PG8_STAGE(PG8_SB(0, 0), cB, voffB); PG8_STAGE(PG8_SA(0, 0), cA, voffA); PG8_STAGE(PG8_SB(0, 1), cB + hstep, voffB); PG8_STAGE(PG8_SA(0, 1), cA + hstep, voffA);
    if (wr == 1) PG8_BAR;
    PG8_WAIT_V(4); PG8_BAR;
    PG8_STAGE(PG8_SB(1, 0), cB + kstep, voffB); PG8_STAGE(PG8_SA(1, 0), cA + kstep, voffA); PG8_STAGE(PG8_SB(1, 1), cB + hstep + kstep, voffB);
    PG8_WAIT_V(6); PG8_BAR;
    PG8_STAMP();
    for (;;) {
        const bool has_next = S.next(ui + 1, nxt);
        const char* nA = has_next ? (const char*)g.A + (size_t)nxt.pm * tstep : cA; const char* nB = has_next ? (const char*)g.Bt + (size_t)nxt.pn * tstep : cB;
        for (int t = 0; t < nt; t += 2) {
            const bool last = (t == nt - 2);
            const char* a1 = cA + (size_t)(t + 1) * kstep;
            const char* a2 = last ? nA : cA + (size_t)(t + 2) * kstep; const char* b2 = last ? nB : cB + (size_t)(t + 2) * kstep;
            const char* a3 = a2 + kstep; const char* b3 = b2 + kstep;
            if (last && has_next) S.a_ready(nxt);
            PG8_LDB(B0, 0, 0); PG8_SCHED; PG8_LDA(At, 0, 0); PG8_STAGE(PG8_SA(1, 1), a1 + hstep, voffA);
            PG8_WAIT_L(8); PG8_BAR; PG8_WAIT_L(0); PG8_MMA(0, 0, At, B0); PG8_BAR; PG8_SCHED;
            PG8_LDB(B1, 0, 1); PG8_STAGE(PG8_SB(0, 0), b2, voffB);
            PG8_BAR; PG8_WAIT_L(0); PG8_MMA(0, 1, At, B1); PG8_BAR;
            PG8_LDA(At, 0, 1); PG8_STAGE(PG8_SA(0, 0), a2, voffA);
            PG8_BAR; PG8_WAIT_L(0); PG8_MMA(1, 0, At, B0); PG8_BAR; PG8_SCHED;
            PG8_STAGE(PG8_SB(0, 1), b2 + hstep, voffB);
            PG8_WAIT_V(6); PG8_BAR; PG8_MMA(1, 1, At, B1); PG8_BAR;
            PG8_LDB(B0, 1, 0); PG8_SCHED; PG8_LDA(At, 1, 0); PG8_STAGE(PG8_SA(0, 1), a2 + hstep, voffA);
            PG8_WAIT_L(8); PG8_BAR; PG8_WAIT_L(0); PG8_MMA(0, 0, At, B0); PG8_BAR; PG8_SCHED;
            PG8_LDB(B1, 1, 1); PG8_STAGE(PG8_SB(1, 0), b3, voffB);
            PG8_BAR; PG8_WAIT_L(0); PG8_MMA(0, 1, At, B1); PG8_BAR;
            PG8_LDA(At, 1, 1); PG8_STAGE(PG8_SA(1, 0), a3, voffA);
            PG8_BAR; PG8_WAIT_L(0); PG8_MMA(1, 0, At, B0); PG8_BAR; PG8_SCHED;
            PG8_STAGE(PG8_SB(1, 1), b3 + hstep, voffB);
            PG8_WAIT_V(6); PG8_BAR; PG8_MMA(1, 1, At, B1); PG8_BAR;
        }
        PG8_STAMP();
        if constexpr (!Epi::AFTER_DRAIN) { E(acc, cur, wr, wc, fr, fq); S.done(cur); }
        PG8_STAMP();
        if (!has_next) break;
#pragma unroll
        for (int a = 0; a < 2; ++a)
#pragma unroll
            for (int b = 0; b < 2; ++b)
#pragma unroll
                for (int m = 0; m < 4; ++m)
#pragma unroll
                    for (int n = 0; n < 2; ++n) acc[a][b][m][n] = (f32x4){0.f, 0.f, 0.f, 0.f};
        cur = nxt; cA = nA; cB = nB; ++ui;
    }
    PG8_WAIT_V(0);
    if (wr == 0) PG8_BAR;
    PG8_BAR;
    if constexpr (Epi::AFTER_DRAIN) { E.fused(acc, cur, wr, wc, fr, fq, lds, wid, lane); S.done(cur); }
    PG8_STAMP();
    if (STAMP && wid == 0) { stamps[lane] = lane < nts ? (((unsigned long long)(unsigned)ts_hi << 32) | (unsigned)ts_lo) : 0ull;
        if (lane == 62) stamps[62] = rt_entry; if (lane == 63) stamps[63] = (unsigned long long)wall_clock64(); }
#undef PG8_STAMP
#undef PG8_SA
#undef PG8_SB
#undef PG8_STAGE
#undef PG8_LDA
#undef PG8_LDB
#undef PG8_MMA
#undef PG8_WAIT_V
#undef PG8_WAIT_L
#undef PG8_BAR
#undef PG8_SCHED
}
}

namespace mk {
using pg8::bf16_t; using pg8::bf16x8; using pg8::f32x4; using pg8::u32x4; using pg8::Unit;
#define LAS __attribute__((address_space(3)))
typedef unsigned u32x2 __attribute__((ext_vector_type(2)));
typedef _Float16 f16;

constexpr int D = 1024, NB = 8, SEQ = 4096, CTX = 256, DIN = 8224, NPAD = 8448, DFF = 2816;
constexpr int BP = 4;
constexpr int NPASS = NB / BP;
constexpr int ML = BP * SEQ;
constexpr int MC = BP * CTX;
constexpr int MP = ML + MC;
constexpr float EPS = 1e-6f;
constexpr int NT = 512;
constexpr int LDS_BYTES = 131072 + 16;

constexpr size_t SZ_WIN = (size_t)NPAD * D * 2, SZ_WOUT = (size_t)D * 2048 * 2, SZ_WGU = (size_t)2 * DFF * D * 2, SZ_WD = (size_t)D * DFF * 2;
constexpr size_t OFF_WIN = 0, OFF_WOUT = OFF_WIN + SZ_WIN, OFF_WGU = OFF_WOUT + SZ_WOUT, OFF_WD = OFF_WGU + SZ_WGU;
constexpr size_t OFF_MOD = OFF_WD + SZ_WD;
constexpr size_t OFF_LB = OFF_MOD + 9 * 6144 * 4;
constexpr size_t OFF_BAR = OFF_LB + 2048 * 4;
constexpr size_t BAR_BYTES = 16384;
constexpr size_t OFF_Q = OFF_BAR + BAR_BYTES;
constexpr size_t OFF_FR = OFF_Q + (size_t)MP * 1024 * 2;
constexpr size_t OFF_V = OFF_FR + (size_t)MP * 2048 * 2;
constexpr size_t OFF_DT = OFF_V + (size_t)MP * 1024 * 2;
constexpr size_t OFF_G = OFF_DT + (size_t)MP * 32 * 4;
constexpr size_t OFF_Z = OFF_G + (size_t)ML * 1024 * 2;
constexpr size_t OFF_XC = OFF_Z + (size_t)ML * 1024 * 2;
constexpr size_t OFF_X1 = OFF_XC + (size_t)MP * 2048 * 2;
constexpr size_t OFF_U = OFF_X1;
constexpr size_t OFF_XR = OFF_X1 + (size_t)MP * 1024 * 2;
constexpr size_t OFF_OH = OFF_X1;
constexpr size_t OFF_OS = OFF_X1 + (size_t)2 * ML * 1024 * 2;
constexpr size_t WS_END = OFF_X1 + (size_t)4 * ML * 1024 * 2;
constexpr size_t OFF_A2 = OFF_Q;
constexpr size_t OFF_H1 = OFF_X1;
constexpr size_t OFF_U2 = OFF_V;
constexpr size_t OFF_ACT = OFF_G;
static_assert((size_t)ML * 2048 * 2 <= (size_t)MP * 1024 * 2 + (size_t)MP * 2048 * 2, "A2 overlay");
static_assert((size_t)ML * DFF * 2 <= (size_t)2 * ML * 1024 * 2 + (size_t)MP * 2048 * 2, "ACT overlay");
static_assert((size_t)MP * 1024 * 2 + (size_t)MP * 2048 * 2 <= (size_t)4 * ML * 1024 * 2, "U+XR in X1");

struct Params {
    const float *x, *c, *ctx, *c_ctx, *w_ada, *b_ada, *norm_mix, *w_in, *conv_w, *conv_b, *a_log, *dt_bias, *ssd_d, *ssd_norm,
                *lb_raw, *hgrn_norm, *w_out, *norm_ffn, *w_gate, *w_up, *w_down, *final_norm;
    float* out; unsigned char* ws;
};

__device__ __forceinline__ float bf2f(unsigned short b) { return __uint_as_float(((unsigned)b) << 16); }
__device__ __forceinline__ float bflo(unsigned w) { return __uint_as_float(w << 16); }
__device__ __forceinline__ float bfhi(unsigned w) { return __uint_as_float(w & 0xffff0000u); }
__device__ __forceinline__ unsigned pk2(float lo, float hi) { return pg8::cvt_pk_bf16(lo, hi); }
__device__ __forceinline__ unsigned short f2bf(float f) { return (unsigned short)(pk2(f, 0.f) & 0xffffu); }
__device__ __forceinline__ float siluf(float v) { return v / (1.0f + __expf(-v)); }
__device__ __forceinline__ float wave_sum(float v) {
#pragma unroll
    for (int o = 1; o < 64; o <<= 1) v += __shfl_xor(v, o);
    return v;
}

__device__ __forceinline__ void p0_transpose_item(const float* W, int K, int N, bf16_t* WT, int k0, int n0, int drow0, LAS float* scr, int lane) {
#pragma unroll 8
    for (int i = 0; i < 32; ++i) { const int kk = 2 * i + (lane >> 5); scr[kk * 33 + (lane & 31)] = W[(size_t)(k0 + kk) * N + n0 + (lane & 31)]; }
    asm volatile("s_waitcnt vmcnt(0) lgkmcnt(0)" ::: "memory");
    const int c = lane & 7;
#pragma unroll
    for (int j = 0; j < 4; ++j) { const int n = (lane >> 3) + 8 * j; const LAS float* s = scr + (8 * c) * 33 + n;
        u32x4 o; o.x = pk2(s[0 * 33], s[1 * 33]); o.y = pk2(s[2 * 33], s[3 * 33]); o.z = pk2(s[4 * 33], s[5 * 33]); o.w = pk2(s[6 * 33], s[7 * 33]);
        *(u32x4*)(WT + (size_t)(drow0 + n) * K + k0 + 8 * c) = o; }
    asm volatile("s_waitcnt lgkmcnt(0)" ::: "memory");
}

__device__ __forceinline__ void phase_prep(const Params& P, LAS unsigned char* lds) {
    const int tid = opaque_tid(), lane = tid & 63, wave = tid >> 6;
    unsigned char* ws = P.ws;
    float* mod = (float*)(ws + OFF_MOD);
    for (int item = blockIdx.x; item < 96; item += gridDim.x) {
        const int col = item * 64 + lane;
        float acc[9];
#pragma unroll
        for (int r = 0; r < 9; ++r) acc[r] = 0.f;
        for (int kk = 0; kk < 128; ++kk) {
            const int k = wave * 128 + kk;
            const float wv = P.w_ada[(size_t)k * 6144 + col];
#pragma unroll
            for (int r = 0; r < 9; ++r) { const float cv = (r < 8) ? P.c[r * 1024 + k] : P.c_ctx[k]; acc[r] += siluf(cv) * wv; }
        }
        LAS float* red = (LAS float*)lds;
#pragma unroll
        for (int r = 0; r < 9; ++r) red[(wave * 9 + r) * 64 + lane] = acc[r];
        __syncthreads();
        for (int e = tid; e < 9 * 64; e += NT) { const int r = e >> 6, l = e & 63; float s = 0.f;
#pragma unroll
            for (int w = 0; w < 8; ++w) s += red[(w * 9 + r) * 64 + l];
            mod[r * 6144 + item * 64 + l] = s + P.b_ada[item * 64 + l]; }
        __syncthreads();
    }
    float* lbv = (float*)(ws + OFF_LB);
    for (int j = blockIdx.x * NT + tid; j < 2048; j += gridDim.x * NT) { const float r0 = P.lb_raw[j], r1 = P.lb_raw[2048 + j]; lbv[j] = 1.0f / (1.0f + __expf(r1 - r0)); }
    { u32x4* z = (u32x4*)(ws + OFF_WIN + (size_t)DIN * D * 2); const int n16 = (NPAD - DIN) * D * 2 / 16;
      for (int j = blockIdx.x * NT + tid; j < n16; j += gridDim.x * NT) z[j] = (u32x4){0u, 0u, 0u, 0u}; }
    LAS float* scr = (LAS float*)(lds + 32768 + wave * 8704);
    bf16_t* WinT = (bf16_t*)(ws + OFF_WIN); bf16_t* WoutT = (bf16_t*)(ws + OFF_WOUT); bf16_t* WguT = (bf16_t*)(ws + OFF_WGU); bf16_t* WdT = (bf16_t*)(ws + OFF_WD);
    constexpr int I_IN = (D / 64) * (DIN / 32), I_OUT = (2048 / 64) * (D / 32), I_G = (D / 64) * (DFF / 32), I_D = (DFF / 64) * (D / 32);
    constexpr int NITEMS = I_IN + I_OUT + 2 * I_G + I_D;
    const int gw = blockIdx.x * 8 + wave, NGW = gridDim.x * 8;
    for (int it = gw; it < NITEMS; it += NGW) {
        int r = it;
        if (r < I_IN) { const int nblk = DIN / 32, kb = r / nblk, nb = r % nblk; p0_transpose_item(P.w_in, D, DIN, WinT, 64 * kb, 32 * nb, 32 * nb, scr, lane); continue; } r -= I_IN;
        if (r < I_OUT) { const int nblk = D / 32, kb = r / nblk, nb = r % nblk; p0_transpose_item(P.w_out, 2048, D, WoutT, 64 * kb, 32 * nb, 32 * nb, scr, lane); continue; } r -= I_OUT;
        if (r < I_G) { const int nblk = DFF / 32, kb = r / nblk, nb = r % nblk, n0 = 32 * nb; p0_transpose_item(P.w_gate, D, DFF, WguT, 64 * kb, n0, (n0 >> 7) * 256 + (n0 & 127), scr, lane); continue; } r -= I_G;
        if (r < I_G) { const int nblk = DFF / 32, kb = r / nblk, nb = r % nblk, n0 = 32 * nb; p0_transpose_item(P.w_up, D, DFF, WguT, 64 * kb, n0, (n0 >> 7) * 256 + 128 + (n0 & 127), scr, lane); continue; } r -= I_G;
        { const int nblk = D / 32, kb = r / nblk, nb = r % nblk; p0_transpose_item(P.w_down, DFF, D, WdT, 64 * kb, 32 * nb, 32 * nb, scr, lane); }
    }
}

template <int MODE>
__device__ __forceinline__ void phase_norm(const Params& P, int pass) {
    const int tid_ = opaque_tid(); const int lane = tid_ & 63, wave = tid_ >> 6;
    const float* mod = (const float*)(P.ws + OFF_MOD);
    const int nrows = MODE == 0 ? MP : ML;
    bf16_t* outp = (bf16_t*)(P.ws + (MODE == 0 ? OFF_U : OFF_U2));
    const float* nw = MODE == 0 ? P.norm_mix : P.norm_ffn;
    for (int r = blockIdx.x * 8 + wave; r < nrows; r += gridDim.x * 8) {
        const float* src; int mrow;
        if (MODE == 0) {
            if (r < ML) { src = P.x + ((size_t)pass * ML + r) * D; mrow = pass * BP + (r >> 12); }
            else { const int rc = r - ML; src = P.ctx + ((size_t)pass * MC + rc) * D; mrow = 8; }
        } else { src = (const float*)(P.ws + OFF_H1) + (size_t)r * D; mrow = pass * BP + (r >> 12); }
        const float* sh = mod + mrow * 6144 + (MODE == 0 ? 0 : 3072); const float* sc = sh + 1024;
        f32x4 v[4]; float ss = 0.f;
#pragma unroll
        for (int j = 0; j < 4; ++j) { v[j] = *(const f32x4*)(src + 256 * j + 4 * lane); ss += (v[j].x * v[j].x + v[j].y * v[j].y) + (v[j].z * v[j].z + v[j].w * v[j].w); }
        const float rstd = rsqrtf(wave_sum(ss) * (1.0f / D) + EPS);
#pragma unroll
        for (int j = 0; j < 4; ++j) { const int c0 = 256 * j + 4 * lane;
            const f32x4 w = *(const f32x4*)(nw + c0), s1 = *(const f32x4*)(sc + c0), s0 = *(const f32x4*)(sh + c0);
            const f32x4 o = (v[j] * rstd * w) * (1.0f + s1) + s0;
            u32x2 pk; pk.x = pk2(o.x, o.y); pk.y = pk2(o.z, o.w);
            *(u32x2*)(outp + (size_t)r * D + c0) = pk; }
    }
}

__device__ __forceinline__ void phase_final_norm(const Params& P, int pass) {
    const int tid_ = opaque_tid(); const int lane = tid_ & 63, wave = tid_ >> 6;
    for (int r = blockIdx.x * 8 + wave; r < ML; r += gridDim.x * 8) {
        float* row = P.out + ((size_t)pass * ML + r) * D;
        f32x4 v[4]; float ss = 0.f;
#pragma unroll
        for (int j = 0; j < 4; ++j) { v[j] = *(const f32x4*)(row + 256 * j + 4 * lane); ss += (v[j].x * v[j].x + v[j].y * v[j].y) + (v[j].z * v[j].z + v[j].w * v[j].w); }
        const float rstd = rsqrtf(wave_sum(ss) * (1.0f / D) + EPS);
#pragma unroll
        for (int j = 0; j < 4; ++j) { const int c0 = 256 * j + 4 * lane; const f32x4 w = *(const f32x4*)(P.final_norm + c0);
            *(f32x4*)(row + c0) = v[j] * rstd * w; }
    }
}

struct EpiIn {
    static constexpr bool PERM = true, AFTER_DRAIN = false;
    unsigned char* ws; const float* dt_bias;
    __device__ __forceinline__ void operator()(const f32x4 (&acc)[2][2][4][2], const Unit& u, int wr, int wc, int fr, int fq) const {
        const int pn = u.pn; const bool lat = u.pm < (ML / 256);
        int kind, ld, cofs; size_t off;
        float scale = 1.0f;
        if (pn < 4) { kind = lat ? 0 : 4; off = OFF_Q; ld = 1024; cofs = 0; scale = 0.08838834764831845f; }
        else if (pn < 12) { kind = 2; off = OFF_FR; ld = 2048; cofs = 1024; }
        else if (pn < 16) { kind = 1; off = OFF_V; ld = 1024; cofs = 3072; }
        else if (pn < 20) { kind = lat ? 0 : 4; off = OFF_G; ld = 1024; cofs = 4096; }
        else if (pn < 24) { kind = lat ? 0 : 4; off = OFF_Z; ld = 1024; cofs = 5120; }
        else if (pn < 32) { kind = 1; off = OFF_XR; ld = 2048; cofs = 6144; }
        else { kind = 3; off = OFF_DT; ld = 32; cofs = 8192; }
        if (kind == 4) return;
        const int row0 = u.pm * 256 + wr * 64 + fr;
        if (kind == 3) {
            if (wc != 0) return;
            float* DT = (float*)(ws + off);
            const f32x4 b0 = *(const f32x4*)(dt_bias + 8 * fq), b1 = *(const f32x4*)(dt_bias + 8 * fq + 4);
#pragma unroll
            for (int ai = 0; ai < 2; ++ai)
#pragma unroll
                for (int m = 0; m < 4; ++m) { const int row = row0 + ai * 128 + m * 16;
                    f32x4 v0 = acc[ai][0][m][0] + b0, v1 = acc[ai][0][m][1] + b1;
#pragma unroll
                    for (int j = 0; j < 4; ++j) { v0[j] = v0[j] > 20.f ? v0[j] : log1pf(__expf(v0[j])); v1[j] = v1[j] > 20.f ? v1[j] : log1pf(__expf(v1[j])); }
                    *(f32x4*)(DT + (size_t)row * 32 + 8 * fq) = v0; *(f32x4*)(DT + (size_t)row * 32 + 8 * fq + 4) = v1; }
            return;
        }
        unsigned short* O = (unsigned short*)(ws + off);
        const int col0 = pn * 256 - cofs + wc * 32 + 8 * fq;
#pragma unroll
        for (int ai = 0; ai < 2; ++ai)
#pragma unroll
            for (int m = 0; m < 4; ++m) { unsigned short* rowp = O + (size_t)(row0 + ai * 128 + m * 16) * ld + col0;
#pragma unroll
                for (int bj = 0; bj < 2; ++bj) { f32x4 v0 = acc[ai][bj][m][0], v1 = acc[ai][bj][m][1]; u32x4 w;
                    if (kind == 0) {
#pragma unroll
                        for (int j = 0; j < 4; ++j) { v0[j] = siluf(v0[j]) * scale; v1[j] = siluf(v1[j]) * scale; } }
                    if (kind == 2) {
                        typedef f16 h2 __attribute__((ext_vector_type(2)));
                        h2 a = {(f16)v0[0], (f16)v0[1]}, b = {(f16)v0[2], (f16)v0[3]}, c = {(f16)v1[0], (f16)v1[1]}, d = {(f16)v1[2], (f16)v1[3]};
                        w.x = __builtin_bit_cast(unsigned, a); w.y = __builtin_bit_cast(unsigned, b); w.z = __builtin_bit_cast(unsigned, c); w.w = __builtin_bit_cast(unsigned, d);
                    } else { w.x = pk2(v0[0], v0[1]); w.y = pk2(v0[2], v0[3]); w.z = pk2(v1[0], v1[1]); w.w = pk2(v1[2], v1[3]); }
                    *(u32x4*)(rowp + bj * 128) = w; } }
    }
};
struct EpiOut {
    static constexpr bool PERM = false, AFTER_DRAIN = false;
    const float* x; const float* mod; float* H1; int pass;
    __device__ __forceinline__ void operator()(const f32x4 (&acc)[2][2][4][2], const Unit& u, int wr, int wc, int fr, int fq) const {
        const int row0 = u.pm * 256 + wr * 64 + fr, col0 = u.pn * 256 + wc * 32 + 4 * fq;
        const float* g1 = mod + (size_t)(pass * BP + (u.pm >> 4)) * 6144 + 2048;
        f32x4 gv[2][2];
#pragma unroll
        for (int bj = 0; bj < 2; ++bj)
#pragma unroll
            for (int n = 0; n < 2; ++n) gv[bj][n] = *(const f32x4*)(g1 + col0 + bj * 128 + n * 16);
#pragma unroll
        for (int ai = 0; ai < 2; ++ai)
#pragma unroll
            for (int m = 0; m < 4; ++m) { const int row = row0 + ai * 128 + m * 16; const float* xr = x + ((size_t)pass * ML + row) * D + col0; float* hr = H1 + (size_t)row * D + col0;
#pragma unroll
                for (int bj = 0; bj < 2; ++bj)
#pragma unroll
                    for (int n = 0; n < 2; ++n) *(f32x4*)(hr + bj * 128 + n * 16) = *(const f32x4*)(xr + bj * 128 + n * 16) + gv[bj][n] * acc[ai][bj][m][n]; }
    }
};
struct EpiGU {
    static constexpr bool PERM = true, AFTER_DRAIN = false;
    bf16_t* ACT;
    __device__ __forceinline__ void operator()(const f32x4 (&acc)[2][2][4][2], const Unit& u, int wr, int wc, int fr, int fq) const {
        const int row0 = u.pm * 256 + wr * 64 + fr, col0 = u.pn * 128 + wc * 32 + 8 * fq;
#pragma unroll
        for (int ai = 0; ai < 2; ++ai)
#pragma unroll
            for (int m = 0; m < 4; ++m) { bf16_t* rowp = ACT + (size_t)(row0 + ai * 128 + m * 16) * DFF + col0;
                f32x4 g0 = acc[ai][0][m][0], g1 = acc[ai][0][m][1]; const f32x4 u0 = acc[ai][1][m][0], u1 = acc[ai][1][m][1];
#pragma unroll
                for (int j = 0; j < 4; ++j) { g0[j] = siluf(g0[j]) * u0[j]; g1[j] = siluf(g1[j]) * u1[j]; }
                u32x4 w; w.x = pk2(g0[0], g0[1]); w.y = pk2(g0[2], g0[3]); w.z = pk2(g1[0], g1[1]); w.w = pk2(g1[2], g1[3]);
                *(u32x4*)rowp = w; }
    }
};
struct EpiDown {
    static constexpr bool PERM = false, AFTER_DRAIN = false;
    const float* H1; const float* mod; float* out; int pass;
    __device__ __forceinline__ void operator()(const f32x4 (&acc)[2][2][4][2], const Unit& u, int wr, int wc, int fr, int fq) const {
        const int row0 = u.pm * 256 + wr * 64 + fr, col0 = u.pn * 256 + wc * 32 + 4 * fq;
        const float* g2 = mod + (size_t)(pass * BP + (u.pm >> 4)) * 6144 + 5120;
        f32x4 gv[2][2];
#pragma unroll
        for (int bj = 0; bj < 2; ++bj)
#pragma unroll
            for (int n = 0; n < 2; ++n) gv[bj][n] = *(const f32x4*)(g2 + col0 + bj * 128 + n * 16);
#pragma unroll
        for (int ai = 0; ai < 2; ++ai)
#pragma unroll
            for (int m = 0; m < 4; ++m) { const int row = row0 + ai * 128 + m * 16; const float* hr = H1 + (size_t)row * D + col0; float* orow = out + ((size_t)pass * ML + row) * D + col0;
#pragma unroll
                for (int bj = 0; bj < 2; ++bj)
#pragma unroll
                    for (int n = 0; n < 2; ++n) *(f32x4*)(orow + bj * 128 + n * 16) = *(const f32x4*)(hr + bj * 128 + n * 16) + gv[bj][n] * acc[ai][bj][m][n]; }
    }
};

__device__ __forceinline__ void phase_conv(const Params& P) {
    const bf16_t* XR = (const bf16_t*)(P.ws + OFF_XR); bf16_t* XC = (bf16_t*)(P.ws + OFF_XC);
    constexpr int SEGL = 32, NSEG = MP / SEGL, NITEM = NSEG * 256;
    for (int it = blockIdx.x * NT + opaque_tid(); it < NITEM; it += gridDim.x * NT) {
        const int seg = it >> 8, cg8 = (it & 255) * 8, r0 = seg * SEGL;
        int L0, L1;
        if (r0 < ML) { L0 = r0 & ~63; L1 = L0 + 64; } else { const int rc = r0 - ML; L0 = ML + (rc & ~255); L1 = L0 + 256; }
        float w[5][8], bias[8];
#pragma unroll
        for (int k = 0; k < 5; ++k) { const f32x4 a = *(const f32x4*)(P.conv_w + k * 2048 + cg8), b = *(const f32x4*)(P.conv_w + k * 2048 + cg8 + 4);
            w[k][0] = a.x; w[k][1] = a.y; w[k][2] = a.z; w[k][3] = a.w; w[k][4] = b.x; w[k][5] = b.y; w[k][6] = b.z; w[k][7] = b.w; }
        { const f32x4 a = *(const f32x4*)(P.conv_b + cg8), b = *(const f32x4*)(P.conv_b + cg8 + 4);
          bias[0] = a.x; bias[1] = a.y; bias[2] = a.z; bias[3] = a.w; bias[4] = b.x; bias[5] = b.y; bias[6] = b.z; bias[7] = b.w; }
        u32x4 win[5];
        const u32x4 zero4 = {0u, 0u, 0u, 0u};
#pragma unroll
        for (int k = 0; k < 4; ++k) { const int r = r0 - 2 + k; win[k] = (r >= L0 && r < L1) ? *(const u32x4*)(XR + (size_t)r * 2048 + cg8) : zero4; }
        for (int t = 0; t < SEGL; ++t) {
            const int r = r0 + t + 2; win[4] = (r >= L0 && r < L1) ? *(const u32x4*)(XR + (size_t)r * 2048 + cg8) : zero4;
            float o[8];
#pragma unroll
            for (int e = 0; e < 8; ++e) o[e] = bias[e];
#pragma unroll
            for (int k = 0; k < 5; ++k) {
                o[0] += w[k][0] * bflo(win[k].x); o[1] += w[k][1] * bfhi(win[k].x); o[2] += w[k][2] * bflo(win[k].y); o[3] += w[k][3] * bfhi(win[k].y);
                o[4] += w[k][4] * bflo(win[k].z); o[5] += w[k][5] * bfhi(win[k].z); o[6] += w[k][6] * bflo(win[k].w); o[7] += w[k][7] * bfhi(win[k].w); }
            u32x4 pk; pk.x = pk2(siluf(o[0]), siluf(o[1])); pk.y = pk2(siluf(o[2]), siluf(o[3])); pk.z = pk2(siluf(o[4]), siluf(o[5])); pk.w = pk2(siluf(o[6]), siluf(o[7]));
            *(u32x4*)(XC + (size_t)(r0 + t) * 2048 + cg8) = pk;
            win[0] = win[1]; win[1] = win[2]; win[2] = win[3]; win[3] = win[4];
        }
    }
}

constexpr int L_AQ = 0, L_AK = 17408, L_KET = 34816, L_VVT = 53248, L_SC = 62464, L_ST = 71680, L_SEG = 89088, L_DEC = 91136, L_CUM = 91648, L_DTV = 91904;
constexpr int PA = 272, PB = 144;

#define MFMA16(a, b, c) __builtin_amdgcn_mfma_f32_16x16x32_bf16((a), (b), (c), 0, 0, 0)

template <bool SSD>
__device__ __forceinline__ void scan_item(const Params& P, LAS unsigned char* lds, int pass, int it) {
    const int tid = opaque_tid(), lane = tid & 63, wave = __builtin_amdgcn_readfirstlane(tid >> 6);
    const int l15 = lane & 15, lq = lane >> 4;
    unsigned char* ws = P.ws;
    int bl, dir, head, vh = 0;
    if (!SSD) { bl = it >> 5; dir = (it >> 4) & 1; head = (it >> 1) & 7; vh = it & 1; }
    else { bl = it >> 5; dir = (it >> 4) & 1; head = it & 15; }
    const unsigned short *srcA, *srcB, *srcV; int ldA, ldB, ldV;
    if (!SSD) { srcA = (const unsigned short*)(ws + OFF_Q) + head * 128; ldA = 1024;
                srcB = (const unsigned short*)(ws + OFF_FR) + dir * 1024 + head * 128; ldB = 2048;
                srcV = (const unsigned short*)(ws + OFF_V) + head * 128 + vh * 64; ldV = 1024; }
    else { const int g = head >> 2;
           srcA = (const unsigned short*)(ws + OFF_XC) + 1536 + g * 128; ldA = 2048;
           srcB = (const unsigned short*)(ws + OFF_XC) + 1024 + g * 128; ldB = 2048;
           srcV = (const unsigned short*)(ws + OFF_XC) + head * 64; ldV = 2048; }
    const float* DT = (const float*)(ws + OFF_DT) + dir * 16 + head;
    unsigned short* Oout = SSD ? (unsigned short*)(ws + OFF_OS) + (size_t)dir * ML * 1024 + head * 64
                               : (unsigned short*)(ws + OFF_OH) + (size_t)dir * ML * 1024 + head * 128 + vh * 64;
    const int f = tid & 127, seg = tid >> 7;
    const int pv = tid & 63, tseg = tid >> 6;
    float lb = 0.f, a_neg = 0.f;
    if (!SSD) lb = ((const float*)(ws + OFF_LB))[dir * 1024 + head * 128 + f];
    else a_neg = -__expf(P.a_log[dir * 16 + head]);

    f32x4 sacc[4];
#pragma unroll
    for (int t = 0; t < 4; ++t) sacc[t] = (f32x4){0.f, 0.f, 0.f, 0.f};

    unsigned short ra[16], rb[16], rv[8]; float rdt = 0.f;
    auto chunk_base = [&](int step) -> int {
        if (step < 4) { const int c = dir ? 3 - step : step; return ML + bl * CTX + c * 64; }
        const int c = dir ? 63 - (step - 4) : step - 4; return bl * SEQ + c * 64; };
    auto load_chunk = [&](int step) {
        const int base = chunk_base(step);
#pragma unroll
        for (int ii = 0; ii < 16; ++ii) { const int i = seg * 16 + ii; const int row = base + (dir ? 63 - i : i);
            ra[ii] = srcA[(size_t)row * ldA + f]; rb[ii] = srcB[(size_t)row * ldB + f]; }
#pragma unroll
        for (int ii = 0; ii < 8; ++ii) { const int i = tseg * 8 + ii; const int row = base + (dir ? 63 - i : i); rv[ii] = srcV[(size_t)row * ldV + pv]; }
        if (SSD && wave == 0) { const int row = base + (dir ? 63 - lane : lane); rdt = DT[(size_t)row * 32]; }
    };
    load_chunk(0);

    LAS float* SEGs = (LAS float*)(lds + L_SEG); LAS float* DEC = (LAS float*)(lds + L_DEC); LAS float* CUM = (LAS float*)(lds + L_CUM); LAS float* DTV = (LAS float*)(lds + L_DTV);

    for (int step = 0; step < 68; ++step) {
        const bool isctx = step < 4;
        const int base = chunk_base(step);
        float cumv[16], kk[16], qq[16];
        if (!SSD) {
            float run = 0.f;
#pragma unroll
            for (int ii = 0; ii < 16; ++ii) {
                const float fr = fminf(fmaxf((float)__builtin_bit_cast(f16, rb[ii]), -30.f), 30.f);
                const float e = __expf(-fr); const float s = 1.0f / (1.0f + e);
                const float fg = lb + (1.0f - lb) * s;
                kk[ii] = (1.0f - lb) * (e * s);
                run += __logf(fg); cumv[ii] = run; qq[ii] = bf2f(ra[ii]);
            }
            SEGs[seg * 128 + f] = run;
        } else {
            if (wave == 0) {
                float c = rdt * a_neg;
#pragma unroll
                for (int o = 1; o < 64; o <<= 1) { const float t = __shfl_up(c, o); if (lane >= o) c += t; }
                CUM[lane] = c; DTV[lane] = rdt;
            }
        }
        __syncthreads();
        if (!SSD) {
            float offs = 0.f, tot = 0.f;
#pragma unroll
            for (int s = 0; s < 4; ++s) { const float t = SEGs[s * 128 + f]; tot += t; if (s < seg) offs += t; }
            u32x4 ke[2]; unsigned kep[8];
#pragma unroll
            for (int ii = 0; ii < 16; ++ii) { const int i = seg * 16 + ii; const float cu = offs + cumv[ii];
                const float eq = __expf(cu), ek = __expf(-cu), ee = __expf(tot - cu);
                *(LAS unsigned short*)(lds + L_AQ + i * PA + f * 2) = f2bf(qq[ii] * eq);
                *(LAS unsigned short*)(lds + L_AK + i * PA + f * 2) = f2bf(kk[ii] * ek);
                kk[ii] = kk[ii] * ee; }
#pragma unroll
            for (int j = 0; j < 8; ++j) kep[j] = pk2(kk[2 * j], kk[2 * j + 1]);
            ke[0] = (u32x4){kep[0], kep[1], kep[2], kep[3]}; ke[1] = (u32x4){kep[4], kep[5], kep[6], kep[7]};
            *(LAS u32x4*)(lds + L_KET + f * PB + seg * 32) = ke[0]; *(LAS u32x4*)(lds + L_KET + f * PB + seg * 32 + 16) = ke[1];
            if (seg == 0) DEC[f] = __expf(tot);
            unsigned vp[4];
#pragma unroll
            for (int j = 0; j < 4; ++j) vp[j] = (unsigned)rv[2 * j] | ((unsigned)rv[2 * j + 1] << 16);
            *(LAS u32x4*)(lds + L_VVT + pv * PB + tseg * 16) = (u32x4){vp[0], vp[1], vp[2], vp[3]};
        } else {
            const float tot = CUM[63];
            unsigned kep[8]; float kv[16];
#pragma unroll
            for (int ii = 0; ii < 16; ++ii) { const int i = seg * 16 + ii; const float ee = __expf(tot - CUM[i]);
                *(LAS unsigned short*)(lds + L_AQ + i * PA + f * 2) = ra[ii];
                *(LAS unsigned short*)(lds + L_AK + i * PA + f * 2) = rb[ii];
                kv[ii] = bf2f(rb[ii]) * ee; }
#pragma unroll
            for (int j = 0; j < 8; ++j) kep[j] = pk2(kv[2 * j], kv[2 * j + 1]);
            *(LAS u32x4*)(lds + L_KET + f * PB + seg * 32) = (u32x4){kep[0], kep[1], kep[2], kep[3]};
            *(LAS u32x4*)(lds + L_KET + f * PB + seg * 32 + 16) = (u32x4){kep[4], kep[5], kep[6], kep[7]};
            if (seg == 0) DEC[f] = __expf(tot);
            unsigned vp[4];
#pragma unroll
            for (int j = 0; j < 4; ++j) { const int i = tseg * 8 + 2 * j; vp[j] = pk2(bf2f(rv[2 * j]) * DTV[i], bf2f(rv[2 * j + 1]) * DTV[i + 1]); }
            *(LAS u32x4*)(lds + L_VVT + pv * PB + tseg * 16) = (u32x4){vp[0], vp[1], vp[2], vp[3]};
        }
        if (step + 1 < 68) load_chunk(step + 1);
        __syncthreads();
        if (!isctx) {
            const int ti = wave >> 1, t0 = (wave & 1) * 2;
            bf16x8 bq[4];
#pragma unroll
            for (int k = 0; k < 4; ++k) bq[k] = *(const LAS bf16x8*)(lds + L_AQ + (ti * 16 + l15) * PA + k * 64 + lq * 16);
#pragma unroll
            for (int tt = 0; tt < 2; ++tt) { const int tj = t0 + tt; const int i = ti * 16 + l15, j0 = tj * 16 + lq * 4;
                u32x2 w = {0u, 0u};
                if (tj <= ti) {
                    f32x4 a = {0.f, 0.f, 0.f, 0.f};
#pragma unroll
                    for (int k = 0; k < 4; ++k) { const bf16x8 ak = *(const LAS bf16x8*)(lds + L_AK + (tj * 16 + l15) * PA + k * 64 + lq * 16); a = MFMA16(ak, bq[k], a); }
                    float ci = 0.f; if (SSD) ci = CUM[i];
#pragma unroll
                    for (int jj = 0; jj < 4; ++jj) { const int j = j0 + jj; float v = a[jj];
                        if (SSD) v *= __expf(fminf(ci - CUM[j], 0.f));
                        a[jj] = (j <= i) ? v : 0.f; }
                    w.x = pk2(a[0], a[1]); w.y = pk2(a[2], a[3]);
                }
                *(LAS u32x2*)(lds + L_SC + i * PB + j0 * 2) = w; }
            __syncthreads();
            bf16x8 bs[2];
#pragma unroll
            for (int k = 0; k < 2; ++k) bs[k] = *(const LAS bf16x8*)(lds + L_SC + (ti * 16 + l15) * PB + k * 64 + lq * 16);
            const int i = ti * 16 + l15; const int row = base + (dir ? 63 - i : i);
            float rs = 1.0f; if (SSD) rs = __expf(CUM[i]);
#pragma unroll
            for (int tt = 0; tt < 2; ++tt) { const int tv = t0 + tt;
                f32x4 a1 = {0.f, 0.f, 0.f, 0.f}, a2 = {0.f, 0.f, 0.f, 0.f};
#pragma unroll
                for (int k = 0; k < 2; ++k) { const bf16x8 av = *(const LAS bf16x8*)(lds + L_VVT + (tv * 16 + l15) * PB + k * 64 + lq * 16); a1 = MFMA16(av, bs[k], a1); }
#pragma unroll
                for (int k = 0; k < 4; ++k) { const bf16x8 as = *(const LAS bf16x8*)(lds + L_ST + (tv * 16 + l15) * PA + k * 64 + lq * 16); a2 = MFMA16(as, bq[k], a2); }
                const f32x4 o = a1 + a2 * rs;
                u32x2 w; w.x = pk2(o[0], o[1]); w.y = pk2(o[2], o[3]);
                *(u32x2*)(Oout + (size_t)row * 1024 + tv * 16 + lq * 4) = w; }
        }
        __syncthreads();
        {
            const f32x4 dv = *(const LAS f32x4*)(lds + L_DEC + (wave * 16 + lq * 4) * 4);
            bf16x8 ak[2];
#pragma unroll
            for (int k = 0; k < 2; ++k) ak[k] = *(const LAS bf16x8*)(lds + L_KET + (wave * 16 + l15) * PB + k * 64 + lq * 16);
#pragma unroll
            for (int tv = 0; tv < 4; ++tv) { f32x4 s = sacc[tv] * dv;
#pragma unroll
                for (int k = 0; k < 2; ++k) { const bf16x8 bv = *(const LAS bf16x8*)(lds + L_VVT + (tv * 16 + l15) * PB + k * 64 + lq * 16); s = MFMA16(ak[k], bv, s); }
                sacc[tv] = s;
                u32x2 w; w.x = pk2(s[0], s[1]); w.y = pk2(s[2], s[3]);
                *(LAS u32x2*)(lds + L_ST + (tv * 16 + l15) * PA + (wave * 16 + lq * 4) * 2) = w; }
        }
    }
    __syncthreads();
}

__device__ __forceinline__ void phase_scan(const Params& P, LAS unsigned char* lds, int pass) {
    for (int it = blockIdx.x; it < 256; it += gridDim.x) {
        if (it < 128) scan_item<false>(P, lds, pass, it); else scan_item<true>(P, lds, pass, it - 128);
    }
}

__device__ __forceinline__ void unpack8(const u32x4 w, float (&o)[8]) { o[0] = bflo(w.x); o[1] = bfhi(w.x); o[2] = bflo(w.y); o[3] = bfhi(w.y); o[4] = bflo(w.z); o[5] = bfhi(w.z); o[6] = bflo(w.w); o[7] = bfhi(w.w); }
__device__ __forceinline__ void phase_readout(const Params& P) {
    const int tid_ = opaque_tid(); const int lane = tid_ & 63, wave = tid_ >> 6;
    unsigned char* ws = P.ws;
    const bf16_t* OH = (const bf16_t*)(ws + OFF_OH); const bf16_t* OS = (const bf16_t*)(ws + OFF_OS);
    const bf16_t* G = (const bf16_t*)(ws + OFF_G); const bf16_t* Z = (const bf16_t*)(ws + OFF_Z); const bf16_t* XC = (const bf16_t*)(ws + OFF_XC);
    bf16_t* A2 = (bf16_t*)(ws + OFF_A2);
    const int c0 = lane * 16;
    float hw[16], sw[16];
#pragma unroll
    for (int e = 0; e < 16; ++e) { hw[e] = P.hgrn_norm[(c0 + e) & 127]; sw[e] = P.ssd_norm[c0 + e]; }
    const float dsk = P.ssd_d[lane >> 2];
    for (int r = blockIdx.x * 8 + wave; r < ML; r += gridDim.x * 8) {
        float o[16], t[8];
        { const u32x4* p0 = (const u32x4*)(OH + (size_t)r * 1024 + c0); const u32x4* p1 = (const u32x4*)(OH + ((size_t)ML + r) * 1024 + c0); const u32x4* pg = (const u32x4*)(G + (size_t)r * 1024 + c0);
          const u32x4 a0 = p0[0], a1 = p0[1], b0 = p1[0], b1 = p1[1], g0 = pg[0], g1 = pg[1];
          unpack8(a0, t);
#pragma unroll
          for (int e = 0; e < 8; ++e) o[e] = t[e];
          unpack8(a1, t);
#pragma unroll
          for (int e = 0; e < 8; ++e) o[8 + e] = t[e];
          unpack8(b0, t);
#pragma unroll
          for (int e = 0; e < 8; ++e) o[e] += t[e];
          unpack8(b1, t);
#pragma unroll
          for (int e = 0; e < 8; ++e) o[8 + e] += t[e];
          float ss = 0.f;
#pragma unroll
          for (int e = 0; e < 16; ++e) ss += o[e] * o[e];
          ss += __shfl_xor(ss, 1); ss += __shfl_xor(ss, 2); ss += __shfl_xor(ss, 4);
          const float rstd = rsqrtf(ss * (1.0f / 128.0f) + EPS);
          float gg[16]; unpack8(g0, t);
#pragma unroll
          for (int e = 0; e < 8; ++e) gg[e] = t[e];
          unpack8(g1, t);
#pragma unroll
          for (int e = 0; e < 8; ++e) gg[8 + e] = t[e];
#pragma unroll
          for (int e = 0; e < 16; ++e) o[e] = o[e] * rstd * hw[e] * gg[e];
          u32x4 w0, w1; w0.x = pk2(o[0], o[1]); w0.y = pk2(o[2], o[3]); w0.z = pk2(o[4], o[5]); w0.w = pk2(o[6], o[7]);
          w1.x = pk2(o[8], o[9]); w1.y = pk2(o[10], o[11]); w1.z = pk2(o[12], o[13]); w1.w = pk2(o[14], o[15]);
          u32x4* po = (u32x4*)(A2 + (size_t)r * 2048 + c0); po[0] = w0; po[1] = w1; }
        { const u32x4* p0 = (const u32x4*)(OS + (size_t)r * 1024 + c0); const u32x4* p1 = (const u32x4*)(OS + ((size_t)ML + r) * 1024 + c0);
          const u32x4* pz = (const u32x4*)(Z + (size_t)r * 1024 + c0); const u32x4* px = (const u32x4*)(XC + (size_t)r * 2048 + c0);
          const u32x4 a0 = p0[0], a1 = p0[1], b0 = p1[0], b1 = p1[1], z0 = pz[0], z1 = pz[1], x0 = px[0], x1 = px[1];
          unpack8(a0, t);
#pragma unroll
          for (int e = 0; e < 8; ++e) o[e] = t[e];
          unpack8(a1, t);
#pragma unroll
          for (int e = 0; e < 8; ++e) o[8 + e] = t[e];
          unpack8(b0, t);
#pragma unroll
          for (int e = 0; e < 8; ++e) o[e] += t[e];
          unpack8(b1, t);
#pragma unroll
          for (int e = 0; e < 8; ++e) o[8 + e] += t[e];
          unpack8(x0, t);
#pragma unroll
          for (int e = 0; e < 8; ++e) o[e] += dsk * t[e];
          unpack8(x1, t);
#pragma unroll
          for (int e = 0; e < 8; ++e) o[8 + e] += dsk * t[e];
          unpack8(z0, t);
#pragma unroll
          for (int e = 0; e < 8; ++e) o[e] *= t[e];
          unpack8(z1, t);
#pragma unroll
          for (int e = 0; e < 8; ++e) o[8 + e] *= t[e];
          float ss = 0.f;
#pragma unroll
          for (int e = 0; e < 16; ++e) ss += o[e] * o[e];
          ss += __shfl_xor(ss, 1); ss += __shfl_xor(ss, 2); ss += __shfl_xor(ss, 4); ss += __shfl_xor(ss, 8);
          const float rstd = rsqrtf(ss * (1.0f / 256.0f) + EPS);
#pragma unroll
          for (int e = 0; e < 16; ++e) o[e] = o[e] * rstd * sw[e];
          u32x4 w0, w1; w0.x = pk2(o[0], o[1]); w0.y = pk2(o[2], o[3]); w0.z = pk2(o[4], o[5]); w0.w = pk2(o[6], o[7]);
          w1.x = pk2(o[8], o[9]); w1.y = pk2(o[10], o[11]); w1.z = pk2(o[12], o[13]); w1.w = pk2(o[14], o[15]);
          u32x4* po = (u32x4*)(A2 + (size_t)r * 2048 + 1024 + c0); po[0] = w0; po[1] = w1; }
    }
}

__device__ __forceinline__ void grid_barrier(unsigned* ctr, unsigned target) {
    __builtin_amdgcn_fence(__ATOMIC_RELEASE, "agent");
    __syncthreads();
    if (threadIdx.x == 0) {
        __hip_atomic_fetch_add(ctr, 1u, __ATOMIC_RELAXED, __HIP_MEMORY_SCOPE_AGENT);
        while (__hip_atomic_load(ctr, __ATOMIC_RELAXED, __HIP_MEMORY_SCOPE_AGENT) < target) __builtin_amdgcn_s_sleep(2);
    }
    __syncthreads();
    __builtin_amdgcn_fence(__ATOMIC_ACQUIRE, "agent");
}
#define XB_TMO      128
#define XB_XCNT(j)  (256  + 64 * (j))
#define XB_XSUB(j)  (1280 + 64 * (j))
#define XB_XGEN(j)  (2304 + 64 * (j))
#define XB_TOP      3328
#define XB_TOPGEN   3392
#define XCD_BAR_WORDS 3456
#define XB_SPIN_CAP (1u << 22)

__device__ __forceinline__ unsigned xb_ld(unsigned* p)              { return __hip_atomic_load(p, __ATOMIC_RELAXED, __HIP_MEMORY_SCOPE_AGENT); }
__device__ __forceinline__ unsigned xb_add(unsigned* p, unsigned v) { return __hip_atomic_fetch_add(p, v, __ATOMIC_RELAXED, __HIP_MEMORY_SCOPE_AGENT); }
__device__ __forceinline__ unsigned xb_xcc_id() { return (unsigned)__builtin_amdgcn_s_getreg((3 << 11) | 20) & 0xFu; }
#define XB_SPIN(cond, bar) do { unsigned _sp = 0; while (cond) { __builtin_amdgcn_s_sleep(1); \
    if ((++_sp & 255u) == 0u) { if (xb_ld(&(bar)[XB_TMO])) break; if (_sp > XB_SPIN_CAP) { atomicAdd(&(bar)[XB_TMO], 1u); break; } } } } while (0)

struct XcdBarrier {
    unsigned* bar; unsigned x;
    volatile LAS unsigned* st;
};

__device__ __forceinline__ XcdBarrier xcd_barrier_post(unsigned* bar, volatile LAS unsigned* st) {
    XcdBarrier b; b.bar = bar; b.x = xb_xcc_id(); b.st = st;
    if (threadIdx.x == 0) (void)xb_add(&bar[XB_XCNT(b.x)], 1u);
    return b;
}
__device__ __forceinline__ void xcd_barrier_complete(unsigned* bar, unsigned x, unsigned& nloc, unsigned& nx) {
    const unsigned G = gridDim.x * gridDim.y * gridDim.z;
    unsigned sum, cnt, mine, sp = 0u;
    for (;;) {
        sum = 0u; cnt = 0u; mine = 0u;
#pragma unroll
        for (unsigned j = 0; j < 16; ++j) { const unsigned c = xb_ld(&bar[XB_XCNT(j)]); sum += c; cnt += (c > 0u) ? 1u : 0u; mine = (j == x) ? c : mine; }
        if (sum == G) break;
        __builtin_amdgcn_s_sleep(1);
        if ((++sp & 255u) == 0u) { if (xb_ld(&bar[XB_TMO])) break; if (sp > XB_SPIN_CAP) { atomicAdd(&bar[XB_TMO], 1u); break; } }
    }
    nloc = mine > 0u ? mine : 1u; nx = cnt > 0u ? cnt : 1u;
}

__device__ __forceinline__ void xcd_barrier(const XcdBarrier& b) {
    asm volatile("s_waitcnt vmcnt(0)" ::: "memory");
    __syncthreads();
    if (threadIdx.x == 0) {
        unsigned* bar = b.bar;
        __builtin_amdgcn_s_waitcnt(0);
        unsigned nloc = b.st[0], nx = b.st[1];
        if (nloc == 0u) { xcd_barrier_complete(bar, b.x, nloc, nx); b.st[0] = nloc; b.st[1] = nx; }
        const unsigned old = xb_add(&bar[XB_XSUB(b.x)], 1u);
        const unsigned gen = old / nloc;
        if (old + 1u == (gen + 1u) * nloc) {
            __builtin_amdgcn_fence(__ATOMIC_RELEASE, "agent");
            asm volatile("s_waitcnt vmcnt(0)" ::: "memory");
            const unsigned og = xb_add(&bar[XB_TOP], 1u);
            const unsigned tg = og / nx;
            if (og + 1u == (tg + 1u) * nx) xb_add(&bar[XB_TOPGEN], 1u);
            else XB_SPIN(xb_ld(&bar[XB_TOPGEN]) == tg, bar);
            __builtin_amdgcn_fence(__ATOMIC_ACQUIRE, "agent");
            xb_add(&bar[XB_XGEN(b.x)], 1u);
            asm volatile("s_waitcnt vmcnt(0)" ::: "memory");
        } else {
            XB_SPIN(xb_ld(&bar[XB_XGEN(b.x)]) == gen, bar);
            __builtin_amdgcn_fence(__ATOMIC_ACQUIRE, "agent");
            asm volatile("s_waitcnt vmcnt(0)" ::: "memory");
        }
    }
    __syncthreads();
}

#ifndef MK_PH_LO
#define MK_PH_LO 0
#endif
__global__ void __launch_bounds__(NT, 2) fwd_megakernel(Params P, int ph_lo, int ph_hi) {
    extern __shared__ __attribute__((aligned(16))) unsigned char lds_raw[];
    LAS unsigned char* lds = (LAS unsigned char*)lds_raw;
    cg::grid_group grid = cg::this_grid();
    unsigned char* ws = P.ws;
    const float* mod = (const float*)(ws + OFF_MOD);
    int ph = 0; unsigned nbar = 0; unsigned* barw = (unsigned*)(ws + OFF_BAR);
#if !defined(MK_OWN_BARRIER)
    if (threadIdx.x < 4) ((LAS unsigned*)(lds + 131072))[threadIdx.x] = 0u;
    __syncthreads();
    XcdBarrier xbar = xcd_barrier_post(barw, (volatile LAS unsigned*)(lds + 131072));
#endif
#if defined(MK_OWN_BARRIER)
    grid.sync();
#endif
#ifndef MK_DUP
#define MK_DUP 0
#endif
#define REPS(bit) for (int rep_ = 0; rep_ < ((MK_DUP & (bit)) ? 2 : 1); ++rep_)
#ifndef MK_MASK
#define MK_MASK 0xffff
#endif
#define PHASE_BEGIN() (ph >= ph_lo && ph < ph_hi)
#if defined(MK_OWN_BARRIER)
#define PHASE_END() do { ++ph; if (ph > ph_lo && ph < ph_hi) { ++nbar; grid_barrier(barw, nbar * gridDim.x); } } while (0)
#else
#define PHASE_END() do { ++ph; if (ph > ph_lo && ph < ph_hi) { if (ph == 1) grid.sync(); else xcd_barrier(xbar); } } while (0)
#endif
    if ((MK_MASK & 1) && PHASE_BEGIN()) REPS(1) phase_prep(P, lds);
    PHASE_END();
    for (int pass = 0; pass < NPASS; ++pass) {
        if ((MK_MASK & 2) && PHASE_BEGIN()) REPS(2) phase_norm<0>(P, pass);
        PHASE_END();
        if ((MK_MASK & 4) && PHASE_BEGIN()) REPS(4) {
            pg8::Gemm g{(const bf16_t*)(ws + OFF_U), (const bf16_t*)(ws + OFF_WIN), MP, NPAD, D}; pg8::StaticOrder S; S.init(MP, NPAD, gridDim.x, blockIdx.x);
            EpiIn E{ws, P.dt_bias};
            pg8::gemm_phase<EpiIn, pg8::StaticOrder>(lds, g, S, E, nullptr);
        }
        PHASE_END();
        if ((MK_MASK & 8) && PHASE_BEGIN()) REPS(8) phase_conv(P);
        PHASE_END();
        if ((MK_MASK & 16) && PHASE_BEGIN()) REPS(16) phase_scan(P, lds, pass);
        PHASE_END();
        if ((MK_MASK & 32) && PHASE_BEGIN()) REPS(32) phase_readout(P);
        PHASE_END();
        if ((MK_MASK & 64) && PHASE_BEGIN()) REPS(64) {
            pg8::Gemm g{(const bf16_t*)(ws + OFF_A2), (const bf16_t*)(ws + OFF_WOUT), ML, D, 2048}; pg8::StaticOrder S; S.init(ML, D, gridDim.x, blockIdx.x);
            EpiOut E{P.x, mod, (float*)(ws + OFF_H1), pass};
            pg8::gemm_phase<EpiOut, pg8::StaticOrder>(lds, g, S, E, nullptr);
        }
        PHASE_END();
        if ((MK_MASK & 128) && PHASE_BEGIN()) REPS(128) phase_norm<1>(P, pass);
        PHASE_END();
        if ((MK_MASK & 256) && PHASE_BEGIN()) REPS(256) {
            pg8::Gemm g{(const bf16_t*)(ws + OFF_U2), (const bf16_t*)(ws + OFF_WGU), ML, 2 * DFF, D}; pg8::StaticOrder S; S.init(ML, 2 * DFF, gridDim.x, blockIdx.x);
            EpiGU E{(bf16_t*)(ws + OFF_ACT)};
            pg8::gemm_phase<EpiGU, pg8::StaticOrder>(lds, g, S, E, nullptr);
        }
        PHASE_END();
        if ((MK_MASK & 512) && PHASE_BEGIN()) REPS(512) {
            pg8::Gemm g{(const bf16_t*)(ws + OFF_ACT), (const bf16_t*)(ws + OFF_WD), ML, D, DFF}; pg8::StaticOrder S; S.init(ML, D, gridDim.x, blockIdx.x);
            EpiDown E{(const float*)(ws + OFF_H1), mod, P.out, pass};
            pg8::gemm_phase<EpiDown, pg8::StaticOrder>(lds, g, S, E, nullptr);
        }
        PHASE_END();
        if ((MK_MASK & 1024) && PHASE_BEGIN()) phase_final_norm(P, pass);
        ++ph;
    }
}
}

extern "C" void kernel_launch(void* const* d_in, const int* in_sizes, int n_in, void* d_out, int out_size, void* d_ws, size_t ws_size, hipStream_t stream) {
    static int grid_blocks = 0;
    if (grid_blocks == 0) {
        if (n_in != 22 || ws_size < mk::WS_END) { fprintf(stderr, "kernel_launch: unexpected n_in %d or ws_size %zu (< %zu)\n", n_in, ws_size, (size_t)mk::WS_END); }
        int dev = 0, cus = 0, per_cu = 0;
        hipGetDevice(&dev);
        hipDeviceGetAttribute(&cus, hipDeviceAttributeMultiprocessorCount, dev);
        if (hipFuncSetAttribute((const void*)mk::fwd_megakernel, hipFuncAttributeMaxDynamicSharedMemorySize, mk::LDS_BYTES) != hipSuccess) fprintf(stderr, "kernel_launch: hipFuncSetAttribute failed\n");
        hipOccupancyMaxActiveBlocksPerMultiprocessor(&per_cu, (const void*)mk::fwd_megakernel, mk::NT, mk::LDS_BYTES);
        if (per_cu < 1) { fprintf(stderr, "kernel_launch: occupancy query returned %d\n", per_cu); per_cu = 1; }
        grid_blocks = cus * 1;
        (void)hipGetLastError();
    }
#ifdef MK_ZERO_WS
    (void)hipMemsetAsync((char*)d_ws + mk::OFF_Q, 0, mk::WS_END - mk::OFF_Q, stream);
#endif
    (void)hipMemsetAsync((char*)d_ws + mk::OFF_BAR, 0, mk::BAR_BYTES, stream);
    mk::Params p{};
    const float** pp = (const float**)&p;
    for (int i = 0; i < 22; ++i) pp[i] = (const float*)d_in[i];
    p.out = (float*)d_out; p.ws = (unsigned char*)d_ws;
    int ph_lo = 0, ph_hi = 1000;
    void* args[] = {&p, &ph_lo, &ph_hi};
    hipError_t e = hipLaunchCooperativeKernel((const void*)mk::fwd_megakernel, dim3(grid_blocks), dim3(mk::NT), args, mk::LDS_BYTES, stream);
    if (e != hipSuccess) fprintf(stderr, "cooperative launch failed: %s (grid %d)\n", hipGetErrorString(e), grid_blocks);
}
```

```cpp
#include <hip/hip_runtime.h>
#include <hip/hip_cooperative_groups.h>
#include <cstdio>
namespace cg = cooperative_groups;
__device__ __forceinline__ int opaque_tid() { int t = threadIdx.x; asm volatile("" : "+v"(t)); return t; }
namespace pg8 {
#define PG8_LAS __attribute__((address_space(3)))
typedef unsigned short bf16_t;
typedef short bf16x8 __attribute__((ext_vector_type(8)));
typedef float f32x4 __attribute__((ext_vector_type(4)));
typedef unsigned u32x4 __attribute__((ext_vector_type(4)));
constexpr int BM = 256, BK = 64, HALF = 128, HTB = HALF * BK * 2  , STAGE_BYTES = 8 * HTB, NXCD = 8, WGM = 8;

__host__ __device__ __forceinline__ int lds_byte(int r, int c) { const int st = (r >> 4) * 2 + (c >> 5), rr = r & 15, cc = c & 31, ob = rr * 64 + cc * 2; return st * 1024 + (ob ^ (((ob >> 9) & 1) << 5)); }
__host__ __device__ __forceinline__ void stage_rc(int b, int& R, int& C) { const int st = b / 1024, sb = b % 1024, swz = sb ^ (((sb >> 9) & 1) << 5); R = (st >> 1) * 16 + swz / 64; C = (st & 1) * 32 + (swz % 64) / 2; }
__host__ __device__ __forceinline__ int perm32(int rho) { const int n = rho >> 4, i = rho & 15; return 8 * (i >> 2) + 4 * n + (i & 3); }

struct Unit { int pm, pn; };
struct Gemm { const bf16_t* A; const bf16_t* Bt; int M, N, K; };

struct StaticOrder {
    int nM, nN, nwg, G, c;
    __host__ __device__ void init(int M, int N, int G_, int c_) { nM = M / BM; nN = N / BM; nwg = nM * nN; G = G_; c = c_; }
    __host__ __device__ bool next(int i, Unit& u) const {
        const long L = (long)i * G + c; if (L >= nwg) return false;
        int wgid = (int)L; { const int q = nwg / NXCD, r = nwg % NXCD, xcd = wgid % NXCD, off = wgid / NXCD; wgid = (xcd < r ? xcd * (q + 1) : r * (q + 1) + (xcd - r) * q) + off; }
        const int nig = WGM * nN, gid = wgid / nig, fm = gid * WGM, gsz = (nM - fm) < WGM ? (nM - fm) : WGM;
        u.pm = fm + ((wgid % nig) % gsz); u.pn = (wgid % nig) / gsz; return true;
    }
    __device__ __forceinline__ void a_ready(const Unit&) const {}
    __device__ __forceinline__ void done(const Unit&) const {}
};
typedef __bf16 bf16v2_t __attribute__((ext_vector_type(2)));
typedef float f32v2_t __attribute__((ext_vector_type(2)));
__device__ __forceinline__ unsigned cvt_pk_bf16(float lo, float hi) { f32v2_t v = {lo, hi}; bf16v2_t r = __builtin_convertvector(v, bf16v2_t); return __builtin_bit_cast(unsigned, r); }
typedef float f32x2 __attribute__((ext_vector_type(2)));
template <class Epi, class Sched, bool STAMP = false>
__device__ __forceinline__ void gemm_phase(PG8_LAS unsigned char* lds, const Gemm g, const Sched& S, const Epi& E, unsigned long long* stamps) {
    const int tid = opaque_tid(), wid = __builtin_amdgcn_readfirstlane(tid >> 6), lane = tid & 63, wr = wid >> 2, wc = wid & 3, fr = lane & 15, fq = lane >> 4;
    const int K = g.K, nt = K / BK;
    int ts_lo = 0, ts_hi = 0, nts = 0; const unsigned long long rt_entry = STAMP ? (unsigned long long)wall_clock64() : 0ull;
#define PG8_STAMP() do { if (STAMP && wid == 0 && nts < 64) { const unsigned long long _c = (unsigned long long)clock64(); \
        ts_lo = (lane == nts) ? (int)(unsigned)_c : ts_lo; ts_hi = (lane == nts) ? (int)(unsigned)(_c >> 32) : ts_hi; ++nts; } } while (0)
    PG8_STAMP();
    unsigned voffA[2], voffB[2];
#pragma unroll
    for (int i = 0; i < 2; ++i) { int R, C; stage_rc(tid * 16 + i * 8192, R, C); const int Rb = Epi::PERM ? ((R & ~31) + perm32(R & 31)) : R;
        voffA[i] = (unsigned)(R * K + C) * 2u; voffB[i] = (unsigned)(Rb * K + C) * 2u; }
    const size_t kstep = (size_t)(BK * 2);
    const size_t hstep = (size_t)HALF * K * 2;
    const size_t tstep = 2 * hstep;
    const unsigned ldsw = (unsigned)wid * 1024u;
    const int aoff = lds_byte(wr * 64 + fr, fq * 8), boff = lds_byte(wc * 32 + fr, fq * 8);
#define PG8_SA(b, h) (((b) * 2 + (h)) * HTB)
#define PG8_SB(b, h) ((4 + (b) * 2 + (h)) * HTB)
#define PG8_STAGE(bufoff, gbase, voff) do { _Pragma("unroll") for (int _i = 0; _i < 2; ++_i) \
        __builtin_amdgcn_global_load_lds((const unsigned*)((const char*)(gbase) + (voff)[_i]), (PG8_LAS unsigned*)(lds + (bufoff) + ldsw + _i * 8192), 16, 0, 0); } while (0)
#define PG8_LDA(dst, b, h) do { _Pragma("unroll") for (int m = 0; m < 4; ++m) _Pragma("unroll") for (int k = 0; k < 2; ++k) dst[m][k] = *(const PG8_LAS bf16x8*)(lds + PG8_SA(b, h) + aoff + m * 2048 + k * 1024); } while (0)
#define PG8_LDB(dst, b, h) do { _Pragma("unroll") for (int n = 0; n < 2; ++n) _Pragma("unroll") for (int k = 0; k < 2; ++k) dst[n][k] = *(const PG8_LAS bf16x8*)(lds + PG8_SB(b, h) + boff + n * 2048 + k * 1024); } while (0)
#define PG8_MMA(ai, bj, At, Bt) do { __builtin_amdgcn_s_setprio(1); _Pragma("unroll") for (int m = 0; m < 4; ++m) _Pragma("unroll") for (int n = 0; n < 2; ++n) _Pragma("unroll") for (int k = 0; k < 2; ++k) \
        acc[ai][bj][m][n] = __builtin_amdgcn_mfma_f32_16x16x32_bf16(Bt[n][k], At[m][k], acc[ai][bj][m][n], 0, 0, 0); __builtin_amdgcn_s_setprio(0); } while (0)
#define PG8_WAIT_V(n) asm volatile("s_waitcnt vmcnt(" #n ")" ::: "memory")
#define PG8_WAIT_L(n) asm volatile("s_waitcnt lgkmcnt(" #n ")" ::: "memory")
#define PG8_BAR __builtin_amdgcn_s_barrier()
#define PG8_SCHED __builtin_amdgcn_sched_barrier(0)
    Unit cur, nxt; int ui = 0;
    if (!S.next(0, cur)) return;
    f32x4 acc[2][2][4][2];
#pragma unroll
    for (int a = 0; a < 2; ++a)
#pragma unroll
        for (int b = 0; b < 2; ++b)
#pragma unroll
            for (int m = 0; m < 4; ++m)
#pragma unroll
                for (int n = 0; n < 2; ++n) acc[a][b][m][n] = (f32x4){0.f, 0.f, 0.f, 0.f};
    bf16x8 At[4][2], B0[2][2], B1[2][2];
    const char* cA = (const char*)g.A + (size_t)cur.pm * tstep; const char* cB = (const char*)g.Bt + (size_t)cur.pn * tstep;
    S.a_ready(cur);
    PG8_STAGE(PG8_SB(0, 0), cB, voffB); PG8_STAGE(PG8_SA(0, 0), cA, voffA); PG8_STAGE(PG8_SB(0, 1), cB + hstep, voffB); PG8_STAGE(PG8_SA(0, 1), cA + hstep, voffA);
    if (wr == 1) PG8_BAR;
    PG8_WAIT_V(4); PG8_BAR;
    PG8_STAGE(PG8_SB(1, 0), cB + kstep, voffB); PG8_STAGE(PG8_SA(1, 0), cA + kstep, voffA); PG8_STAGE(PG8_SB(1, 1), cB + hstep + kstep, voffB);
    PG8_WAIT_V(6); PG8_BAR;
    PG8_STAMP();
    for (;;) {
        const bool has_next = S.next(ui + 1, nxt);
        const char* nA = has_next ? (const char*)g.A + (size_t)nxt.pm * tstep : cA; const char* nB = has_next ? (const char*)g.Bt + (size_t)nxt.pn * tstep : cB;
        for (int t = 0; t < nt; t += 2) {
            const bool last = (t == nt - 2);
            const char* a1 = cA + (size_t)(t + 1) * kstep;
            const char* a2 = last ? nA : cA + (size_t)(t + 2) * kstep; const char* b2 = last ? nB : cB + (size_t)(t + 2) * kstep;
            const char* a3 = a2 + kstep; const char* b3 = b2 + kstep;
            if (last && has_next) S.a_ready(nxt);
            PG8_LDB(B0, 0, 0); PG8_SCHED; PG8_LDA(At, 0, 0); PG8_STAGE(PG8_SA(1, 1), a1 + hstep, voffA);
            PG8_WAIT_L(8); PG8_BAR; PG8_WAIT_L(0); PG8_MMA(0, 0, At, B0); PG8_BAR; PG8_SCHED;
            PG8_LDB(B1, 0, 1); PG8_STAGE(PG8_SB(0, 0), b2, voffB);
            PG8_BAR; PG8_WAIT_L(0); PG8_MMA(0, 1, At, B1); PG8_BAR;
            PG8_LDA(At, 0, 1); PG8_STAGE(PG8_SA(0, 0), a2, voffA);
            PG8_BAR; PG8_WAIT_L(0); PG8_MMA(1, 0, At, B0); PG8_BAR; PG8_SCHED;
            PG8_STAGE(PG8_SB(0, 1), b2 + hstep, voffB);
            PG8_WAIT_V(6); PG8_BAR; PG8_MMA(1, 1, At, B1); PG8_BAR;
            PG8_LDB(B0, 1, 0); PG8_SCHED; PG8_LDA(At, 1, 0); PG8_STAGE(PG8_SA(0, 1), a2 + hstep, voffA);
            PG8_WAIT_L(8); PG8_BAR; PG8_WAIT_L(0); PG8_MMA(0, 0, At, B0); PG8_BAR; PG8_SCHED;
            PG8_LDB(B1, 1, 1); PG8_STAGE(PG8_SB(1, 0), b3, voffB);
            PG8_BAR; PG8_WAIT_L(0); PG8_MMA(0, 1, At, B1); PG8_BAR;
            PG8_LDA(At, 1, 1); PG8_STAGE(PG8_SA(1, 0), a3, voffA);
            PG8_BAR; PG8_WAIT_L(0); PG8_MMA(1, 0, At, B0); PG8_BAR; PG8_SCHED;
            PG8_STAGE(PG8_SB(1, 1), b3 + hstep, voffB);
            PG8_WAIT_V(6); PG8_BAR; PG8_MMA(1, 1, At, B1); PG8_BAR;
        }
        PG8_STAMP();
        if constexpr (!Epi::AFTER_DRAIN) { E(acc, cur, wr, wc, fr, fq); S.done(cur); }
        PG8_STAMP();
        if (!has_next) break;
#pragma unroll
        for (int a = 0; a < 2; ++a)
#pragma unroll
            for (int b = 0; b < 2; ++b)
#pragma unroll
                for (int m = 0; m < 4; ++m)
#pragma unroll
                    for (int n = 0; n < 2; ++n) acc[a][b][m][n] = (f32x4){0.f, 0.f, 0.f, 0.f};
        cur = nxt; cA = nA; cB = nB; ++ui;
    }
    PG8_WAIT_V(0);
    if (wr == 0) PG8_BAR;
    PG8_BAR;
    if constexpr (Epi::AFTER_DRAIN) { E.fused(acc, cur, wr, wc, fr, fq, lds, wid, lane); S.done(cur); }
    PG8_STAMP();
    if (STAMP && wid == 0) { stamps[lane] = lane < nts ? (((unsigned long long)(unsigned)ts_hi << 32) | (unsigned)ts_lo) : 0ull;
        if (lane == 62) stamps[62] = rt_entry; if (lane == 63) stamps[63] = (unsigned long long)wall_clock64(); }
#undef PG8_STAMP
#undef PG8_SA
#undef PG8_SB
#undef PG8_STAGE
#undef PG8_LDA
#undef PG8_LDB
#undef PG8_MMA
#undef PG8_WAIT_V
#undef PG8_WAIT_L
#undef PG8_BAR
#undef PG8_SCHED
}
}

namespace mk {
using pg8::bf16_t; using pg8::bf16x8; using pg8::f32x4; using pg8::u32x4; using pg8::Unit;
#define LAS __attribute__((address_space(3)))
typedef unsigned u32x2 __attribute__((ext_vector_type(2)));
typedef _Float16 f16;

constexpr int D = 1024, NB = 8, SEQ = 4096, CTX = 256, DIN = 8224, NPAD = 8448, DFF = 2816;
constexpr int BP = 4;
constexpr int NPASS = NB / BP;
constexpr int ML = BP * SEQ;
constexpr int MC = BP * CTX;
constexpr int MP = ML + MC;
constexpr float EPS = 1e-6f;
constexpr int NT = 512;
constexpr int LDS_XB = 140288;
constexpr int LDS_BYTES = LDS_XB + 16;

constexpr size_t SZ_WIN = (size_t)NPAD * D * 2, SZ_WOUT = (size_t)D * 2048 * 2, SZ_WGU = (size_t)2 * DFF * D * 2, SZ_WD = (size_t)D * DFF * 2;
constexpr size_t OFF_WIN = 0, OFF_WOUT = OFF_WIN + SZ_WIN, OFF_WGU = OFF_WOUT + SZ_WOUT, OFF_WD = OFF_WGU + SZ_WGU;
constexpr size_t OFF_MOD = OFF_WD + SZ_WD;
constexpr size_t OFF_LB = OFF_MOD + 9 * 6144 * 4;
constexpr size_t OFF_BAR = OFF_LB + 2048 * 4;
constexpr size_t BAR_BYTES = 16384;
constexpr size_t OFF_Q = OFF_BAR + BAR_BYTES;
constexpr size_t OFF_FR = OFF_Q + (size_t)MP * 1024 * 2;
constexpr size_t OFF_V = OFF_FR + (size_t)MP * 2048 * 2;
constexpr size_t OFF_DT = OFF_V + (size_t)MP * 1024 * 2;
constexpr size_t OFF_G = OFF_DT + (size_t)MP * 32 * 4;
constexpr size_t OFF_Z = OFF_G + (size_t)ML * 1024 * 2;
constexpr size_t OFF_XC = OFF_Z + (size_t)ML * 1024 * 2;
constexpr size_t OFF_X1 = OFF_XC + (size_t)MP * 2048 * 2;
constexpr size_t OFF_U = OFF_X1;
constexpr size_t OFF_XR = OFF_X1 + (size_t)MP * 1024 * 2;
constexpr size_t OFF_OH = OFF_X1;
constexpr size_t OFF_OS = OFF_X1 + (size_t)2 * ML * 1024 * 2;
constexpr size_t WS_END = OFF_X1 + (size_t)4 * ML * 1024 * 2;
constexpr size_t OFF_A2 = OFF_Q;
constexpr size_t OFF_H1 = OFF_X1;
constexpr size_t OFF_U2 = OFF_V;
constexpr size_t OFF_ACT = OFF_G;
static_assert((size_t)ML * 2048 * 2 <= (size_t)MP * 1024 * 2 + (size_t)MP * 2048 * 2, "A2 overlay");
static_assert((size_t)ML * DFF * 2 <= (size_t)2 * ML * 1024 * 2 + (size_t)MP * 2048 * 2, "ACT overlay");
static_assert((size_t)MP * 1024 * 2 + (size_t)MP * 2048 * 2 <= (size_t)4 * ML * 1024 * 2, "U+XR in X1");

struct Params {
    const float *x, *c, *ctx, *c_ctx, *w_ada, *b_ada, *norm_mix, *w_in, *conv_w, *conv_b, *a_log, *dt_bias, *ssd_d, *ssd_norm,
                *lb_raw, *hgrn_norm, *w_out, *norm_ffn, *w_gate, *w_up, *w_down, *final_norm;
    float* out; unsigned char* ws;
};

__device__ __forceinline__ float bf2f(unsigned short b) { return __uint_as_float(((unsigned)b) << 16); }
__device__ __forceinline__ float bflo(unsigned w) { return __uint_as_float(w << 16); }
__device__ __forceinline__ float bfhi(unsigned w) { return __uint_as_float(w & 0xffff0000u); }
__device__ __forceinline__ unsigned pk2(float lo, float hi) { return pg8::cvt_pk_bf16(lo, hi); }
__device__ __forceinline__ unsigned short f2bf(float f) { return (unsigned short)(pk2(f, 0.f) & 0xffffu); }
__device__ __forceinline__ float siluf(float v) { return v * __builtin_amdgcn_rcpf(1.0f + __expf(-v)); }
__device__ __forceinline__ float wave_sum(float v) {
#pragma unroll
    for (int o = 1; o < 64; o <<= 1) v += __shfl_xor(v, o);
    return v;
}

__device__ __forceinline__ void p0_transpose_item(const float* W, int K, int N, bf16_t* WT, int k0, int n0, int drow0, LAS float* scr, int lane) {
#pragma unroll 8
    for (int i = 0; i < 32; ++i) { const int kk = 2 * i + (lane >> 5); scr[kk * 33 + (lane & 31)] = W[(size_t)(k0 + kk) * N + n0 + (lane & 31)]; }
    asm volatile("s_waitcnt vmcnt(0) lgkmcnt(0)" ::: "memory");
    const int c = lane & 7;
#pragma unroll
    for (int j = 0; j < 4; ++j) { const int n = (lane >> 3) + 8 * j; const LAS float* s = scr + (8 * c) * 33 + n;
        u32x4 o; o.x = pk2(s[0 * 33], s[1 * 33]); o.y = pk2(s[2 * 33], s[3 * 33]); o.z = pk2(s[4 * 33], s[5 * 33]); o.w = pk2(s[6 * 33], s[7 * 33]);
        *(u32x4*)(WT + (size_t)(drow0 + n) * K + k0 + 8 * c) = o; }
    asm volatile("s_waitcnt lgkmcnt(0)" ::: "memory");
}

__device__ __forceinline__ void phase_prep(const Params& P, LAS unsigned char* lds) {
    const int tid = opaque_tid(), lane = tid & 63, wave = tid >> 6;
    unsigned char* ws = P.ws;
    float* mod = (float*)(ws + OFF_MOD);
    LAS float* cs = (LAS float*)(lds + 32768);
    if (blockIdx.x < 96) {
        for (int e = tid; e < 9 * 1024; e += NT) { const float cv = (e < 8192) ? P.c[e] : P.c_ctx[e - 8192]; cs[e] = siluf(cv); }
        __syncthreads();
    }
    for (int item = blockIdx.x; item < 96; item += gridDim.x) {
        const int col = item * 64 + lane;
        float acc[9];
#pragma unroll
        for (int r = 0; r < 9; ++r) acc[r] = 0.f;
#pragma unroll 4
        for (int kk = 0; kk < 128; ++kk) {
            const int k = wave * 128 + kk;
            const float wv = P.w_ada[(size_t)k * 6144 + col];
#pragma unroll
            for (int r = 0; r < 9; ++r) acc[r] += cs[r * 1024 + k] * wv;
        }
        LAS float* red = (LAS float*)lds;
#pragma unroll
        for (int r = 0; r < 9; ++r) red[(wave * 9 + r) * 64 + lane] = acc[r];
        __syncthreads();
        for (int e = tid; e < 9 * 64; e += NT) { const int r = e >> 6, l = e & 63; float s = 0.f;
#pragma unroll
            for (int w = 0; w < 8; ++w) s += red[(w * 9 + r) * 64 + l];
            mod[r * 6144 + item * 64 + l] = s + P.b_ada[item * 64 + l]; }
        __syncthreads();
    }
    float* lbv = (float*)(ws + OFF_LB);
    for (int j = blockIdx.x * NT + tid; j < 2048; j += gridDim.x * NT) { const float r0 = P.lb_raw[j], r1 = P.lb_raw[2048 + j]; lbv[j] = 1.0f / (1.0f + __expf(r1 - r0)); }
    { u32x4* z = (u32x4*)(ws + OFF_WIN + (size_t)DIN * D * 2); const int n16 = (NPAD - DIN) * D * 2 / 16;
      for (int j = blockIdx.x * NT + tid; j < n16; j += gridDim.x * NT) z[j] = (u32x4){0u, 0u, 0u, 0u}; }
    LAS float* scr = (LAS float*)(lds + 32768 + 36864 + wave * 8704);
    bf16_t* WinT = (bf16_t*)(ws + OFF_WIN); bf16_t* WoutT = (bf16_t*)(ws + OFF_WOUT); bf16_t* WguT = (bf16_t*)(ws + OFF_WGU); bf16_t* WdT = (bf16_t*)(ws + OFF_WD);
    constexpr int I_IN = (D / 64) * (DIN / 32), I_OUT = (2048 / 64) * (D / 32), I_G = (D / 64) * (DFF / 32), I_D = (DFF / 64) * (D / 32);
    constexpr int NITEMS = I_IN + I_OUT + 2 * I_G + I_D;
    const int gw = blockIdx.x * 8 + wave, NGW = gridDim.x * 8;
    for (int it = gw; it < NITEMS; it += NGW) {
        int r = it;
        if (r < I_IN) { const int nblk = DIN / 32, kb = r / nblk, nb = r % nblk; p0_transpose_item(P.w_in, D, DIN, WinT, 64 * kb, 32 * nb, 32 * nb, scr, lane); continue; } r -= I_IN;
        if (r < I_OUT) { const int nblk = D / 32, kb = r / nblk, nb = r % nblk; p0_transpose_item(P.w_out, 2048, D, WoutT, 64 * kb, 32 * nb, 32 * nb, scr, lane); continue; } r -= I_OUT;
        if (r < I_G) { const int nblk = DFF / 32, kb = r / nblk, nb = r % nblk, n0 = 32 * nb; p0_transpose_item(P.w_gate, D, DFF, WguT, 64 * kb, n0, (n0 >> 7) * 256 + (n0 & 127), scr, lane); continue; } r -= I_G;
        if (r < I_G) { const int nblk = DFF / 32, kb = r / nblk, nb = r % nblk, n0 = 32 * nb; p0_transpose_item(P.w_up, D, DFF, WguT, 64 * kb, n0, (n0 >> 7) * 256 + 128 + (n0 & 127), scr, lane); continue; } r -= I_G;
        { const int nblk = D / 32, kb = r / nblk, nb = r % nblk; p0_transpose_item(P.w_down, DFF, D, WdT, 64 * kb, 32 * nb, 32 * nb, scr, lane); }
    }
}

template <int MODE>
__device__ __forceinline__ void phase_norm(const Params& P, int pass) {
    const int tid_ = opaque_tid(); const int lane = tid_ & 63, wave = tid_ >> 6;
    const float* mod = (const float*)(P.ws + OFF_MOD);
    const int nrows = MODE == 0 ? MP : ML;
    bf16_t* outp = (bf16_t*)(P.ws + (MODE == 0 ? OFF_U : OFF_U2));
    const float* nw = MODE == 0 ? P.norm_mix : P.norm_ffn;
    for (int r = blockIdx.x * 8 + wave; r < nrows; r += gridDim.x * 8) {
        const float* src; int mrow;
        if (MODE == 0) {
            if (r < ML) { src = P.x + ((size_t)pass * ML + r) * D; mrow = pass * BP + (r >> 12); }
            else { const int rc = r - ML; src = P.ctx + ((size_t)pass * MC + rc) * D; mrow = 8; }
        } else { src = (const float*)(P.ws + OFF_H1) + (size_t)r * D; mrow = pass * BP + (r >> 12); }
        const float* sh = mod + mrow * 6144 + (MODE == 0 ? 0 : 3072); const float* sc = sh + 1024;
        f32x4 v[4]; float ss = 0.f;
#pragma unroll
        for (int j = 0; j < 4; ++j) { v[j] = *(const f32x4*)(src + 256 * j + 4 * lane); ss += (v[j].x * v[j].x + v[j].y * v[j].y) + (v[j].z * v[j].z + v[j].w * v[j].w); }
        const float rstd = rsqrtf(wave_sum(ss) * (1.0f / D) + EPS);
#pragma unroll
        for (int j = 0; j < 4; ++j) { const int c0 = 256 * j + 4 * lane;
            const f32x4 w = *(const f32x4*)(nw + c0), s1 = *(const f32x4*)(sc + c0), s0 = *(const f32x4*)(sh + c0);
            const f32x4 o = (v[j] * rstd * w) * (1.0f + s1) + s0;
            u32x2 pk; pk.x = pk2(o.x, o.y); pk.y = pk2(o.z, o.w);
            *(u32x2*)(outp + (size_t)r * D + c0) = pk; }
    }
}

__device__ __forceinline__ void phase_final_norm(const Params& P, int pass) {
    const int tid_ = opaque_tid(); const int lane = tid_ & 63, wave = tid_ >> 6;
    for (int r = blockIdx.x * 8 + wave; r < ML; r += gridDim.x * 8) {
        float* row = P.out + ((size_t)pass * ML + r) * D;
        f32x4 v[4]; float ss = 0.f;
#pragma unroll
        for (int j = 0; j < 4; ++j) { v[j] = *(const f32x4*)(row + 256 * j + 4 * lane); ss += (v[j].x * v[j].x + v[j].y * v[j].y) + (v[j].z * v[j].z + v[j].w * v[j].w); }
        const float rstd = rsqrtf(wave_sum(ss) * (1.0f / D) + EPS);
#pragma unroll
        for (int j = 0; j < 4; ++j) { const int c0 = 256 * j + 4 * lane; const f32x4 w = *(const f32x4*)(P.final_norm + c0);
            *(f32x4*)(row + c0) = v[j] * rstd * w; }
    }
}

struct EpiIn {
    static constexpr bool PERM = true, AFTER_DRAIN = false;
    unsigned char* ws; const float* dt_bias;
    __device__ __forceinline__ void operator()(const f32x4 (&acc)[2][2][4][2], const Unit& u, int wr, int wc, int fr, int fq) const {
        const int pn = u.pn; const bool lat = u.pm < (ML / 256);
        int kind, ld, cofs; size_t off;
        float scale = 1.0f;
        if (pn < 4) { kind = lat ? 0 : 4; off = OFF_Q; ld = 1024; cofs = 0; scale = 0.08838834764831845f; }
        else if (pn < 12) { kind = 2; off = OFF_FR; ld = 2048; cofs = 1024; }
        else if (pn < 16) { kind = 1; off = OFF_V; ld = 1024; cofs = 3072; }
        else if (pn < 20) { kind = lat ? 0 : 4; off = OFF_G; ld = 1024; cofs = 4096; }
        else if (pn < 24) { kind = lat ? 0 : 4; off = OFF_Z; ld = 1024; cofs = 5120; }
        else if (pn < 32) { kind = 1; off = OFF_XR; ld = 2048; cofs = 6144; }
        else { kind = 3; off = OFF_DT; ld = 32; cofs = 8192; }
        if (kind == 4) return;
        const int row0 = u.pm * 256 + wr * 64 + fr;
        if (kind == 3) {
            if (wc != 0) return;
            float* DT = (float*)(ws + off);
            const f32x4 b0 = *(const f32x4*)(dt_bias + 8 * fq), b1 = *(const f32x4*)(dt_bias + 8 * fq + 4);
#pragma unroll
            for (int ai = 0; ai < 2; ++ai)
#pragma unroll
                for (int m = 0; m < 4; ++m) { const int row = row0 + ai * 128 + m * 16;
                    f32x4 v0 = acc[ai][0][m][0] + b0, v1 = acc[ai][0][m][1] + b1;
#pragma unroll
                    for (int j = 0; j < 4; ++j) { v0[j] = v0[j] > 20.f ? v0[j] : log1pf(__expf(v0[j])); v1[j] = v1[j] > 20.f ? v1[j] : log1pf(__expf(v1[j])); }
                    *(f32x4*)(DT + (size_t)row * 32 + 8 * fq) = v0; *(f32x4*)(DT + (size_t)row * 32 + 8 * fq + 4) = v1; }
            return;
        }
        unsigned short* O = (unsigned short*)(ws + off);
        const int col0 = pn * 256 - cofs + wc * 32 + 8 * fq;
#pragma unroll
        for (int ai = 0; ai < 2; ++ai)
#pragma unroll
            for (int m = 0; m < 4; ++m) { unsigned short* rowp = O + (size_t)(row0 + ai * 128 + m * 16) * ld + col0;
#pragma unroll
                for (int bj = 0; bj < 2; ++bj) { f32x4 v0 = acc[ai][bj][m][0], v1 = acc[ai][bj][m][1]; u32x4 w;
                    if (kind == 0) {
#pragma unroll
                        for (int j = 0; j < 4; ++j) { v0[j] = siluf(v0[j]) * scale; v1[j] = siluf(v1[j]) * scale; } }
                    if (kind == 2) {
                        typedef f16 h2 __attribute__((ext_vector_type(2)));
                        const float* lbp = (const float*)(ws + OFF_LB) + col0 + bj * 128;
                        const f32x4 l0 = *(const f32x4*)lbp, l1 = *(const f32x4*)(lbp + 4);
#pragma unroll
                        for (int j = 0; j < 4; ++j) { const float x0 = fminf(fmaxf(v0[j], -30.f), 30.f), x1 = fminf(fmaxf(v1[j], -30.f), 30.f);
                            v0[j] = (1.0f - l0[j]) * __builtin_amdgcn_rcpf(1.0f + __expf(x0)); v1[j] = (1.0f - l1[j]) * __builtin_amdgcn_rcpf(1.0f + __expf(x1)); }
                        h2 a = {(f16)v0[0], (f16)v0[1]}, b = {(f16)v0[2], (f16)v0[3]}, c = {(f16)v1[0], (f16)v1[1]}, d = {(f16)v1[2], (f16)v1[3]};
                        w.x = __builtin_bit_cast(unsigned, a); w.y = __builtin_bit_cast(unsigned, b); w.z = __builtin_bit_cast(unsigned, c); w.w = __builtin_bit_cast(unsigned, d);
                    } else { w.x = pk2(v0[0], v0[1]); w.y = pk2(v0[2], v0[3]); w.z = pk2(v1[0], v1[1]); w.w = pk2(v1[2], v1[3]); }
                    *(u32x4*)(rowp + bj * 128) = w; } }
    }
};
struct EpiOut {
    static constexpr bool PERM = false, AFTER_DRAIN = false;
    const float* x; const float* mod; float* H1; int pass;
    __device__ __forceinline__ void operator()(const f32x4 (&acc)[2][2][4][2], const Unit& u, int wr, int wc, int fr, int fq) const {
        const int row0 = u.pm * 256 + wr * 64 + fr, col0 = u.pn * 256 + wc * 32 + 4 * fq;
        const float* g1 = mod + (size_t)(pass * BP + (u.pm >> 4)) * 6144 + 2048;
        f32x4 gv[2][2];
#pragma unroll
        for (int bj = 0; bj < 2; ++bj)
#pragma unroll
            for (int n = 0; n < 2; ++n) gv[bj][n] = *(const f32x4*)(g1 + col0 + bj * 128 + n * 16);
#pragma unroll
        for (int ai = 0; ai < 2; ++ai)
#pragma unroll
            for (int m = 0; m < 4; ++m) { const int row = row0 + ai * 128 + m * 16; const float* xr = x + ((size_t)pass * ML + row) * D + col0; float* hr = H1 + (size_t)row * D + col0;
#pragma unroll
                for (int bj = 0; bj < 2; ++bj)
#pragma unroll
                    for (int n = 0; n < 2; ++n) *(f32x4*)(hr + bj * 128 + n * 16) = *(const f32x4*)(xr + bj * 128 + n * 16) + gv[bj][n] * acc[ai][bj][m][n]; }
    }
};
struct EpiGU {
    static constexpr bool PERM = true, AFTER_DRAIN = false;
    bf16_t* ACT;
    __device__ __forceinline__ void operator()(const f32x4 (&acc)[2][2][4][2], const Unit& u, int wr, int wc, int fr, int fq) const {
        const int row0 = u.pm * 256 + wr * 64 + fr, col0 = u.pn * 128 + wc * 32 + 8 * fq;
#pragma unroll
        for (int ai = 0; ai < 2; ++ai)
#pragma unroll
            for (int m = 0; m < 4; ++m) { bf16_t* rowp = ACT + (size_t)(row0 + ai * 128 + m * 16) * DFF + col0;
                f32x4 g0 = acc[ai][0][m][0], g1 = acc[ai][0][m][1]; const f32x4 u0 = acc[ai][1][m][0], u1 = acc[ai][1][m][1];
#pragma unroll
                for (int j = 0; j < 4; ++j) { g0[j] = siluf(g0[j]) * u0[j]; g1[j] = siluf(g1[j]) * u1[j]; }
                u32x4 w; w.x = pk2(g0[0], g0[1]); w.y = pk2(g0[2], g0[3]); w.z = pk2(g1[0], g1[1]); w.w = pk2(g1[2], g1[3]);
                *(u32x4*)rowp = w; }
    }
};
struct EpiDown {
    static constexpr bool PERM = false, AFTER_DRAIN = false;
    const float* H1; const float* mod; float* out; int pass;
    __device__ __forceinline__ void operator()(const f32x4 (&acc)[2][2][4][2], const Unit& u, int wr, int wc, int fr, int fq) const {
        const int row0 = u.pm * 256 + wr * 64 + fr, col0 = u.pn * 256 + wc * 32 + 4 * fq;
        const float* g2 = mod + (size_t)(pass * BP + (u.pm >> 4)) * 6144 + 5120;
        f32x4 gv[2][2];
#pragma unroll
        for (int bj = 0; bj < 2; ++bj)
#pragma unroll
            for (int n = 0; n < 2; ++n) gv[bj][n] = *(const f32x4*)(g2 + col0 + bj * 128 + n * 16);
#pragma unroll
        for (int ai = 0; ai < 2; ++ai)
#pragma unroll
            for (int m = 0; m < 4; ++m) { const int row = row0 + ai * 128 + m * 16; const float* hr = H1 + (size_t)row * D + col0; float* orow = out + ((size_t)pass * ML + row) * D + col0;
#pragma unroll
                for (int bj = 0; bj < 2; ++bj)
#pragma unroll
                    for (int n = 0; n < 2; ++n) *(f32x4*)(orow + bj * 128 + n * 16) = *(const f32x4*)(hr + bj * 128 + n * 16) + gv[bj][n] * acc[ai][bj][m][n]; }
    }
};

__device__ __forceinline__ void phase_conv(const Params& P) {
    const bf16_t* XR = (const bf16_t*)(P.ws + OFF_XR); bf16_t* XC = (bf16_t*)(P.ws + OFF_XC);
    constexpr int SEGL = 32, NSEG = MP / SEGL, NITEM = NSEG * 256;
    for (int it = blockIdx.x * NT + opaque_tid(); it < NITEM; it += gridDim.x * NT) {
        const int seg = it >> 8, cg8 = (it & 255) * 8, r0 = seg * SEGL;
        int L0, L1;
        if (r0 < ML) { L0 = r0 & ~63; L1 = L0 + 64; } else { const int rc = r0 - ML; L0 = ML + (rc & ~255); L1 = L0 + 256; }
        float w[5][8], bias[8];
#pragma unroll
        for (int k = 0; k < 5; ++k) { const f32x4 a = *(const f32x4*)(P.conv_w + k * 2048 + cg8), b = *(const f32x4*)(P.conv_w + k * 2048 + cg8 + 4);
            w[k][0] = a.x; w[k][1] = a.y; w[k][2] = a.z; w[k][3] = a.w; w[k][4] = b.x; w[k][5] = b.y; w[k][6] = b.z; w[k][7] = b.w; }
        { const f32x4 a = *(const f32x4*)(P.conv_b + cg8), b = *(const f32x4*)(P.conv_b + cg8 + 4);
          bias[0] = a.x; bias[1] = a.y; bias[2] = a.z; bias[3] = a.w; bias[4] = b.x; bias[5] = b.y; bias[6] = b.z; bias[7] = b.w; }
        u32x4 win[5];
        const u32x4 zero4 = {0u, 0u, 0u, 0u};
#pragma unroll
        for (int k = 0; k < 4; ++k) { const int r = r0 - 2 + k; win[k] = (r >= L0 && r < L1) ? *(const u32x4*)(XR + (size_t)r * 2048 + cg8) : zero4; }
        for (int t = 0; t < SEGL; ++t) {
            const int r = r0 + t + 2; win[4] = (r >= L0 && r < L1) ? *(const u32x4*)(XR + (size_t)r * 2048 + cg8) : zero4;
            float o[8];
#pragma unroll
            for (int e = 0; e < 8; ++e) o[e] = bias[e];
#pragma unroll
            for (int k = 0; k < 5; ++k) {
                o[0] += w[k][0] * bflo(win[k].x); o[1] += w[k][1] * bfhi(win[k].x); o[2] += w[k][2] * bflo(win[k].y); o[3] += w[k][3] * bfhi(win[k].y);
                o[4] += w[k][4] * bflo(win[k].z); o[5] += w[k][5] * bfhi(win[k].z); o[6] += w[k][6] * bflo(win[k].w); o[7] += w[k][7] * bfhi(win[k].w); }
            u32x4 pk; pk.x = pk2(siluf(o[0]), siluf(o[1])); pk.y = pk2(siluf(o[2]), siluf(o[3])); pk.z = pk2(siluf(o[4]), siluf(o[5])); pk.w = pk2(siluf(o[6]), siluf(o[7]));
            *(u32x4*)(XC + (size_t)(r0 + t) * 2048 + cg8) = pk;
            win[0] = win[1]; win[1] = win[2]; win[2] = win[3]; win[3] = win[4];
        }
    }
}

constexpr int L_AQ = 0, L_AK = 17408, L_KET = 34816  , L_VVT = 71680  , L_SC = 90112, L_ST = 99328  , L_SEG = 134144  , L_DEC = 138240  , L_CUM = 139264  , L_DTV = 139776  , L_SCAN_END = 140288;
constexpr int SZ_KET = 18432, SZ_VVT = 9216, SZ_ST = 17408, SZ_SEG = 2048, SZ_DEC = 512, SZ_CUM = 256;
constexpr int PA = 272, PB = 144;

#define MFMA16(a, b, c) __builtin_amdgcn_mfma_f32_16x16x32_bf16((a), (b), (c), 0, 0, 0)

template <bool SSD>
__device__ __forceinline__ void scan_item(const Params& P, LAS unsigned char* lds, int pass, int it) {
    const int tid = opaque_tid(), lane = tid & 63, wave = __builtin_amdgcn_readfirstlane(tid >> 6);
    const int l15 = lane & 15, lq = lane >> 4;
    unsigned char* ws = P.ws;
    int bl, dir, head, vh = 0;
    if (!SSD) { bl = it >> 5; dir = (it >> 4) & 1; head = (it >> 1) & 7; vh = it & 1; }
    else { bl = it >> 5; dir = (it >> 4) & 1; head = it & 15; }
    const unsigned short *srcA, *srcB, *srcV; int ldA, ldB, ldV;
    if (!SSD) { srcA = (const unsigned short*)(ws + OFF_Q) + head * 128; ldA = 1024;
                srcB = (const unsigned short*)(ws + OFF_FR) + dir * 1024 + head * 128; ldB = 2048;
                srcV = (const unsigned short*)(ws + OFF_V) + head * 128 + vh * 64; ldV = 1024; }
    else { const int g = head >> 2;
           srcA = (const unsigned short*)(ws + OFF_XC) + 1536 + g * 128; ldA = 2048;
           srcB = (const unsigned short*)(ws + OFF_XC) + 1024 + g * 128; ldB = 2048;
           srcV = (const unsigned short*)(ws + OFF_XC) + head * 64; ldV = 2048; }
    const float* DT = (const float*)(ws + OFF_DT) + dir * 16 + head;
    unsigned short* Oout = SSD ? (unsigned short*)(ws + OFF_OS) + (size_t)dir * ML * 1024 + head * 64
                               : (unsigned short*)(ws + OFF_OH) + (size_t)dir * ML * 1024 + head * 128 + vh * 64;
    const int f = tid & 127, seg = tid >> 7;
    const int pv = tid & 63, tseg = tid >> 6;
    float a_neg = 0.f;
    if (SSD) a_neg = -__expf(P.a_log[dir * 16 + head]);

    f32x4 sacc[4];
#pragma unroll
    for (int t = 0; t < 4; ++t) sacc[t] = (f32x4){0.f, 0.f, 0.f, 0.f};

    unsigned short ra[16], rb[16], rv[8]; float rdt = 0.f;
    float cumv[16], kk[16], qq[16];
    auto chunk_base = [&](int step) -> int {
        if (step < 4) { const int c = dir ? 3 - step : step; return ML + bl * CTX + c * 64; }
        const int c = dir ? 63 - (step - 4) : step - 4; return bl * SEQ + c * 64; };
    auto load_ab = [&](int step) {
        const int base = chunk_base(step);
#pragma unroll
        for (int ii = 0; ii < 16; ++ii) { const int i = seg * 16 + ii; const int row = base + (dir ? 63 - i : i);
            ra[ii] = srcA[(size_t)row * ldA + f]; rb[ii] = srcB[(size_t)row * ldB + f]; } };
    auto load_v = [&](int step) {
        const int base = chunk_base(step);
#pragma unroll
        for (int ii = 0; ii < 8; ++ii) { const int i = tseg * 8 + ii; const int row = base + (dir ? 63 - i : i); rv[ii] = srcV[(size_t)row * ldV + pv]; } };
    auto load_dt = [&](int step) { if (wave == 0) { const int row = chunk_base(step) + (dir ? 63 - lane : lane); rdt = DT[(size_t)row * 32]; } };
    auto load_early = [&](int step) { if (!SSD) load_ab(step); else load_dt(step); };
    auto load_late = [&](int step) { if (!SSD) load_v(step); else { load_ab(step); load_v(step); } };
    auto local = [&](int p) {
        if (!SSD) {
            float run = 1.f;
#pragma unroll
            for (int ii = 0; ii < 16; ++ii) {
                kk[ii] = (float)__builtin_bit_cast(f16, rb[ii]);
                run *= 1.0f - kk[ii]; cumv[ii] = run; qq[ii] = bf2f(ra[ii]);
            }
            *(LAS float*)(lds + L_SEG + p * SZ_SEG + (seg * 128 + f) * 4) = run;
        } else if (wave == 0) {
            float c = rdt * a_neg;
#pragma unroll
            for (int o = 1; o < 64; o <<= 1) { const float t = __shfl_up(c, o); if (lane >= o) c += t; }
            *(LAS float*)(lds + L_CUM + p * SZ_CUM + lane * 4) = c; *(LAS float*)(lds + L_DTV + p * SZ_CUM + lane * 4) = rdt;
            const float tot = __shfl(c, 63);
            *(LAS float*)(lds + L_SEG + p * SZ_SEG + lane * 4) = __expf(tot - c);
        }
    };
    load_early(0); load_late(0);
    local(0);
    load_early(1);
    __syncthreads();

    for (int step = 0; step < 68; ++step) {
        const int p = step & 1;
        const bool isctx = step < 4;
        const int base = chunk_base(step);
        const LAS float* CUM = (const LAS float*)(lds + L_CUM + p * SZ_CUM); const LAS float* DTV = (const LAS float*)(lds + L_DTV + p * SZ_CUM);
        LAS unsigned char* KETp = lds + L_KET + p * SZ_KET; LAS unsigned char* VVTp = lds + L_VVT + p * SZ_VVT;
        if (!SSD) {
            const LAS float* SEGs = (const LAS float*)(lds + L_SEG + p * SZ_SEG);
            float offs = 1.f, tot = 1.f;
#pragma unroll
            for (int s = 0; s < 4; ++s) { const float t = SEGs[s * 128 + f]; tot *= t; if (s < seg) offs *= t; }
            unsigned kep[8];
#pragma unroll
            for (int ii = 0; ii < 16; ++ii) { const int i = seg * 16 + ii; const float eq = offs * cumv[ii];
                const float ki = kk[ii] * __builtin_amdgcn_rcpf(eq);
                *(LAS unsigned short*)(lds + L_AQ + i * PA + f * 2) = f2bf(qq[ii] * eq);
                *(LAS unsigned short*)(lds + L_AK + i * PA + f * 2) = f2bf(ki);
                kk[ii] = ki * tot; }
#pragma unroll
            for (int j = 0; j < 8; ++j) kep[j] = pk2(kk[2 * j], kk[2 * j + 1]);
            *(LAS u32x4*)(KETp + f * PB + seg * 32) = (u32x4){kep[0], kep[1], kep[2], kep[3]};
            *(LAS u32x4*)(KETp + f * PB + seg * 32 + 16) = (u32x4){kep[4], kep[5], kep[6], kep[7]};
            if (seg == 0) *(LAS float*)(lds + L_DEC + p * SZ_DEC + f * 4) = tot;
            unsigned vp[4];
#pragma unroll
            for (int j = 0; j < 4; ++j) vp[j] = (unsigned)rv[2 * j] | ((unsigned)rv[2 * j + 1] << 16);
            *(LAS u32x4*)(VVTp + pv * PB + tseg * 16) = (u32x4){vp[0], vp[1], vp[2], vp[3]};
        } else {
            const float tot = CUM[63];
            unsigned kep[8]; float kv[16];
#pragma unroll
            for (int ii = 0; ii < 16; ++ii) { const int i = seg * 16 + ii; const float ee = *(const LAS float*)(lds + L_SEG + p * SZ_SEG + i * 4);
                *(LAS unsigned short*)(lds + L_AQ + i * PA + f * 2) = ra[ii];
                *(LAS unsigned short*)(lds + L_AK + i * PA + f * 2) = rb[ii];
                kv[ii] = bf2f(rb[ii]) * ee; }
#pragma unroll
            for (int j = 0; j < 8; ++j) kep[j] = pk2(kv[2 * j], kv[2 * j + 1]);
            *(LAS u32x4*)(KETp + f * PB + seg * 32) = (u32x4){kep[0], kep[1], kep[2], kep[3]};
            *(LAS u32x4*)(KETp + f * PB + seg * 32 + 16) = (u32x4){kep[4], kep[5], kep[6], kep[7]};
            if (seg == 0) *(LAS float*)(lds + L_DEC + p * SZ_DEC + f * 4) = __expf(tot);
            unsigned vp[4];
#pragma unroll
            for (int j = 0; j < 4; ++j) { const int i = tseg * 8 + 2 * j; vp[j] = pk2(bf2f(rv[2 * j]) * DTV[i], bf2f(rv[2 * j + 1]) * DTV[i + 1]); }
            *(LAS u32x4*)(VVTp + pv * PB + tseg * 16) = (u32x4){vp[0], vp[1], vp[2], vp[3]};
        }
        if (step + 1 < 68) load_late(step + 1);
        __syncthreads();
        const int ti = wave >> 1, t0 = (wave & 1) * 2;
        bf16x8 bq[4];
        if (!isctx) {
#pragma unroll
            for (int k = 0; k < 4; ++k) bq[k] = *(const LAS bf16x8*)(lds + L_AQ + (ti * 16 + l15) * PA + k * 64 + lq * 16);
#pragma unroll
            for (int tt = 0; tt < 2; ++tt) { const int tj = t0 + tt; const int i = ti * 16 + l15, j0 = tj * 16 + lq * 4;
                u32x2 w = {0u, 0u};
                if (tj <= ti) {
                    f32x4 a = {0.f, 0.f, 0.f, 0.f};
#pragma unroll
                    for (int k = 0; k < 4; ++k) { const bf16x8 ak = *(const LAS bf16x8*)(lds + L_AK + (tj * 16 + l15) * PA + k * 64 + lq * 16); a = MFMA16(ak, bq[k], a); }
                    float ci = 0.f; if (SSD) ci = CUM[i];
#pragma unroll
                    for (int jj = 0; jj < 4; ++jj) { const int j = j0 + jj; float v = a[jj];
                        if (SSD) v *= __expf(fminf(ci - CUM[j], 0.f));
                        a[jj] = (j <= i) ? v : 0.f; }
                    w.x = pk2(a[0], a[1]); w.y = pk2(a[2], a[3]);
                }
                *(LAS u32x2*)(lds + L_SC + i * PB + j0 * 2) = w; }
        }
        if (step + 1 < 68) { local(p ^ 1); if (step + 2 < 68) load_early(step + 2); }
        __syncthreads();
        if (!isctx) {
            const LAS unsigned char* STp = lds + L_ST + p * SZ_ST;
            bf16x8 bs[2];
#pragma unroll
            for (int k = 0; k < 2; ++k) bs[k] = *(const LAS bf16x8*)(lds + L_SC + (ti * 16 + l15) * PB + k * 64 + lq * 16);
            const int i = ti * 16 + l15; const int row = base + (dir ? 63 - i : i);
            float rs = 1.0f; if (SSD) rs = __expf(CUM[i]);
#pragma unroll
            for (int tt = 0; tt < 2; ++tt) { const int tv = t0 + tt;
                f32x4 a1 = {0.f, 0.f, 0.f, 0.f}, a2 = {0.f, 0.f, 0.f, 0.f};
#pragma unroll
                for (int k = 0; k < 2; ++k) { const bf16x8 av = *(const LAS bf16x8*)(VVTp + (tv * 16 + l15) * PB + k * 64 + lq * 16); a1 = MFMA16(av, bs[k], a1); }
#pragma unroll
                for (int k = 0; k < 4; ++k) { const bf16x8 as = *(const LAS bf16x8*)(STp + (tv * 16 + l15) * PA + k * 64 + lq * 16); a2 = MFMA16(as, bq[k], a2); }
                const f32x4 o = a1 + a2 * rs;
                u32x2 w; w.x = pk2(o[0], o[1]); w.y = pk2(o[2], o[3]);
                *(u32x2*)(Oout + (size_t)row * 1024 + tv * 16 + lq * 4) = w; }
        }
        {
            LAS unsigned char* STn = lds + L_ST + (p ^ 1) * SZ_ST;
            const f32x4 dv = *(const LAS f32x4*)(lds + L_DEC + p * SZ_DEC + (wave * 16 + lq * 4) * 4);
            bf16x8 ak[2];
#pragma unroll
            for (int k = 0; k < 2; ++k) ak[k] = *(const LAS bf16x8*)(KETp + (wave * 16 + l15) * PB + k * 64 + lq * 16);
#pragma unroll
            for (int tv = 0; tv < 4; ++tv) { f32x4 s = sacc[tv] * dv;
#pragma unroll
                for (int k = 0; k < 2; ++k) { const bf16x8 bv = *(const LAS bf16x8*)(VVTp + (tv * 16 + l15) * PB + k * 64 + lq * 16); s = MFMA16(ak[k], bv, s); }
                sacc[tv] = s;
                u32x2 w; w.x = pk2(s[0], s[1]); w.y = pk2(s[2], s[3]);
                *(LAS u32x2*)(STn + (tv * 16 + l15) * PA + (wave * 16 + lq * 4) * 2) = w; }
        }
    }
    __syncthreads();
}

__device__ __forceinline__ void phase_scan(const Params& P, LAS unsigned char* lds, int pass) {
    for (int it = blockIdx.x; it < 256; it += gridDim.x) {
        if (it < 128) scan_item<false>(P, lds, pass, it); else scan_item<true>(P, lds, pass, it - 128);
    }
}

__device__ __forceinline__ void unpack8(const u32x4 w, float (&o)[8]) { o[0] = bflo(w.x); o[1] = bfhi(w.x); o[2] = bflo(w.y); o[3] = bfhi(w.y); o[4] = bflo(w.z); o[5] = bfhi(w.z); o[6] = bflo(w.w); o[7] = bfhi(w.w); }
__device__ __forceinline__ void phase_readout(const Params& P) {
    const int tid_ = opaque_tid(); const int lane = tid_ & 63, wave = tid_ >> 6;
    unsigned char* ws = P.ws;
    const bf16_t* OH = (const bf16_t*)(ws + OFF_OH); const bf16_t* OS = (const bf16_t*)(ws + OFF_OS);
    const bf16_t* G = (const bf16_t*)(ws + OFF_G); const bf16_t* Z = (const bf16_t*)(ws + OFF_Z); const bf16_t* XC = (const bf16_t*)(ws + OFF_XC);
    bf16_t* A2 = (bf16_t*)(ws + OFF_A2);
    const int c0 = lane * 16;
    float hw[16], sw[16];
#pragma unroll
    for (int e = 0; e < 16; ++e) { hw[e] = P.hgrn_norm[(c0 + e) & 127]; sw[e] = P.ssd_norm[c0 + e]; }
    const float dsk = P.ssd_d[lane >> 2];
    for (int r = blockIdx.x * 8 + wave; r < ML; r += gridDim.x * 8) {
        float o[16], t[8];
        { const u32x4* p0 = (const u32x4*)(OH + (size_t)r * 1024 + c0); const u32x4* p1 = (const u32x4*)(OH + ((size_t)ML + r) * 1024 + c0); const u32x4* pg = (const u32x4*)(G + (size_t)r * 1024 + c0);
          const u32x4 a0 = p0[0], a1 = p0[1], b0 = p1[0], b1 = p1[1], g0 = pg[0], g1 = pg[1];
          unpack8(a0, t);
#pragma unroll
          for (int e = 0; e < 8; ++e) o[e] = t[e];
          unpack8(a1, t);
#pragma unroll
          for (int e = 0; e < 8; ++e) o[8 + e] = t[e];
          unpack8(b0, t);
#pragma unroll
          for (int e = 0; e < 8; ++e) o[e] += t[e];
          unpack8(b1, t);
#pragma unroll
          for (int e = 0; e < 8; ++e) o[8 + e] += t[e];
          float ss = 0.f;
#pragma unroll
          for (int e = 0; e < 16; ++e) ss += o[e] * o[e];
          ss += __shfl_xor(ss, 1); ss += __shfl_xor(ss, 2); ss += __shfl_xor(ss, 4);
          const float rstd = rsqrtf(ss * (1.0f / 128.0f) + EPS);
          float gg[16]; unpack8(g0, t);
#pragma unroll
          for (int e = 0; e < 8; ++e) gg[e] = t[e];
          unpack8(g1, t);
#pragma unroll
          for (int e = 0; e < 8; ++e) gg[8 + e] = t[e];
#pragma unroll
          for (int e = 0; e < 16; ++e) o[e] = o[e] * rstd * hw[e] * gg[e];
          u32x4 w0, w1; w0.x = pk2(o[0], o[1]); w0.y = pk2(o[2], o[3]); w0.z = pk2(o[4], o[5]); w0.w = pk2(o[6], o[7]);
          w1.x = pk2(o[8], o[9]); w1.y = pk2(o[10], o[11]); w1.z = pk2(o[12], o[13]); w1.w = pk2(o[14], o[15]);
          u32x4* po = (u32x4*)(A2 + (size_t)r * 2048 + c0); po[0] = w0; po[1] = w1; }
        { const u32x4* p0 = (const u32x4*)(OS + (size_t)r * 1024 + c0); const u32x4* p1 = (const u32x4*)(OS + ((size_t)ML + r) * 1024 + c0);
          const u32x4* pz = (const u32x4*)(Z + (size_t)r * 1024 + c0); const u32x4* px = (const u32x4*)(XC + (size_t)r * 2048 + c0);
          const u32x4 a0 = p0[0], a1 = p0[1], b0 = p1[0], b1 = p1[1], z0 = pz[0], z1 = pz[1], x0 = px[0], x1 = px[1];
          unpack8(a0, t);
#pragma unroll
          for (int e = 0; e < 8; ++e) o[e] = t[e];
          unpack8(a1, t);
#pragma unroll
          for (int e = 0; e < 8; ++e) o[8 + e] = t[e];
          unpack8(b0, t);
#pragma unroll
          for (int e = 0; e < 8; ++e) o[e] += t[e];
          unpack8(b1, t);
#pragma unroll
          for (int e = 0; e < 8; ++e) o[8 + e] += t[e];
          unpack8(x0, t);
#pragma unroll
          for (int e = 0; e < 8; ++e) o[e] += dsk * t[e];
          unpack8(x1, t);
#pragma unroll
          for (int e = 0; e < 8; ++e) o[8 + e] += dsk * t[e];
          unpack8(z0, t);
#pragma unroll
          for (int e = 0; e < 8; ++e) o[e] *= t[e];
          unpack8(z1, t);
#pragma unroll
          for (int e = 0; e < 8; ++e) o[8 + e] *= t[e];
          float ss = 0.f;
#pragma unroll
          for (int e = 0; e < 16; ++e) ss += o[e] * o[e];
          ss += __shfl_xor(ss, 1); ss += __shfl_xor(ss, 2); ss += __shfl_xor(ss, 4); ss += __shfl_xor(ss, 8);
          const float rstd = rsqrtf(ss * (1.0f / 256.0f) + EPS);
#pragma unroll
          for (int e = 0; e < 16; ++e) o[e] = o[e] * rstd * sw[e];
          u32x4 w0, w1; w0.x = pk2(o[0], o[1]); w0.y = pk2(o[2], o[3]); w0.z = pk2(o[4], o[5]); w0.w = pk2(o[6], o[7]);
          w1.x = pk2(o[8], o[9]); w1.y = pk2(o[10], o[11]); w1.z = pk2(o[12], o[13]); w1.w = pk2(o[14], o[15]);
          u32x4* po = (u32x4*)(A2 + (size_t)r * 2048 + 1024 + c0); po[0] = w0; po[1] = w1; }
    }
}

__device__ __forceinline__ void grid_barrier(unsigned* ctr, unsigned target) {
    __builtin_amdgcn_fence(__ATOMIC_RELEASE, "agent");
    __syncthreads();
    if (threadIdx.x == 0) {
        __hip_atomic_fetch_add(ctr, 1u, __ATOMIC_RELAXED, __HIP_MEMORY_SCOPE_AGENT);
        while (__hip_atomic_load(ctr, __ATOMIC_RELAXED, __HIP_MEMORY_SCOPE_AGENT) < target) __builtin_amdgcn_s_sleep(2);
    }
    __syncthreads();
    __builtin_amdgcn_fence(__ATOMIC_ACQUIRE, "agent");
}
#define XB_TMO      128
#define XB_XCNT(j)  (256  + 64 * (j))
#define XB_XSUB(j)  (1280 + 64 * (j))
#define XB_XGEN(j)  (2304 + 64 * (j))
#define XB_TOP      3328
#define XB_TOPGEN   3392
#define XCD_BAR_WORDS 3456
#define XB_SPIN_CAP (1u << 22)

__device__ __forceinline__ unsigned xb_ld(unsigned* p)              { return __hip_atomic_load(p, __ATOMIC_RELAXED, __HIP_MEMORY_SCOPE_AGENT); }
__device__ __forceinline__ unsigned xb_add(unsigned* p, unsigned v) { return __hip_atomic_fetch_add(p, v, __ATOMIC_RELAXED, __HIP_MEMORY_SCOPE_AGENT); }
__device__ __forceinline__ unsigned xb_xcc_id() { return (unsigned)__builtin_amdgcn_s_getreg((3 << 11) | 20) & 0xFu; }
#define XB_SPIN(cond, bar) do { unsigned _sp = 0; while (cond) { __builtin_amdgcn_s_sleep(1); \
    if ((++_sp & 255u) == 0u) { if (xb_ld(&(bar)[XB_TMO])) break; if (_sp > XB_SPIN_CAP) { atomicAdd(&(bar)[XB_TMO], 1u); break; } } } } while (0)

struct XcdBarrier {
    unsigned* bar; unsigned x;
    volatile LAS unsigned* st;
};

__device__ __forceinline__ XcdBarrier xcd_barrier_post(unsigned* bar, volatile LAS unsigned* st) {
    XcdBarrier b; b.bar = bar; b.x = xb_xcc_id(); b.st = st;
    if (threadIdx.x == 0) (void)xb_add(&bar[XB_XCNT(b.x)], 1u);
    return b;
}
__device__ __forceinline__ void xcd_barrier_complete(unsigned* bar, unsigned x, unsigned& nloc, unsigned& nx) {
    const unsigned G = gridDim.x * gridDim.y * gridDim.z;
    unsigned sum, cnt, mine, sp = 0u;
    for (;;) {
        sum = 0u; cnt = 0u; mine = 0u;
#pragma unroll
        for (unsigned j = 0; j < 16; ++j) { const unsigned c = xb_ld(&bar[XB_XCNT(j)]); sum += c; cnt += (c > 0u) ? 1u : 0u; mine = (j == x) ? c : mine; }
        if (sum == G) break;
        __builtin_amdgcn_s_sleep(1);
        if ((++sp & 255u) == 0u) { if (xb_ld(&bar[XB_TMO])) break; if (sp > XB_SPIN_CAP) { atomicAdd(&bar[XB_TMO], 1u); break; } }
    }
    nloc = mine > 0u ? mine : 1u; nx = cnt > 0u ? cnt : 1u;
}

__device__ __forceinline__ void xcd_barrier(const XcdBarrier& b) {
    asm volatile("s_waitcnt vmcnt(0)" ::: "memory");
    __syncthreads();
    if (threadIdx.x == 0) {
        unsigned* bar = b.bar;
        __builtin_amdgcn_s_waitcnt(0);
        unsigned nloc = b.st[0], nx = b.st[1];
        if (nloc == 0u) { xcd_barrier_complete(bar, b.x, nloc, nx); b.st[0] = nloc; b.st[1] = nx; }
        const unsigned old = xb_add(&bar[XB_XSUB(b.x)], 1u);
        const unsigned gen = old / nloc;
        if (old + 1u == (gen + 1u) * nloc) {
            __builtin_amdgcn_fence(__ATOMIC_RELEASE, "agent");
            asm volatile("s_waitcnt vmcnt(0)" ::: "memory");
            const unsigned og = xb_add(&bar[XB_TOP], 1u);
            const unsigned tg = og / nx;
            if (og + 1u == (tg + 1u) * nx) xb_add(&bar[XB_TOPGEN], 1u);
            else XB_SPIN(xb_ld(&bar[XB_TOPGEN]) == tg, bar);
            __builtin_amdgcn_fence(__ATOMIC_ACQUIRE, "agent");
            xb_add(&bar[XB_XGEN(b.x)], 1u);
            asm volatile("s_waitcnt vmcnt(0)" ::: "memory");
        } else {
            XB_SPIN(xb_ld(&bar[XB_XGEN(b.x)]) == gen, bar);
            __builtin_amdgcn_fence(__ATOMIC_ACQUIRE, "agent");
            asm volatile("s_waitcnt vmcnt(0)" ::: "memory");
        }
    }
    __syncthreads();
}

#ifndef MK_PH_LO
#define MK_PH_LO 0
#endif
__global__ void __launch_bounds__(NT, 2) fwd_megakernel(Params P, int ph_lo, int ph_hi) {
    extern __shared__ __attribute__((aligned(16))) unsigned char lds_raw[];
    LAS unsigned char* lds = (LAS unsigned char*)lds_raw;
    cg::grid_group grid = cg::this_grid();
    unsigned char* ws = P.ws;
    const float* mod = (const float*)(ws + OFF_MOD);
    int ph = 0; unsigned nbar = 0; unsigned* barw = (unsigned*)(ws + OFF_BAR);
#if !defined(MK_OWN_BARRIER)
    if (threadIdx.x < 4) ((LAS unsigned*)(lds + LDS_XB))[threadIdx.x] = 0u;
    __syncthreads();
    XcdBarrier xbar = xcd_barrier_post(barw, (volatile LAS unsigned*)(lds + LDS_XB));
#endif
#if defined(MK_OWN_BARRIER)
    grid.sync();
#endif
#ifndef MK_DUP
#define MK_DUP 0
#endif
#define REPS(bit) for (int rep_ = 0; rep_ < ((MK_DUP & (bit)) ? 2 : 1); ++rep_)
#ifndef MK_MASK
#define MK_MASK 0xffff
#endif
#define PHASE_BEGIN() (ph >= ph_lo && ph < ph_hi)
#if defined(MK_OWN_BARRIER)
#define PHASE_END() do { ++ph; if (ph > ph_lo && ph < ph_hi) { ++nbar; grid_barrier(barw, nbar * gridDim.x); } } while (0)
#else
#define PHASE_END() do { ++ph; if (ph > ph_lo && ph < ph_hi) { if (ph == 1) grid.sync(); else xcd_barrier(xbar); } } while (0)
#endif
    if ((MK_MASK & 1) && PHASE_BEGIN()) REPS(1) phase_prep(P, lds);
    PHASE_END();
    for (int pass = 0; pass < NPASS; ++pass) {
        if ((MK_MASK & 2) && PHASE_BEGIN()) REPS(2) phase_norm<0>(P, pass);
        PHASE_END();
        if ((MK_MASK & 4) && PHASE_BEGIN()) REPS(4) {
            pg8::Gemm g{(const bf16_t*)(ws + OFF_U), (const bf16_t*)(ws + OFF_WIN), MP, NPAD, D}; pg8::StaticOrder S; S.init(MP, NPAD, gridDim.x, blockIdx.x);
            EpiIn E{ws, P.dt_bias};
            pg8::gemm_phase<EpiIn, pg8::StaticOrder>(lds, g, S, E, nullptr);
        }
        PHASE_END();
        if ((MK_MASK & 8) && PHASE_BEGIN()) REPS(8) phase_conv(P);
        PHASE_END();
        if ((MK_MASK & 16) && PHASE_BEGIN()) REPS(16) phase_scan(P, lds, pass);
        PHASE_END();
        if ((MK_MASK & 32) && PHASE_BEGIN()) REPS(32) phase_readout(P);
        PHASE_END();
        if ((MK_MASK & 64) && PHASE_BEGIN()) REPS(64) {
            pg8::Gemm g{(const bf16_t*)(ws + OFF_A2), (const bf16_t*)(ws + OFF_WOUT), ML, D, 2048}; pg8::StaticOrder S; S.init(ML, D, gridDim.x, blockIdx.x);
            EpiOut E{P.x, mod, (float*)(ws + OFF_H1), pass};
            pg8::gemm_phase<EpiOut, pg8::StaticOrder>(lds, g, S, E, nullptr);
        }
        PHASE_END();
        if ((MK_MASK & 128) && PHASE_BEGIN()) REPS(128) phase_norm<1>(P, pass);
        PHASE_END();
        if ((MK_MASK & 256) && PHASE_BEGIN()) REPS(256) {
            pg8::Gemm g{(const bf16_t*)(ws + OFF_U2), (const bf16_t*)(ws + OFF_WGU), ML, 2 * DFF, D}; pg8::StaticOrder S; S.init(ML, 2 * DFF, gridDim.x, blockIdx.x);
            EpiGU E{(bf16_t*)(ws + OFF_ACT)};
            pg8::gemm_phase<EpiGU, pg8::StaticOrder>(lds, g, S, E, nullptr);
        }
        PHASE_END();
        if ((MK_MASK & 512) && PHASE_BEGIN()) REPS(512) {
            pg8::Gemm g{(const bf16_t*)(ws + OFF_ACT), (const bf16_t*)(ws + OFF_WD), ML, D, DFF}; pg8::StaticOrder S; S.init(ML, D, gridDim.x, blockIdx.x);
            EpiDown E{(const float*)(ws + OFF_H1), mod, P.out, pass};
            pg8::gemm_phase<EpiDown, pg8::StaticOrder>(lds, g, S, E, nullptr);
        }
        PHASE_END();
        if ((MK_MASK & 1024) && PHASE_BEGIN()) phase_final_norm(P, pass);
        ++ph;
    }
}
}

extern "C" void kernel_launch(void* const* d_in, const int* in_sizes, int n_in, void* d_out, int out_size, void* d_ws, size_t ws_size, hipStream_t stream) {
    static int grid_blocks = 0;
    if (grid_blocks == 0) {
        if (n_in != 22 || ws_size < mk::WS_END) { fprintf(stderr, "kernel_launch: unexpected n_in %d or ws_size %zu (< %zu)\n", n_in, ws_size, (size_t)mk::WS_END); }
        int dev = 0, cus = 0, per_cu = 0;
        hipGetDevice(&dev);
        hipDeviceGetAttribute(&cus, hipDeviceAttributeMultiprocessorCount, dev);
        if (hipFuncSetAttribute((const void*)mk::fwd_megakernel, hipFuncAttributeMaxDynamicSharedMemorySize, mk::LDS_BYTES) != hipSuccess) fprintf(stderr, "kernel_launch: hipFuncSetAttribute failed\n");
        hipOccupancyMaxActiveBlocksPerMultiprocessor(&per_cu, (const void*)mk::fwd_megakernel, mk::NT, mk::LDS_BYTES);
        if (per_cu < 1) { fprintf(stderr, "kernel_launch: occupancy query returned %d\n", per_cu); per_cu = 1; }
        grid_blocks = cus * 1;
        (void)hipGetLastError();
    }
#ifdef MK_ZERO_WS
    (void)hipMemsetAsync((char*)d_ws + mk::OFF_Q, 0, mk::WS_END - mk::OFF_Q, stream);
#endif
    (void)hipMemsetAsync((char*)d_ws + mk::OFF_BAR, 0, mk::BAR_BYTES, stream);
    mk::Params p{};
    const float** pp = (const float**)&p;
    for (int i = 0; i < 22; ++i) pp[i] = (const float*)d_in[i];
    p.out = (float*)d_out; p.ws = (unsigned char*)d_ws;
    int ph_lo = 0, ph_hi = 1000;
    void* args[] = {&p, &ph_lo, &ph_hi};
    hipError_t e = hipLaunchCooperativeKernel((const void*)mk::fwd_megakernel, dim3(grid_blocks), dim3(mk::NT), args, mk::LDS_BYTES, stream);
    if (e != hipSuccess) fprintf(stderr, "cooperative launch failed: %s (grid %d)\n", hipGetErrorString(e), grid_blocks);
}
```

```cpp
#include <hip/hip_runtime.h>
#include <hip/hip_cooperative_groups.h>
#include <cstdio>
namespace cg = cooperative_groups;
__device__ __forceinline__ int opaque_tid() { int t = threadIdx.x; asm volatile("" : "+v"(t)); return t; }
namespace pg8 {
#define PG8_LAS __attribute__((address_space(3)))
typedef unsigned short bf16_t;
typedef short bf16x8 __attribute__((ext_vector_type(8)));
typedef float f32x4 __attribute__((ext_vector_type(4)));
typedef unsigned u32x4 __attribute__((ext_vector_type(4)));
constexpr int BM = 256, BK = 64, HALF = 128, HTB = HALF * BK * 2  , STAGE_BYTES = 8 * HTB, NXCD = 8, WGM = 8;

__host__ __device__ __forceinline__ int lds_byte(int r, int c) { const int st = (r >> 4) * 2 + (c >> 5), rr = r & 15, cc = c & 31, ob = rr * 64 + cc * 2; return st * 1024 + (ob ^ (((ob >> 9) & 1) << 5)); }
__host__ __device__ __forceinline__ void stage_rc(int b, int& R, int& C) { const int st = b / 1024, sb = b % 1024, swz = sb ^ (((sb >> 9) & 1) << 5); R = (st >> 1) * 16 + swz / 64; C = (st & 1) * 32 + (swz % 64) / 2; }
__host__ __device__ __forceinline__ int perm32(int rho) { const int n = rho >> 4, i = rho & 15; return 8 * (i >> 2) + 4 * n + (i & 3); }

struct Unit { int pm, pn; };
struct Gemm { const bf16_t* A; const bf16_t* Bt; int M, N, K; };

struct StaticOrder {
    int nM, nN, nwg, G, c;
    __host__ __device__ void init(int M, int N, int G_, int c_) { nM = M / BM; nN = N / BM; nwg = nM * nN; G = G_; c = c_; }
    __host__ __device__ bool next(int i, Unit& u) const {
        const long L = (long)i * G + c; if (L >= nwg) return false;
        int wgid = (int)L; { const int q = nwg / NXCD, r = nwg % NXCD, xcd = wgid % NXCD, off = wgid / NXCD; wgid = (xcd < r ? xcd * (q + 1) : r * (q + 1) + (xcd - r) * q) + off; }
        const int nig = WGM * nN, gid = wgid / nig, fm = gid * WGM, gsz = (nM - fm) < WGM ? (nM - fm) : WGM;
        u.pm = fm + ((wgid % nig) % gsz); u.pn = (wgid % nig) / gsz; return true;
    }
    __device__ __forceinline__ void a_ready(const Unit&) const {}
    __device__ __forceinline__ void done(const Unit&) const {}
};
typedef __bf16 bf16v2_t __attribute__((ext_vector_type(2)));
typedef float f32v2_t __attribute__((ext_vector_type(2)));
__device__ __forceinline__ unsigned cvt_pk_bf16(float lo, float hi) { f32v2_t v = {lo, hi}; bf16v2_t r = __builtin_convertvector(v, bf16v2_t); return __builtin_bit_cast(unsigned, r); }
typedef float f32x2 __attribute__((ext_vector_type(2)));
template <class Epi, class Sched, bool STAMP = false>
__device__ __forceinline__ void gemm_phase(PG8_LAS unsigned char* lds, const Gemm g, const Sched& S, const Epi& E, unsigned long long* stamps) {
    const int tid = opaque_tid(), wid = __builtin_amdgcn_readfirstlane(tid >> 6), lane = tid & 63, wr = wid >> 2, wc = wid & 3, fr = lane & 15, fq = lane >> 4;
    const int K = g.K, nt = K / BK;
    int ts_lo = 0, ts_hi = 0, nts = 0; const unsigned long long rt_entry = STAMP ? (unsigned long long)wall_clock64() : 0ull;
#define PG8_STAMP() do { if (STAMP && wid == 0 && nts < 64) { const unsigned long long _c = (unsigned long long)clock64(); \
        ts_lo = (lane == nts) ? (int)(unsigned)_c : ts_lo; ts_hi = (lane == nts) ? (int)(unsigned)(_c >> 32) : ts_hi; ++nts; } } while (0)
    PG8_STAMP();
    unsigned voffA[2], voffB[2];
#pragma unroll
    for (int i = 0; i < 2; ++i) { int R, C; stage_rc(tid * 16 + i * 8192, R, C); const int Rb = Epi::PERM ? ((R & ~31) + perm32(R & 31)) : R;
        voffA[i] = (unsigned)(R * K + C) * 2u; voffB[i] = (unsigned)(Rb * K + C) * 2u; }
    const size_t kstep = (size_t)(BK * 2);
    const size_t hstep = (size_t)HALF * K * 2;
    const size_t tstep = 2 * hstep;
    const unsigned ldsw = (unsigned)wid * 1024u;
    const int aoff = lds_byte(wr * 64 + fr, fq * 8), boff = lds_byte(wc * 32 + fr, fq * 8);
#define PG8_SA(b, h) (((b) * 2 + (h)) * HTB)
#define PG8_SB(b, h) ((4 + (b) * 2 + (h)) * HTB)
#define PG8_STAGE(bufoff, gbase, voff) do { _Pragma("unroll") for (int _i = 0; _i < 2; ++_i) \
        __builtin_amdgcn_global_load_lds((const unsigned*)((const char*)(gbase) + (voff)[_i]), (PG8_LAS unsigned*)(lds + (bufoff) + ldsw + _i * 8192), 16, 0, 0); } while (0)
#define PG8_LDA(dst, b, h) do { _Pragma("unroll") for (int m = 0; m < 4; ++m) _Pragma("unroll") for (int k = 0; k < 2; ++k) dst[m][k] = *(const PG8_LAS bf16x8*)(lds + PG8_SA(b, h) + aoff + m * 2048 + k * 1024); } while (0)
#define PG8_LDB(dst, b, h) do { _Pragma("unroll") for (int n = 0; n < 2; ++n) _Pragma("unroll") for (int k = 0; k < 2; ++k) dst[n][k] = *(const PG8_LAS bf16x8*)(lds + PG8_SB(b, h) + boff + n * 2048 + k * 1024); } while (0)
#define PG8_MMA(ai, bj, At, Bt) do { __builtin_amdgcn_s_setprio(1); _Pragma("unroll") for (int m = 0; m < 4; ++m) _Pragma("unroll") for (int n = 0; n < 2; ++n) _Pragma("unroll") for (int k = 0; k < 2; ++k) \
        acc[ai][bj][m][n] = __builtin_amdgcn_mfma_f32_16x16x32_bf16(Bt[n][k], At[m][k], acc[ai][bj][m][n], 0, 0, 0); __builtin_amdgcn_s_setprio(0); } while (0)
#define PG8_WAIT_V(n) asm volatile("s_waitcnt vmcnt(" #n ")" ::: "memory")
#define PG8_WAIT_L(n) asm volatile("s_waitcnt lgkmcnt(" #n ")" ::: "memory")
#define PG8_BAR __builtin_amdgcn_s_barrier()
#define PG8_SCHED __builtin_amdgcn_sched_barrier(0)
    Unit cur, nxt; int ui = 0;
    if (!S.next(0, cur)) return;
    f32x4 acc[2][2][4][2];
#pragma unroll
    for (int a = 0; a < 2; ++a)
#pragma unroll
        for (int b = 0; b < 2; ++b)
#pragma unroll
            for (int m = 0; m < 4; ++m)
#pragma unroll
                for (int n = 0; n < 2; ++n) acc[a][b][m][n] = (f32x4){0.f, 0.f, 0.f, 0.f};
    bf16x8 At[4][2], B0[2][2], B1[2][2];
    const char* cA = (const char*)g.A + (size_t)cur.pm * tstep; const char* cB = (const char*)g.Bt + (size_t)cur.pn * tstep;
    S.a_ready(cur);
    PG8_STAGE(PG8_SB(0, 0), cB, voffB); PG8_STAGE(PG8_SA(0, 0), cA, voffA); PG8_STAGE(PG8_SB(0, 1), cB + hstep, voffB); PG8_STAGE(PG8_SA(0, 1), cA + hstep, voffA);
    if (wr == 1) PG8_BAR;
    PG8_WAIT_V(4); PG8_BAR;
    PG8_STAGE(PG8_SB(1, 0), cB + kstep, voffB); PG8_STAGE(PG8_SA(1, 0), cA + kstep, voffA); PG8_STAGE(PG8_SB(1, 1), cB + hstep + kstep, voffB);
    PG8_WAIT_V(6); PG8_BAR;
    PG8_STAMP();
    for (;;) {
        const bool has_next = S.next(ui + 1, nxt);
        const char* nA = has_next ? (const char*)g.A + (size_t)nxt.pm * tstep : cA; const char* nB = has_next ? (const char*)g.Bt + (size_t)nxt.pn * tstep : cB;
        for (int t = 0; t < nt; t += 2) {
            const bool last = (t == nt - 2);
            const char* a1 = cA + (size_t)(t + 1) * kstep;
            const char* a2 = last ? nA : cA + (size_t)(t + 2) * kstep; const char* b2 = last ? nB : cB + (size_t)(t + 2) * kstep;
            const char* a3 = a2 + kstep; const char* b3 = b2 + kstep;
            if (last && has_next) S.a_ready(nxt);
            PG8_LDB(B0, 0, 0); PG8_SCHED; PG8_LDA(At, 0, 0); PG8_STAGE(PG8_SA(1, 1), a1 + hstep, voffA);
            PG8_WAIT_L(8); PG8_BAR; PG8_WAIT_L(0); PG8_MMA(0, 0, At, B0); PG8_BAR; PG8_SCHED;
            PG8_LDB(B1, 0, 1); PG8_STAGE(PG8_SB(0, 0), b2, voffB);
            PG8_BAR; PG8_WAIT_L(0); PG8_MMA(0, 1, At, B1); PG8_BAR;
            PG8_LDA(At, 0, 1); PG8_STAGE(PG8_SA(0, 0), a2, voffA);
            PG8_BAR; PG8_WAIT_L(0); PG8_MMA(1, 0, At, B0); PG8_BAR; PG8_SCHED;
            PG8_STAGE(PG8_SB(0, 1), b2 + hstep, voffB);
            PG8_WAIT_V(6); PG8_BAR; PG8_MMA(1, 1, At, B1); PG8_BAR;
            PG8_LDB(B0, 1, 0); PG8_SCHED; PG8_LDA(At, 1, 0); PG8_STAGE(PG8_SA(0, 1), a2 + hstep, voffA);
            PG8_WAIT_L(8); PG8_BAR; PG8_WAIT_L(0); PG8_MMA(0, 0, At, B0); PG8_BAR; PG8_SCHED;
            PG8_LDB(B1, 1, 1); PG8_STAGE(PG8_SB(1, 0), b3, voffB);
            PG8_BAR; PG8_WAIT_L(0); PG8_MMA(0, 1, At, B1); PG8_BAR;
            PG8_LDA(At, 1, 1); PG8_STAGE(PG8_SA(1, 0), a3, voffA);
            PG8_BAR; PG8_WAIT_L(0); PG8_MMA(1, 0, At, B0); PG8_BAR; PG8_SCHED;
            PG8_STAGE(PG8_SB(1, 1), b3 + hstep, voffB);
            PG8_WAIT_V(6); PG8_BAR; PG8_MMA(1, 1, At, B1); PG8_BAR;
        }
        PG8_STAMP();
        if constexpr (!Epi::AFTER_DRAIN) { E(acc, cur, wr, wc, fr, fq); S.done(cur); }
        PG8_STAMP();
        if (!has_next) break;
#pragma unroll
        for (int a = 0; a < 2; ++a)
#pragma unroll
            for (int b = 0; b < 2; ++b)
#pragma unroll
                for (int m = 0; m < 4; ++m)
#pragma unroll
                    for (int n = 0; n < 2; ++n) acc[a][b][m][n] = (f32x4){0.f, 0.f, 0.f, 0.f};
        cur = nxt; cA = nA; cB = nB; ++ui;
    }
    PG8_WAIT_V(0);
    if (wr == 0) PG8_BAR;
    PG8_BAR;
    if constexpr (Epi::AFTER_DRAIN) { E.fused(acc, cur, wr, wc, fr, fq, lds, wid, lane); S.done(cur); }
    PG8_STAMP();
    if (STAMP && wid == 0) { stamps[lane] = lane < nts ? (((unsigned long long)(unsigned)ts_hi << 32) | (unsigned)ts_lo) : 0ull;
        if (lane == 62) stamps[62] = rt_entry; if (lane == 63) stamps[63] = (unsigned long long)wall_clock64(); }
#undef PG8_STAMP
#undef PG8_SA
#undef PG8_SB
#undef PG8_STAGE
#undef PG8_LDA
#undef PG8_LDB
#undef PG8_MMA
#undef PG8_WAIT_V
#undef PG8_WAIT_L
#undef PG8_BAR
#undef PG8_SCHED
}
}

namespace mk {
using pg8::bf16_t; using pg8::bf16x8; using pg8::f32x4; using pg8::u32x4; using pg8::Unit;
#define LAS __attribute__((address_space(3)))
typedef unsigned u32x2 __attribute__((ext_vector_type(2)));
typedef _Float16 f16;

constexpr int D = 1024, NB = 8, SEQ = 4096, CTX = 256, DIN = 8224, NPAD = 8448, DFF = 2816;
constexpr int BP = 4;
constexpr int NPASS = NB / BP;
constexpr int ML = BP * SEQ;
constexpr int MC = BP * CTX;
constexpr int MP = ML + MC;
constexpr float EPS = 1e-6f;
constexpr int NT = 512;
constexpr int LDS_XB = 158208;
constexpr int LDS_BYTES = LDS_XB + 16;

constexpr size_t SZ_WIN = (size_t)NPAD * D * 2, SZ_WOUT = (size_t)D * 2048 * 2, SZ_WGU = (size_t)2 * DFF * D * 2, SZ_WD = (size_t)D * DFF * 2;
constexpr size_t OFF_WIN = 0, OFF_WOUT = OFF_WIN + SZ_WIN, OFF_WGU = OFF_WOUT + SZ_WOUT, OFF_WD = OFF_WGU + SZ_WGU;
constexpr size_t OFF_MOD = OFF_WD + SZ_WD;
constexpr size_t OFF_LB = OFF_MOD + 9 * 6144 * 4;
constexpr size_t OFF_BAR = OFF_LB + 2048 * 4;
constexpr size_t BAR_BYTES = 16384;
constexpr size_t OFF_Q = OFF_BAR + BAR_BYTES;
constexpr size_t OFF_FR = OFF_Q + (size_t)MP * 1024 * 2;
constexpr size_t OFF_V = OFF_FR + (size_t)MP * 2048 * 2;
constexpr size_t OFF_DT = OFF_V + (size_t)MP * 1024 * 2;
constexpr size_t OFF_G = OFF_DT + (size_t)MP * 32 * 4;
constexpr size_t OFF_Z = OFF_G + (size_t)ML * 1024 * 2;
constexpr size_t OFF_XC = OFF_Z + (size_t)ML * 1024 * 2;
constexpr size_t OFF_X1 = OFF_XC + (size_t)MP * 2048 * 2;
constexpr size_t OFF_U = OFF_X1;
constexpr size_t OFF_XR = OFF_X1 + (size_t)MP * 1024 * 2;
constexpr size_t OFF_OH = OFF_X1;
constexpr size_t OFF_OS = OFF_X1 + (size_t)2 * ML * 1024 * 2;
constexpr size_t WS_END = OFF_X1 + (size_t)4 * ML * 1024 * 2;
constexpr size_t OFF_A2 = OFF_Q;
constexpr size_t OFF_H1 = OFF_X1;
constexpr size_t OFF_U2 = OFF_V;
constexpr size_t OFF_ACT = OFF_G;
static_assert((size_t)ML * 2048 * 2 <= (size_t)MP * 1024 * 2 + (size_t)MP * 2048 * 2, "A2 overlay");
static_assert((size_t)ML * DFF * 2 <= (size_t)2 * ML * 1024 * 2 + (size_t)MP * 2048 * 2, "ACT overlay");
static_assert((size_t)MP * 1024 * 2 + (size_t)MP * 2048 * 2 <= (size_t)4 * ML * 1024 * 2, "U+XR in X1");

struct Params {
    const float *x, *c, *ctx, *c_ctx, *w_ada, *b_ada, *norm_mix, *w_in, *conv_w, *conv_b, *a_log, *dt_bias, *ssd_d, *ssd_norm,
                *lb_raw, *hgrn_norm, *w_out, *norm_ffn, *w_gate, *w_up, *w_down, *final_norm;
    float* out; unsigned char* ws;
};

__device__ __forceinline__ float bf2f(unsigned short b) { return __uint_as_float(((unsigned)b) << 16); }
__device__ __forceinline__ float bflo(unsigned w) { return __uint_as_float(w << 16); }
__device__ __forceinline__ float bfhi(unsigned w) { return __uint_as_float(w & 0xffff0000u); }
__device__ __forceinline__ float h_lo(unsigned w) { return (float)__builtin_bit_cast(f16, (unsigned short)(w & 0xffffu)); }
__device__ __forceinline__ float h_hi(unsigned w) { return (float)__builtin_bit_cast(f16, (unsigned short)(w >> 16)); }
__device__ __forceinline__ unsigned pk2(float lo, float hi) { return pg8::cvt_pk_bf16(lo, hi); }
__device__ __forceinline__ unsigned short f2bf(float f) { return (unsigned short)(pk2(f, 0.f) & 0xffffu); }
__device__ __forceinline__ float siluf(float v) { return v * __builtin_amdgcn_rcpf(1.0f + __expf(-v)); }
__device__ __forceinline__ float wave_sum(float v) {
#pragma unroll
    for (int o = 1; o < 64; o <<= 1) v += __shfl_xor(v, o);
    return v;
}

__device__ __forceinline__ void p0_transpose_item(const float* W, int K, int N, bf16_t* WT, int k0, int n0, int drow0, LAS float* scr, int lane) {
#pragma unroll 8
    for (int i = 0; i < 32; ++i) { const int kk = 2 * i + (lane >> 5); scr[kk * 33 + (lane & 31)] = W[(size_t)(k0 + kk) * N + n0 + (lane & 31)]; }
    asm volatile("s_waitcnt vmcnt(0) lgkmcnt(0)" ::: "memory");
    const int c = lane & 7;
#pragma unroll
    for (int j = 0; j < 4; ++j) { const int n = (lane >> 3) + 8 * j; const LAS float* s = scr + (8 * c) * 33 + n;
        u32x4 o; o.x = pk2(s[0 * 33], s[1 * 33]); o.y = pk2(s[2 * 33], s[3 * 33]); o.z = pk2(s[4 * 33], s[5 * 33]); o.w = pk2(s[6 * 33], s[7 * 33]);
        *(u32x4*)(WT + (size_t)(drow0 + n) * K + k0 + 8 * c) = o; }
    asm volatile("s_waitcnt lgkmcnt(0)" ::: "memory");
}

__device__ __forceinline__ void phase_prep(const Params& P, LAS unsigned char* lds) {
    const int tid = opaque_tid(), lane = tid & 63, wave = tid >> 6;
    unsigned char* ws = P.ws;
    float* mod = (float*)(ws + OFF_MOD);
    LAS float* cs = (LAS float*)(lds + 18432);
    if (blockIdx.x < 96) {
        for (int e = tid; e < 9 * 1024; e += NT) { const float cv = (e < 8192) ? P.c[e] : P.c_ctx[e - 8192]; cs[e] = siluf(cv); }
        __syncthreads();
    }
    for (int item = blockIdx.x; item < 96; item += gridDim.x) {
        const int col = item * 64 + lane;
        float acc[9];
#pragma unroll
        for (int r = 0; r < 9; ++r) acc[r] = 0.f;
#pragma unroll 4
        for (int kk = 0; kk < 128; ++kk) {
            const int k = wave * 128 + kk;
            const float wv = P.w_ada[(size_t)k * 6144 + col];
#pragma unroll
            for (int r = 0; r < 9; ++r) acc[r] += cs[r * 1024 + k] * wv;
        }
        LAS float* red = (LAS float*)lds;
#pragma unroll
        for (int r = 0; r < 9; ++r) red[(wave * 9 + r) * 64 + lane] = acc[r];
        __syncthreads();
        for (int e = tid; e < 9 * 64; e += NT) { const int r = e >> 6, l = e & 63; float s = 0.f;
#pragma unroll
            for (int w = 0; w < 8; ++w) s += red[(w * 9 + r) * 64 + l];
            mod[r * 6144 + item * 64 + l] = s + P.b_ada[item * 64 + l]; }
        __syncthreads();
    }
    float* lbv = (float*)(ws + OFF_LB);
    for (int j = blockIdx.x * NT + tid; j < 2048; j += gridDim.x * NT) { const float r0 = P.lb_raw[j], r1 = P.lb_raw[2048 + j]; lbv[j] = 1.0f / (1.0f + __expf(r1 - r0)); }
    { u32x4* z = (u32x4*)(ws + OFF_WIN + (size_t)DIN * D * 2); const int n16 = (NPAD - DIN) * D * 2 / 16;
      for (int j = blockIdx.x * NT + tid; j < n16; j += gridDim.x * NT) z[j] = (u32x4){0u, 0u, 0u, 0u}; }
    LAS float* scr = (LAS float*)(lds + 55296 + wave * 8704);
    bf16_t* WinT = (bf16_t*)(ws + OFF_WIN); bf16_t* WoutT = (bf16_t*)(ws + OFF_WOUT); bf16_t* WguT = (bf16_t*)(ws + OFF_WGU); bf16_t* WdT = (bf16_t*)(ws + OFF_WD);
    constexpr int I_IN = (D / 64) * (DIN / 32), I_OUT = (2048 / 64) * (D / 32), I_G = (D / 64) * (DFF / 32), I_D = (DFF / 64) * (D / 32);
    constexpr int NITEMS = I_IN + I_OUT + 2 * I_G + I_D;
    const int gw = blockIdx.x * 8 + wave, NGW = gridDim.x * 8;
    for (int it = gw; it < NITEMS; it += NGW) {
        int r = it;
        if (r < I_IN) { const int nblk = DIN / 32, kb = r / nblk, nb = r % nblk; p0_transpose_item(P.w_in, D, DIN, WinT, 64 * kb, 32 * nb, 32 * nb, scr, lane); continue; } r -= I_IN;
        if (r < I_OUT) { const int nblk = D / 32, kb = r / nblk, nb = r % nblk; p0_transpose_item(P.w_out, 2048, D, WoutT, 64 * kb, 32 * nb, 32 * nb, scr, lane); continue; } r -= I_OUT;
        if (r < I_G) { const int nblk = DFF / 32, kb = r / nblk, nb = r % nblk, n0 = 32 * nb; p0_transpose_item(P.w_gate, D, DFF, WguT, 64 * kb, n0, (n0 >> 7) * 256 + (n0 & 127), scr, lane); continue; } r -= I_G;
        if (r < I_G) { const int nblk = DFF / 32, kb = r / nblk, nb = r % nblk, n0 = 32 * nb; p0_transpose_item(P.w_up, D, DFF, WguT, 64 * kb, n0, (n0 >> 7) * 256 + 128 + (n0 & 127), scr, lane); continue; } r -= I_G;
        { const int nblk = D / 32, kb = r / nblk, nb = r % nblk; p0_transpose_item(P.w_down, DFF, D, WdT, 64 * kb, 32 * nb, 32 * nb, scr, lane); }
    }
}

template <int MODE>
__device__ __forceinline__ void phase_norm(const Params& P, int pass) {
    const int tid_ = opaque_tid(); const int lane = tid_ & 63, wave = tid_ >> 6;
    const float* mod = (const float*)(P.ws + OFF_MOD);
    const int nrows = MODE == 0 ? MP : ML;
    bf16_t* outp = (bf16_t*)(P.ws + (MODE == 0 ? OFF_U : OFF_U2));
    const float* nw = MODE == 0 ? P.norm_mix : P.norm_ffn;
    for (int r = blockIdx.x * 8 + wave; r < nrows; r += gridDim.x * 8) {
        const float* src; int mrow;
        if (MODE == 0) {
            if (r < ML) { src = P.x + ((size_t)pass * ML + r) * D; mrow = pass * BP + (r >> 12); }
            else { const int rc = r - ML; src = P.ctx + ((size_t)pass * MC + rc) * D; mrow = 8; }
        } else { src = (const float*)(P.ws + OFF_H1) + (size_t)r * D; mrow = pass * BP + (r >> 12); }
        const float* sh = mod + mrow * 6144 + (MODE == 0 ? 0 : 3072); const float* sc = sh + 1024;
        f32x4 v[4]; float ss = 0.f;
#pragma unroll
        for (int j = 0; j < 4; ++j) { v[j] = *(const f32x4*)(src + 256 * j + 4 * lane); ss += (v[j].x * v[j].x + v[j].y * v[j].y) + (v[j].z * v[j].z + v[j].w * v[j].w); }
        const float rstd = rsqrtf(wave_sum(ss) * (1.0f / D) + EPS);
#pragma unroll
        for (int j = 0; j < 4; ++j) { const int c0 = 256 * j + 4 * lane;
            const f32x4 w = *(const f32x4*)(nw + c0), s1 = *(const f32x4*)(sc + c0), s0 = *(const f32x4*)(sh + c0);
            const f32x4 o = (v[j] * rstd * w) * (1.0f + s1) + s0;
            u32x2 pk; pk.x = pk2(o.x, o.y); pk.y = pk2(o.z, o.w);
            *(u32x2*)(outp + (size_t)r * D + c0) = pk; }
    }
}

__device__ __forceinline__ void phase_final_norm(const Params& P, int pass) {
    const int tid_ = opaque_tid(); const int lane = tid_ & 63, wave = tid_ >> 6;
    for (int r = blockIdx.x * 8 + wave; r < ML; r += gridDim.x * 8) {
        float* row = P.out + ((size_t)pass * ML + r) * D;
        f32x4 v[4]; float ss = 0.f;
#pragma unroll
        for (int j = 0; j < 4; ++j) { v[j] = *(const f32x4*)(row + 256 * j + 4 * lane); ss += (v[j].x * v[j].x + v[j].y * v[j].y) + (v[j].z * v[j].z + v[j].w * v[j].w); }
        const float rstd = rsqrtf(wave_sum(ss) * (1.0f / D) + EPS);
#pragma unroll
        for (int j = 0; j < 4; ++j) { const int c0 = 256 * j + 4 * lane; const f32x4 w = *(const f32x4*)(P.final_norm + c0);
            *(f32x4*)(row + c0) = v[j] * rstd * w; }
    }
}

struct EpiIn {
    static constexpr bool PERM = true, AFTER_DRAIN = false;
    unsigned char* ws; const float* dt_bias;
    __device__ __forceinline__ void operator()(const f32x4 (&acc)[2][2][4][2], const Unit& u, int wr, int wc, int fr, int fq) const {
        const int pn = u.pn; const bool lat = u.pm < (ML / 256);
        int kind, ld, cofs; size_t off;
        float scale = 1.0f;
        if (pn < 4) { kind = lat ? 0 : 4; off = OFF_Q; ld = 1024; cofs = 0; scale = 0.08838834764831845f; }
        else if (pn < 12) { kind = 2; off = OFF_FR; ld = 2048; cofs = 1024; }
        else if (pn < 16) { kind = 1; off = OFF_V; ld = 1024; cofs = 3072; }
        else if (pn < 20) { kind = lat ? 0 : 4; off = OFF_G; ld = 1024; cofs = 4096; }
        else if (pn < 24) { kind = lat ? 0 : 4; off = OFF_Z; ld = 1024; cofs = 5120; }
        else if (pn < 32) { kind = 1; off = OFF_XR; ld = 2048; cofs = 6144; }
        else { kind = 3; off = OFF_DT; ld = 32; cofs = 8192; }
        if (kind == 4) return;
        const int row0 = u.pm * 256 + wr * 64 + fr;
        if (kind == 3) {
            if (wc != 0) return;
            float* DT = (float*)(ws + off);
            const f32x4 b0 = *(const f32x4*)(dt_bias + 8 * fq), b1 = *(const f32x4*)(dt_bias + 8 * fq + 4);
#pragma unroll
            for (int ai = 0; ai < 2; ++ai)
#pragma unroll
                for (int m = 0; m < 4; ++m) { const int row = row0 + ai * 128 + m * 16;
                    f32x4 v0 = acc[ai][0][m][0] + b0, v1 = acc[ai][0][m][1] + b1;
#pragma unroll
                    for (int j = 0; j < 4; ++j) { v0[j] = v0[j] > 20.f ? v0[j] : log1pf(__expf(v0[j])); v1[j] = v1[j] > 20.f ? v1[j] : log1pf(__expf(v1[j])); }
                    *(f32x4*)(DT + (size_t)row * 32 + 8 * fq) = v0; *(f32x4*)(DT + (size_t)row * 32 + 8 * fq + 4) = v1; }
            return;
        }
        unsigned short* O = (unsigned short*)(ws + off);
        const int col0 = pn * 256 - cofs + wc * 32 + 8 * fq;
#pragma unroll
        for (int ai = 0; ai < 2; ++ai)
#pragma unroll
            for (int m = 0; m < 4; ++m) { unsigned short* rowp = O + (size_t)(row0 + ai * 128 + m * 16) * ld + col0;
#pragma unroll
                for (int bj = 0; bj < 2; ++bj) { f32x4 v0 = acc[ai][bj][m][0], v1 = acc[ai][bj][m][1]; u32x4 w;
                    if (kind == 0) {
#pragma unroll
                        for (int j = 0; j < 4; ++j) { v0[j] = siluf(v0[j]) * scale; v1[j] = siluf(v1[j]) * scale; } }
                    if (kind == 2) {
                        typedef f16 h2 __attribute__((ext_vector_type(2)));
                        const float* lbp = (const float*)(ws + OFF_LB) + col0 + bj * 128;
                        const f32x4 l0 = *(const f32x4*)lbp, l1 = *(const f32x4*)(lbp + 4);
#pragma unroll
                        for (int j = 0; j < 4; ++j) { const float x0 = fminf(fmaxf(v0[j], -30.f), 30.f), x1 = fminf(fmaxf(v1[j], -30.f), 30.f);
                            v0[j] = (1.0f - l0[j]) * __builtin_amdgcn_rcpf(1.0f + __expf(x0)); v1[j] = (1.0f - l1[j]) * __builtin_amdgcn_rcpf(1.0f + __expf(x1)); }
                        h2 a = {(f16)v0[0], (f16)v0[1]}, b = {(f16)v0[2], (f16)v0[3]}, c = {(f16)v1[0], (f16)v1[1]}, d = {(f16)v1[2], (f16)v1[3]};
                        w.x = __builtin_bit_cast(unsigned, a); w.y = __builtin_bit_cast(unsigned, b); w.z = __builtin_bit_cast(unsigned, c); w.w = __builtin_bit_cast(unsigned, d);
                    } else { w.x = pk2(v0[0], v0[1]); w.y = pk2(v0[2], v0[3]); w.z = pk2(v1[0], v1[1]); w.w = pk2(v1[2], v1[3]); }
                    *(u32x4*)(rowp + bj * 128) = w; } }
    }
};
struct EpiOut {
    static constexpr bool PERM = false, AFTER_DRAIN = false;
    const float* x; const float* mod; float* H1; int pass;
    __device__ __forceinline__ void operator()(const f32x4 (&acc)[2][2][4][2], const Unit& u, int wr, int wc, int fr, int fq) const {
        const int row0 = u.pm * 256 + wr * 64 + fr, col0 = u.pn * 256 + wc * 32 + 4 * fq;
        const float* g1 = mod + (size_t)(pass * BP + (u.pm >> 4)) * 6144 + 2048;
        f32x4 gv[2][2];
#pragma unroll
        for (int bj = 0; bj < 2; ++bj)
#pragma unroll
            for (int n = 0; n < 2; ++n) gv[bj][n] = *(const f32x4*)(g1 + col0 + bj * 128 + n * 16);
#pragma unroll
        for (int ai = 0; ai < 2; ++ai)
#pragma unroll
            for (int m = 0; m < 4; ++m) { const int row = row0 + ai * 128 + m * 16; const float* xr = x + ((size_t)pass * ML + row) * D + col0; float* hr = H1 + (size_t)row * D + col0;
#pragma unroll
                for (int bj = 0; bj < 2; ++bj)
#pragma unroll
                    for (int n = 0; n < 2; ++n) *(f32x4*)(hr + bj * 128 + n * 16) = *(const f32x4*)(xr + bj * 128 + n * 16) + gv[bj][n] * acc[ai][bj][m][n]; }
    }
};
struct EpiGU {
    static constexpr bool PERM = true, AFTER_DRAIN = false;
    bf16_t* ACT;
    __device__ __forceinline__ void operator()(const f32x4 (&acc)[2][2][4][2], const Unit& u, int wr, int wc, int fr, int fq) const {
        const int row0 = u.pm * 256 + wr * 64 + fr, col0 = u.pn * 128 + wc * 32 + 8 * fq;
#pragma unroll
        for (int ai = 0; ai < 2; ++ai)
#pragma unroll
            for (int m = 0; m < 4; ++m) { bf16_t* rowp = ACT + (size_t)(row0 + ai * 128 + m * 16) * DFF + col0;
                f32x4 g0 = acc[ai][0][m][0], g1 = acc[ai][0][m][1]; const f32x4 u0 = acc[ai][1][m][0], u1 = acc[ai][1][m][1];
#pragma unroll
                for (int j = 0; j < 4; ++j) { g0[j] = siluf(g0[j]) * u0[j]; g1[j] = siluf(g1[j]) * u1[j]; }
                u32x4 w; w.x = pk2(g0[0], g0[1]); w.y = pk2(g0[2], g0[3]); w.z = pk2(g1[0], g1[1]); w.w = pk2(g1[2], g1[3]);
                *(u32x4*)rowp = w; }
    }
};
struct EpiDown {
    static constexpr bool PERM = false, AFTER_DRAIN = false;
    const float* H1; const float* mod; float* out; int pass;
    __device__ __forceinline__ void operator()(const f32x4 (&acc)[2][2][4][2], const Unit& u, int wr, int wc, int fr, int fq) const {
        const int row0 = u.pm * 256 + wr * 64 + fr, col0 = u.pn * 256 + wc * 32 + 4 * fq;
        const float* g2 = mod + (size_t)(pass * BP + (u.pm >> 4)) * 6144 + 5120;
        f32x4 gv[2][2];
#pragma unroll
        for (int bj = 0; bj < 2; ++bj)
#pragma unroll
            for (int n = 0; n < 2; ++n) gv[bj][n] = *(const f32x4*)(g2 + col0 + bj * 128 + n * 16);
#pragma unroll
        for (int ai = 0; ai < 2; ++ai)
#pragma unroll
            for (int m = 0; m < 4; ++m) { const int row = row0 + ai * 128 + m * 16; const float* hr = H1 + (size_t)row * D + col0; float* orow = out + ((size_t)pass * ML + row) * D + col0;
#pragma unroll
                for (int bj = 0; bj < 2; ++bj)
#pragma unroll
                    for (int n = 0; n < 2; ++n) *(f32x4*)(orow + bj * 128 + n * 16) = *(const f32x4*)(hr + bj * 128 + n * 16) + gv[bj][n] * acc[ai][bj][m][n]; }
    }
};

__device__ __forceinline__ void phase_conv(const Params& P) {
    const bf16_t* XR = (const bf16_t*)(P.ws + OFF_XR); bf16_t* XC = (bf16_t*)(P.ws + OFF_XC);
    constexpr int SEGL = 32, NSEG = MP / SEGL, NITEM = NSEG * 256;
    for (int it = blockIdx.x * NT + opaque_tid(); it < NITEM; it += gridDim.x * NT) {
        const int seg = it >> 8, cg8 = (it & 255) * 8, r0 = seg * SEGL;
        int L0, L1;
        if (r0 < ML) { L0 = r0 & ~63; L1 = L0 + 64; } else { const int rc = r0 - ML; L0 = ML + (rc & ~255); L1 = L0 + 256; }
        float w[5][8], bias[8];
#pragma unroll
        for (int k = 0; k < 5; ++k) { const f32x4 a = *(const f32x4*)(P.conv_w + k * 2048 + cg8), b = *(const f32x4*)(P.conv_w + k * 2048 + cg8 + 4);
            w[k][0] = a.x; w[k][1] = a.y; w[k][2] = a.z; w[k][3] = a.w; w[k][4] = b.x; w[k][5] = b.y; w[k][6] = b.z; w[k][7] = b.w; }
        { const f32x4 a = *(const f32x4*)(P.conv_b + cg8), b = *(const f32x4*)(P.conv_b + cg8 + 4);
          bias[0] = a.x; bias[1] = a.y; bias[2] = a.z; bias[3] = a.w; bias[4] = b.x; bias[5] = b.y; bias[6] = b.z; bias[7] = b.w; }
        u32x4 win[5];
        const u32x4 zero4 = {0u, 0u, 0u, 0u};
#pragma unroll
        for (int k = 0; k < 4; ++k) { const int r = r0 - 2 + k; win[k] = (r >= L0 && r < L1) ? *(const u32x4*)(XR + (size_t)r * 2048 + cg8) : zero4; }
        for (int t = 0; t < SEGL; ++t) {
            const int r = r0 + t + 2; win[4] = (r >= L0 && r < L1) ? *(const u32x4*)(XR + (size_t)r * 2048 + cg8) : zero4;
            float o[8];
#pragma unroll
            for (int e = 0; e < 8; ++e) o[e] = bias[e];
#pragma unroll
            for (int k = 0; k < 5; ++k) {
                o[0] += w[k][0] * bflo(win[k].x); o[1] += w[k][1] * bfhi(win[k].x); o[2] += w[k][2] * bflo(win[k].y); o[3] += w[k][3] * bfhi(win[k].y);
                o[4] += w[k][4] * bflo(win[k].z); o[5] += w[k][5] * bfhi(win[k].z); o[6] += w[k][6] * bflo(win[k].w); o[7] += w[k][7] * bfhi(win[k].w); }
            u32x4 pk; pk.x = pk2(siluf(o[0]), siluf(o[1])); pk.y = pk2(siluf(o[2]), siluf(o[3])); pk.z = pk2(siluf(o[4]), siluf(o[5])); pk.w = pk2(siluf(o[6]), siluf(o[7]));
            *(u32x4*)(XC + (size_t)(r0 + t) * 2048 + cg8) = pk;
            win[0] = win[1]; win[1] = win[2]; win[2] = win[3]; win[3] = win[4];
        }
    }
}

constexpr int L_AQ = 0  , L_AK = 34816  , L_KET = 69632  , L_VVT = 106496  , L_SC = 124928, L_ST = 134144, L_SEG = 151552, L_DEC = 155648  , L_CUM = 156672  , L_DTV = 157184  , L_EE = 157696  , L_SCAN_END = 158208;
constexpr int SZ_AQ = 17408;
constexpr int SZ_KET = 18432, SZ_VVT = 9216, SZ_DEC = 512, SZ_CUM = 256;
constexpr int PA = 272, PB = 144;

#define MFMA16(a, b, c) __builtin_amdgcn_mfma_f32_16x16x32_bf16((a), (b), (c), 0, 0, 0)

template <bool SSD>
__device__ __forceinline__ void scan_item(const Params& P, LAS unsigned char* lds, int pass, int it) {
    const int tid = opaque_tid(), lane = tid & 63, wave = __builtin_amdgcn_readfirstlane(tid >> 6);
    const int l15 = lane & 15, lq = lane >> 4;
    unsigned char* ws = P.ws;
    int bl, dir, head, vh = 0;
    if (!SSD) { bl = it >> 5; dir = (it >> 4) & 1; head = (it >> 1) & 7; vh = it & 1; }
    else { bl = it >> 5; dir = (it >> 4) & 1; head = it & 15; }
    auto chunk_base = [&](int step) -> int {
        if (step < 4) { const int c = dir ? 3 - step : step; return ML + bl * CTX + c * 64; }
        const int c = dir ? 63 - (step - 4) : step - 4; return bl * SEQ + c * 64; };

    if (wave >= 4) {
        const int ptid = tid - 256, pw = wave - 4;
        const int f4 = ptid & 31, seg = ptid >> 5;
        const int v4 = ptid & 15, tq = ptid >> 4;
        const unsigned short *srcA, *srcB, *srcV; int ldA, ldB, ldV;
        if (!SSD) { srcA = (const unsigned short*)(ws + OFF_Q) + head * 128 + f4 * 4; ldA = 1024;
                    srcB = (const unsigned short*)(ws + OFF_FR) + dir * 1024 + head * 128 + f4 * 4; ldB = 2048;
                    srcV = (const unsigned short*)(ws + OFF_V) + head * 128 + vh * 64 + v4 * 4; ldV = 1024; }
        else { const int g = head >> 2;
               srcA = (const unsigned short*)(ws + OFF_XC) + 1536 + g * 128 + f4 * 4; ldA = 2048;
               srcB = (const unsigned short*)(ws + OFF_XC) + 1024 + g * 128 + f4 * 4; ldB = 2048;
               srcV = (const unsigned short*)(ws + OFF_XC) + head * 64 + v4 * 4; ldV = 2048; }
        const float* DT = (const float*)(ws + OFF_DT) + dir * 16 + head;
        float a_neg = 0.f;
        if (SSD) a_neg = -__expf(P.a_log[dir * 16 + head]);
        u32x2 ra[8], rb[8], rv[4]; float rdt = 0.f;
        auto load_ab = [&](int step) { const int base = chunk_base(step);
#pragma unroll
            for (int ii = 0; ii < 8; ++ii) { const int i = seg * 8 + ii; const int row = base + (dir ? 63 - i : i);
                ra[ii] = *(const u32x2*)(srcA + (size_t)row * ldA); rb[ii] = *(const u32x2*)(srcB + (size_t)row * ldB); } };
        auto load_v = [&](int step) { const int base = chunk_base(step);
#pragma unroll
            for (int ii = 0; ii < 4; ++ii) { const int i = tq * 4 + ii; const int row = base + (dir ? 63 - i : i); rv[ii] = *(const u32x2*)(srcV + (size_t)row * ldV); } };
        auto load_dt = [&](int step) { if (pw == 0) { const int row = chunk_base(step) + (dir ? 63 - lane : lane); rdt = DT[(size_t)row * 32]; } };
        float cumv[8][4], kk[8][4], qq[8][4];
        load_ab(0); load_v(0); if (SSD) load_dt(0);
        for (int n = -1; n < 68; ++n) {
            if (n == 67) { __syncthreads(); __syncthreads(); continue; }
            const int q = (n + 1) & 1;
            LAS unsigned char* KETq = lds + L_KET + q * SZ_KET; LAS unsigned char* VVTq = lds + L_VVT + q * SZ_VVT;
            if (!SSD) {
                float run[4] = {1.f, 1.f, 1.f, 1.f};
#pragma unroll
                for (int ii = 0; ii < 8; ++ii) {
                    kk[ii][0] = h_lo(rb[ii].x); kk[ii][1] = h_hi(rb[ii].x); kk[ii][2] = h_lo(rb[ii].y); kk[ii][3] = h_hi(rb[ii].y);
                    qq[ii][0] = bflo(ra[ii].x); qq[ii][1] = bfhi(ra[ii].x); qq[ii][2] = bflo(ra[ii].y); qq[ii][3] = bfhi(ra[ii].y);
#pragma unroll
                    for (int c = 0; c < 4; ++c) { run[c] *= 1.0f - kk[ii][c]; cumv[ii][c] = run[c]; }
                }
                *(LAS f32x4*)(lds + L_SEG + (seg * 128 + f4 * 4) * 4) = (f32x4){run[0], run[1], run[2], run[3]};
#pragma unroll
                for (int c = 0; c < 4; ++c) {
                    const unsigned w0 = (c < 2) ? rv[0].x : rv[0].y, w1 = (c < 2) ? rv[1].x : rv[1].y, w2 = (c < 2) ? rv[2].x : rv[2].y, w3 = (c < 2) ? rv[3].x : rv[3].y;
                    const unsigned sh = (c & 1) * 16;
                    u32x2 o; o.x = ((w0 >> sh) & 0xffffu) | (((w1 >> sh) & 0xffffu) << 16); o.y = ((w2 >> sh) & 0xffffu) | (((w3 >> sh) & 0xffffu) << 16);
                    *(LAS u32x2*)(VVTq + (v4 * 4 + c) * PB + tq * 8) = o; }
                if (n + 2 < 68) { load_ab(n + 2); load_v(n + 2); }
            } else {
                if (pw == 0) {
                    float c = rdt * a_neg;
#pragma unroll
                    for (int o = 1; o < 64; o <<= 1) { const float t = __shfl_up(c, o); if (lane >= o) c += t; }
                    const float tot = __shfl(c, 63);
                    *(LAS float*)(lds + L_CUM + q * SZ_CUM + lane * 4) = c; *(LAS float*)(lds + L_DTV + q * SZ_CUM + lane * 4) = rdt;
                    *(LAS float*)(lds + L_EE + q * SZ_CUM + lane * 4) = __expf(tot - c);
                    if (lane == 0) *(LAS float*)(lds + L_SEG) = __expf(tot);
                    if (n + 2 < 68) load_dt(n + 2);
                }
            }
            __syncthreads();
            if (!SSD) {
                float offs[4] = {1.f, 1.f, 1.f, 1.f}, tot[4] = {1.f, 1.f, 1.f, 1.f};
#pragma unroll
                for (int s = 0; s < 8; ++s) { const f32x4 t = *(const LAS f32x4*)(lds + L_SEG + (s * 128 + f4 * 4) * 4);
#pragma unroll
                    for (int c = 0; c < 4; ++c) { tot[c] *= t[c]; if (s < seg) offs[c] *= t[c]; } }
                float ke[8][4];
#pragma unroll
                for (int ii = 0; ii < 8; ++ii) { const int i = seg * 8 + ii; float aq[4], ak[4];
#pragma unroll
                    for (int c = 0; c < 4; ++c) { const float eq = offs[c] * cumv[ii][c]; const float ki = kk[ii][c] * __builtin_amdgcn_rcpf(eq);
                        aq[c] = qq[ii][c] * eq; ak[c] = ki; ke[ii][c] = ki * tot[c]; }
                    *(LAS u32x2*)(lds + L_AQ + q * SZ_AQ + i * PA + f4 * 8) = (u32x2){pk2(aq[0], aq[1]), pk2(aq[2], aq[3])};
                    *(LAS u32x2*)(lds + L_AK + q * SZ_AQ + i * PA + f4 * 8) = (u32x2){pk2(ak[0], ak[1]), pk2(ak[2], ak[3])}; }
#pragma unroll
                for (int c = 0; c < 4; ++c)
                    *(LAS u32x4*)(KETq + (f4 * 4 + c) * PB + seg * 16) = (u32x4){pk2(ke[0][c], ke[1][c]), pk2(ke[2][c], ke[3][c]), pk2(ke[4][c], ke[5][c]), pk2(ke[6][c], ke[7][c])};
                if (seg == 0) *(LAS f32x4*)(lds + L_DEC + q * SZ_DEC + f4 * 16) = (f32x4){tot[0], tot[1], tot[2], tot[3]};
            } else {
                const LAS float* EE = (const LAS float*)(lds + L_EE + q * SZ_CUM); const LAS float* DTV = (const LAS float*)(lds + L_DTV + q * SZ_CUM);
                if (ptid == 0) *(LAS float*)(lds + L_DEC + q * SZ_DEC) = *(const LAS float*)(lds + L_SEG);
                float ke[8][4];
#pragma unroll
                for (int ii = 0; ii < 8; ++ii) { const int i = seg * 8 + ii; const float ee = EE[i];
                    *(LAS u32x2*)(lds + L_AQ + q * SZ_AQ + i * PA + f4 * 8) = ra[ii];
                    *(LAS u32x2*)(lds + L_AK + q * SZ_AQ + i * PA + f4 * 8) = rb[ii];
                    ke[ii][0] = bflo(rb[ii].x) * ee; ke[ii][1] = bfhi(rb[ii].x) * ee; ke[ii][2] = bflo(rb[ii].y) * ee; ke[ii][3] = bfhi(rb[ii].y) * ee; }
#pragma unroll
                for (int c = 0; c < 4; ++c)
                    *(LAS u32x4*)(KETq + (f4 * 4 + c) * PB + seg * 16) = (u32x4){pk2(ke[0][c], ke[1][c]), pk2(ke[2][c], ke[3][c]), pk2(ke[4][c], ke[5][c]), pk2(ke[6][c], ke[7][c])};
                float xv[4][4];
#pragma unroll
                for (int ii = 0; ii < 4; ++ii) { const float d = DTV[tq * 4 + ii];
                    xv[ii][0] = bflo(rv[ii].x) * d; xv[ii][1] = bfhi(rv[ii].x) * d; xv[ii][2] = bflo(rv[ii].y) * d; xv[ii][3] = bfhi(rv[ii].y) * d; }
#pragma unroll
                for (int c = 0; c < 4; ++c) *(LAS u32x2*)(VVTq + (v4 * 4 + c) * PB + tq * 8) = (u32x2){pk2(xv[0][c], xv[1][c]), pk2(xv[2][c], xv[3][c])};
                if (n + 2 < 68) { load_ab(n + 2); load_v(n + 2); }
            }
            __syncthreads();
        }
    } else {
        unsigned short* Oout = SSD ? (unsigned short*)(ws + OFF_OS) + (size_t)dir * ML * 1024 + head * 64
                                   : (unsigned short*)(ws + OFF_OH) + (size_t)dir * ML * 1024 + head * 128 + vh * 64;
        f32x4 sacc[2][4];
#pragma unroll
        for (int a = 0; a < 2; ++a)
#pragma unroll
            for (int t = 0; t < 4; ++t) sacc[a][t] = (f32x4){0.f, 0.f, 0.f, 0.f};
        const int ti = wave;
        bf16x8 vv[4][2];
        for (int n = -1; n < 68; ++n) {
            if (n < 0) { __syncthreads(); __syncthreads(); continue; }
            const int p = n & 1;
            if (n >= 1) {
                const int pp = p ^ 1;
                const LAS unsigned char* KETp = lds + L_KET + pp * SZ_KET;
#pragma unroll
                for (int a = 0; a < 2; ++a) { const int f0 = wave * 32 + a * 16;
                    f32x4 dv;
                    if (!SSD) dv = *(const LAS f32x4*)(lds + L_DEC + pp * SZ_DEC + (f0 + lq * 4) * 4);
                    else { const float d = *(const LAS float*)(lds + L_DEC + pp * SZ_DEC); dv = (f32x4){d, d, d, d}; }
                    bf16x8 ak[2];
#pragma unroll
                    for (int k = 0; k < 2; ++k) ak[k] = *(const LAS bf16x8*)(KETp + (f0 + l15) * PB + k * 64 + lq * 16);
#pragma unroll
                    for (int tv = 0; tv < 4; ++tv) { f32x4 s = sacc[a][tv] * dv;
#pragma unroll
                        for (int k = 0; k < 2; ++k) s = MFMA16(ak[k], vv[tv][k], s);
                        sacc[a][tv] = s;
                        u32x2 w; w.x = pk2(s[0], s[1]); w.y = pk2(s[2], s[3]);
                        *(LAS u32x2*)(lds + L_ST + (tv * 16 + l15) * PA + (f0 + lq * 4) * 2) = w; } }
            }
            __syncthreads();
            const bool isctx = n < 4;
            const int base = chunk_base(n);
            const LAS float* CUM = (const LAS float*)(lds + L_CUM + p * SZ_CUM);
            const LAS unsigned char* VVTp = lds + L_VVT + p * SZ_VVT;
            const LAS unsigned char* AQp = lds + L_AQ + p * SZ_AQ; const LAS unsigned char* AKp = lds + L_AK + p * SZ_AQ;
#pragma unroll
            for (int tv = 0; tv < 4; ++tv)
#pragma unroll
                for (int k = 0; k < 2; ++k) vv[tv][k] = *(const LAS bf16x8*)(VVTp + (tv * 16 + l15) * PB + k * 64 + lq * 16);
            if (!isctx) {
                bf16x8 bq[4];
#pragma unroll
                for (int k = 0; k < 4; ++k) bq[k] = *(const LAS bf16x8*)(AQp + (ti * 16 + l15) * PA + k * 64 + lq * 16);
                const int i = ti * 16 + l15;
                float ci = 0.f; if (SSD) ci = CUM[i];
#pragma unroll
                for (int tj = 0; tj < 4; ++tj) { const int j0 = tj * 16 + lq * 4;
                    u32x2 w = {0u, 0u};
                    if (tj <= ti) {
                        f32x4 a = {0.f, 0.f, 0.f, 0.f};
#pragma unroll
                        for (int k = 0; k < 4; ++k) { const bf16x8 ak = *(const LAS bf16x8*)(AKp + (tj * 16 + l15) * PA + k * 64 + lq * 16); a = MFMA16(ak, bq[k], a); }
#pragma unroll
                        for (int jj = 0; jj < 4; ++jj) { const int j = j0 + jj; float v = a[jj];
                            if (SSD) v *= __expf(fminf(ci - CUM[j], 0.f));
                            a[jj] = (j <= i) ? v : 0.f; }
                        w.x = pk2(a[0], a[1]); w.y = pk2(a[2], a[3]);
                    }
                    *(LAS u32x2*)(lds + L_SC + i * PB + j0 * 2) = w; }
                asm volatile("" ::: "memory"); __builtin_amdgcn_wave_barrier(); asm volatile("" ::: "memory");
                bf16x8 bs[2];
#pragma unroll
                for (int k = 0; k < 2; ++k) bs[k] = *(const LAS bf16x8*)(lds + L_SC + (ti * 16 + l15) * PB + k * 64 + lq * 16);
                const int row = base + (dir ? 63 - i : i);
                float rs = 1.0f; if (SSD) rs = __expf(ci);
#pragma unroll
                for (int tv = 0; tv < 4; ++tv) {
                    f32x4 a1 = {0.f, 0.f, 0.f, 0.f}, a2 = {0.f, 0.f, 0.f, 0.f};
#pragma unroll
                    for (int k = 0; k < 2; ++k) a1 = MFMA16(vv[tv][k], bs[k], a1);
#pragma unroll
                    for (int k = 0; k < 4; ++k) { const bf16x8 as = *(const LAS bf16x8*)(lds + L_ST + (tv * 16 + l15) * PA + k * 64 + lq * 16); a2 = MFMA16(as, bq[k], a2); }
                    const f32x4 o = a1 + a2 * rs;
                    u32x2 w; w.x = pk2(o[0], o[1]); w.y = pk2(o[2], o[3]);
                    *(u32x2*)(Oout + (size_t)row * 1024 + tv * 16 + lq * 4) = w; }
            }
            __syncthreads();
        }
    }
    __syncthreads();
}

__device__ __forceinline__ void phase_scan(const Params& P, LAS unsigned char* lds, int pass) {
    for (int it = blockIdx.x; it < 256; it += gridDim.x) {
        if (it < 128) scan_item<false>(P, lds, pass, it); else scan_item<true>(P, lds, pass, it - 128);
    }
}

__device__ __forceinline__ void unpack8(const u32x4 w, float (&o)[8]) { o[0] = bflo(w.x); o[1] = bfhi(w.x); o[2] = bflo(w.y); o[3] = bfhi(w.y); o[4] = bflo(w.z); o[5] = bfhi(w.z); o[6] = bflo(w.w); o[7] = bfhi(w.w); }
__device__ __forceinline__ void phase_readout(const Params& P) {
    const int tid_ = opaque_tid(); const int lane = tid_ & 63, wave = tid_ >> 6;
    unsigned char* ws = P.ws;
    const bf16_t* OH = (const bf16_t*)(ws + OFF_OH); const bf16_t* OS = (const bf16_t*)(ws + OFF_OS);
    const bf16_t* G = (const bf16_t*)(ws + OFF_G); const bf16_t* Z = (const bf16_t*)(ws + OFF_Z); const bf16_t* XC = (const bf16_t*)(ws + OFF_XC);
    bf16_t* A2 = (bf16_t*)(ws + OFF_A2);
    const int c0 = lane * 16;
    float hw[16], sw[16];
#pragma unroll
    for (int e = 0; e < 16; ++e) { hw[e] = P.hgrn_norm[(c0 + e) & 127]; sw[e] = P.ssd_norm[c0 + e]; }
    const float dsk = P.ssd_d[lane >> 2];
    for (int r = blockIdx.x * 8 + wave; r < ML; r += gridDim.x * 8) {
        float o[16], t[8];
        { const u32x4* p0 = (const u32x4*)(OH + (size_t)r * 1024 + c0); const u32x4* p1 = (const u32x4*)(OH + ((size_t)ML + r) * 1024 + c0); const u32x4* pg = (const u32x4*)(G + (size_t)r * 1024 + c0);
          const u32x4 a0 = p0[0], a1 = p0[1], b0 = p1[0], b1 = p1[1], g0 = pg[0], g1 = pg[1];
          unpack8(a0, t);
#pragma unroll
          for (int e = 0; e < 8; ++e) o[e] = t[e];
          unpack8(a1, t);
#pragma unroll
          for (int e = 0; e < 8; ++e) o[8 + e] = t[e];
          unpack8(b0, t);
#pragma unroll
          for (int e = 0; e < 8; ++e) o[e] += t[e];
          unpack8(b1, t);
#pragma unroll
          for (int e = 0; e < 8; ++e) o[8 + e] += t[e];
          float ss = 0.f;
#pragma unroll
          for (int e = 0; e < 16; ++e) ss += o[e] * o[e];
          ss += __shfl_xor(ss, 1); ss += __shfl_xor(ss, 2); ss += __shfl_xor(ss, 4);
          const float rstd = rsqrtf(ss * (1.0f / 128.0f) + EPS);
          float gg[16]; unpack8(g0, t);
#pragma unroll
          for (int e = 0; e < 8; ++e) gg[e] = t[e];
          unpack8(g1, t);
#pragma unroll
          for (int e = 0; e < 8; ++e) gg[8 + e] = t[e];
#pragma unroll
          for (int e = 0; e < 16; ++e) o[e] = o[e] * rstd * hw[e] * gg[e];
          u32x4 w0, w1; w0.x = pk2(o[0], o[1]); w0.y = pk2(o[2], o[3]); w0.z = pk2(o[4], o[5]); w0.w = pk2(o[6], o[7]);
          w1.x = pk2(o[8], o[9]); w1.y = pk2(o[10], o[11]); w1.z = pk2(o[12], o[13]); w1.w = pk2(o[14], o[15]);
          u32x4* po = (u32x4*)(A2 + (size_t)r * 2048 + c0); po[0] = w0; po[1] = w1; }
        { const u32x4* p0 = (const u32x4*)(OS + (size_t)r * 1024 + c0); const u32x4* p1 = (const u32x4*)(OS + ((size_t)ML + r) * 1024 + c0);
          const u32x4* pz = (const u32x4*)(Z + (size_t)r * 1024 + c0); const u32x4* px = (const u32x4*)(XC + (size_t)r * 2048 + c0);
          const u32x4 a0 = p0[0], a1 = p0[1], b0 = p1[0], b1 = p1[1], z0 = pz[0], z1 = pz[1], x0 = px[0], x1 = px[1];
          unpack8(a0, t);
#pragma unroll
          for (int e = 0; e < 8; ++e) o[e] = t[e];
          unpack8(a1, t);
#pragma unroll
          for (int e = 0; e < 8; ++e) o[8 + e] = t[e];
          unpack8(b0, t);
#pragma unroll
          for (int e = 0; e < 8; ++e) o[e] += t[e];
          unpack8(b1, t);
#pragma unroll
          for (int e = 0; e < 8; ++e) o[8 + e] += t[e];
          unpack8(x0, t);
#pragma unroll
          for (int e = 0; e < 8; ++e) o[e] += dsk * t[e];
          unpack8(x1, t);
#pragma unroll
          for (int e = 0; e < 8; ++e) o[8 + e] += dsk * t[e];
          unpack8(z0, t);
#pragma unroll
          for (int e = 0; e < 8; ++e) o[e] *= t[e];
          unpack8(z1, t);
#pragma unroll
          for (int e = 0; e < 8; ++e) o[8 + e] *= t[e];
          float ss = 0.f;
#pragma unroll
          for (int e = 0; e < 16; ++e) ss += o[e] * o[e];
          ss += __shfl_xor(ss, 1); ss += __shfl_xor(ss, 2); ss += __shfl_xor(ss, 4); ss += __shfl_xor(ss, 8);
          const float rstd = rsqrtf(ss * (1.0f / 256.0f) + EPS);
#pragma unroll
          for (int e = 0; e < 16; ++e) o[e] = o[e] * rstd * sw[e];
          u32x4 w0, w1; w0.x = pk2(o[0], o[1]); w0.y = pk2(o[2], o[3]); w0.z = pk2(o[4], o[5]); w0.w = pk2(o[6], o[7]);
          w1.x = pk2(o[8], o[9]); w1.y = pk2(o[10], o[11]); w1.z = pk2(o[12], o[13]); w1.w = pk2(o[14], o[15]);
          u32x4* po = (u32x4*)(A2 + (size_t)r * 2048 + 1024 + c0); po[0] = w0; po[1] = w1; }
    }
}

__device__ __forceinline__ void grid_barrier(unsigned* ctr, unsigned target) {
    __builtin_amdgcn_fence(__ATOMIC_RELEASE, "agent");
    __syncthreads();
    if (threadIdx.x == 0) {
        __hip_atomic_fetch_add(ctr, 1u, __ATOMIC_RELAXED, __HIP_MEMORY_SCOPE_AGENT);
        while (__hip_atomic_load(ctr, __ATOMIC_RELAXED, __HIP_MEMORY_SCOPE_AGENT) < target) __builtin_amdgcn_s_sleep(2);
    }
    __syncthreads();
    __builtin_amdgcn_fence(__ATOMIC_ACQUIRE, "agent");
}
#define XB_TMO      128
#define XB_XCNT(j)  (256  + 64 * (j))
#define XB_XSUB(j)  (1280 + 64 * (j))
#define XB_XGEN(j)  (2304 + 64 * (j))
#define XB_TOP      3328
#define XB_TOPGEN   3392
#define XCD_BAR_WORDS 3456
#define XB_SPIN_CAP (1u << 22)

__device__ __forceinline__ unsigned xb_ld(unsigned* p)              { return __hip_atomic_load(p, __ATOMIC_RELAXED, __HIP_MEMORY_SCOPE_AGENT); }
__device__ __forceinline__ unsigned xb_add(unsigned* p, unsigned v) { return __hip_atomic_fetch_add(p, v, __ATOMIC_RELAXED, __HIP_MEMORY_SCOPE_AGENT); }
__device__ __forceinline__ unsigned xb_xcc_id() { return (unsigned)__builtin_amdgcn_s_getreg((3 << 11) | 20) & 0xFu; }
#define XB_SPIN(cond, bar) do { unsigned _sp = 0; while (cond) { __builtin_amdgcn_s_sleep(1); \
    if ((++_sp & 255u) == 0u) { if (xb_ld(&(bar)[XB_TMO])) break; if (_sp > XB_SPIN_CAP) { atomicAdd(&(bar)[XB_TMO], 1u); break; } } } } while (0)

struct XcdBarrier {
    unsigned* bar; unsigned x;
    volatile LAS unsigned* st;
};

__device__ __forceinline__ XcdBarrier xcd_barrier_post(unsigned* bar, volatile LAS unsigned* st) {
    XcdBarrier b; b.bar = bar; b.x = xb_xcc_id(); b.st = st;
    if (threadIdx.x == 0) (void)xb_add(&bar[XB_XCNT(b.x)], 1u);
    return b;
}
__device__ __forceinline__ void xcd_barrier_complete(unsigned* bar, unsigned x, unsigned& nloc, unsigned& nx) {
    const unsigned G = gridDim.x * gridDim.y * gridDim.z;
    unsigned sum, cnt, mine, sp = 0u;
    for (;;) {
        sum = 0u; cnt = 0u; mine = 0u;
#pragma unroll
        for (unsigned j = 0; j < 16; ++j) { const unsigned c = xb_ld(&bar[XB_XCNT(j)]); sum += c; cnt += (c > 0u) ? 1u : 0u; mine = (j == x) ? c : mine; }
        if (sum == G) break;
        __builtin_amdgcn_s_sleep(1);
        if ((++sp & 255u) == 0u) { if (xb_ld(&bar[XB_TMO])) break; if (sp > XB_SPIN_CAP) { atomicAdd(&bar[XB_TMO], 1u); break; } }
    }
    nloc = mine > 0u ? mine : 1u; nx = cnt > 0u ? cnt : 1u;
}

__device__ __forceinline__ void xcd_barrier(const XcdBarrier& b) {
    asm volatile("s_waitcnt vmcnt(0)" ::: "memory");
    __syncthreads();
    if (threadIdx.x == 0) {
        unsigned* bar = b.bar;
        __builtin_amdgcn_s_waitcnt(0);
        unsigned nloc = b.st[0], nx = b.st[1];
        if (nloc == 0u) { xcd_barrier_complete(bar, b.x, nloc, nx); b.st[0] = nloc; b.st[1] = nx; }
        const unsigned old = xb_add(&bar[XB_XSUB(b.x)], 1u);
        const unsigned gen = old / nloc;
        if (old + 1u == (gen + 1u) * nloc) {
            __builtin_amdgcn_fence(__ATOMIC_RELEASE, "agent");
            asm volatile("s_waitcnt vmcnt(0)" ::: "memory");
            const unsigned og = xb_add(&bar[XB_TOP], 1u);
            const unsigned tg = og / nx;
            if (og + 1u == (tg + 1u) * nx) xb_add(&bar[XB_TOPGEN], 1u);
            else XB_SPIN(xb_ld(&bar[XB_TOPGEN]) == tg, bar);
            __builtin_amdgcn_fence(__ATOMIC_ACQUIRE, "agent");
            xb_add(&bar[XB_XGEN(b.x)], 1u);
            asm volatile("s_waitcnt vmcnt(0)" ::: "memory");
        } else {
            XB_SPIN(xb_ld(&bar[XB_XGEN(b.x)]) == gen, bar);
            __builtin_amdgcn_fence(__ATOMIC_ACQUIRE, "agent");
            asm volatile("s_waitcnt vmcnt(0)" ::: "memory");
        }
    }
    __syncthreads();
}

#ifndef MK_PH_LO
#define MK_PH_LO 0
#endif
__global__ void __launch_bounds__(NT, 2) fwd_megakernel(Params P, int ph_lo, int ph_hi) {
    extern __shared__ __attribute__((aligned(16))) unsigned char lds_raw[];
    LAS unsigned char* lds = (LAS unsigned char*)lds_raw;
    cg::grid_group grid = cg::this_grid();
    unsigned char* ws = P.ws;
    const float* mod = (const float*)(ws + OFF_MOD);
    int ph = 0; unsigned nbar = 0; unsigned* barw = (unsigned*)(ws + OFF_BAR);
#if !defined(MK_OWN_BARRIER)
    if (threadIdx.x < 4) ((LAS unsigned*)(lds + LDS_XB))[threadIdx.x] = 0u;
    __syncthreads();
    XcdBarrier xbar = xcd_barrier_post(barw, (volatile LAS unsigned*)(lds + LDS_XB));
#endif
#if defined(MK_OWN_BARRIER)
    grid.sync();
#endif
#ifndef MK_DUP
#define MK_DUP 0
#endif
#define REPS(bit) for (int rep_ = 0; rep_ < ((MK_DUP & (bit)) ? 2 : 1); ++rep_)
#ifndef MK_MASK
#define MK_MASK 0xffff
#endif
#define PHASE_BEGIN() (ph >= ph_lo && ph < ph_hi)
#if defined(MK_OWN_BARRIER)
#define PHASE_END() do { ++ph; if (ph > ph_lo && ph < ph_hi) { ++nbar; grid_barrier(barw, nbar * gridDim.x); } } while (0)
#else
#define PHASE_END() do { ++ph; if (ph > ph_lo && ph < ph_hi) { if (ph == 1) grid.sync(); else xcd_barrier(xbar); } } while (0)
#endif
    if ((MK_MASK & 1) && PHASE_BEGIN()) REPS(1) phase_prep(P, lds);
    PHASE_END();
    for (int pass = 0; pass < NPASS; ++pass) {
        if ((MK_MASK & 2) && PHASE_BEGIN()) REPS(2) phase_norm<0>(P, pass);
        PHASE_END();
        if ((MK_MASK & 4) && PHASE_BEGIN()) REPS(4) {
            pg8::Gemm g{(const bf16_t*)(ws + OFF_U), (const bf16_t*)(ws + OFF_WIN), MP, NPAD, D}; pg8::StaticOrder S; S.init(MP, NPAD, gridDim.x, blockIdx.x);
            EpiIn E{ws, P.dt_bias};
            pg8::gemm_phase<EpiIn, pg8::StaticOrder>(lds, g, S, E, nullptr);
        }
        PHASE_END();
        if ((MK_MASK & 8) && PHASE_BEGIN()) REPS(8) phase_conv(P);
        PHASE_END();
        if ((MK_MASK & 16) && PHASE_BEGIN()) REPS(16) phase_scan(P, lds, pass);
        PHASE_END();
        if ((MK_MASK & 32) && PHASE_BEGIN()) REPS(32) phase_readout(P);
        PHASE_END();
        if ((MK_MASK & 64) && PHASE_BEGIN()) REPS(64) {
            pg8::Gemm g{(const bf16_t*)(ws + OFF_A2), (const bf16_t*)(ws + OFF_WOUT), ML, D, 2048}; pg8::StaticOrder S; S.init(ML, D, gridDim.x, blockIdx.x);
            EpiOut E{P.x, mod, (float*)(ws + OFF_H1), pass};
            pg8::gemm_phase<EpiOut, pg8::StaticOrder>(lds, g, S, E, nullptr);
        }
        PHASE_END();
        if ((MK_MASK & 128) && PHASE_BEGIN()) REPS(128) phase_norm<1>(P, pass);
        PHASE_END();
        if ((MK_MASK & 256) && PHASE_BEGIN()) REPS(256) {
            pg8::Gemm g{(const bf16_t*)(ws + OFF_U2), (const bf16_t*)(ws + OFF_WGU), ML, 2 * DFF, D}; pg8::StaticOrder S; S.init(ML, 2 * DFF, gridDim.x, blockIdx.x);
            EpiGU E{(bf16_t*)(ws + OFF_ACT)};
            pg8::gemm_phase<EpiGU, pg8::StaticOrder>(lds, g, S, E, nullptr);
        }
        PHASE_END();
        if ((MK_MASK & 512) && PHASE_BEGIN()) REPS(512) {
            pg8::Gemm g{(const bf16_t*)(ws + OFF_ACT), (const bf16_t*)(ws + OFF_WD), ML, D, DFF}; pg8::StaticOrder S; S.init(ML, D, gridDim.x, blockIdx.x);
            EpiDown E{(const float*)(ws + OFF_H1), mod, P.out, pass};
            pg8::gemm_phase<EpiDown, pg8::StaticOrder>(lds, g, S, E, nullptr);
        }
        PHASE_END();
        if ((MK_MASK & 1024) && PHASE_BEGIN()) phase_final_norm(P, pass);
        ++ph;
    }
}
}

extern "C" void kernel_launch(void* const* d_in, const int* in_sizes, int n_in, void* d_out, int out_size, void* d_ws, size_t ws_size, hipStream_t stream) {
    static int grid_blocks = 0;
    if (grid_blocks == 0) {
        if (n_in != 22 || ws_size < mk::WS_END) { fprintf(stderr, "kernel_launch: unexpected n_in %d or ws_size %zu (< %zu)\n", n_in, ws_size, (size_t)mk::WS_END); }
        int dev = 0, cus = 0, per_cu = 0;
        hipGetDevice(&dev);
        hipDeviceGetAttribute(&cus, hipDeviceAttributeMultiprocessorCount, dev);
        if (hipFuncSetAttribute((const void*)mk::fwd_megakernel, hipFuncAttributeMaxDynamicSharedMemorySize, mk::LDS_BYTES) != hipSuccess) fprintf(stderr, "kernel_launch: hipFuncSetAttribute failed\n");
        hipOccupancyMaxActiveBlocksPerMultiprocessor(&per_cu, (const void*)mk::fwd_megakernel, mk::NT, mk::LDS_BYTES);
        if (per_cu < 1) { fprintf(stderr, "kernel_launch: occupancy query returned %d\n", per_cu); per_cu = 1; }
        grid_blocks = cus * 1;
        (void)hipGetLastError();
    }
#ifdef MK_ZERO_WS
    (void)hipMemsetAsync((char*)d_ws + mk::OFF_Q, 0, mk::WS_END - mk::OFF_Q, stream);
#endif
    (void)hipMemsetAsync((char*)d_ws + mk::OFF_BAR, 0, mk::BAR_BYTES, stream);
    mk::Params p{};
    const float** pp = (const float**)&p;
    for (int i = 0; i < 22; ++i) pp[i] = (const float*)d_in[i];
    p.out = (float*)d_out; p.ws = (unsigned char*)d_ws;
    int ph_lo = 0, ph_hi = 1000;
    void* args[] = {&p, &ph_lo, &ph_hi};
    hipError_t e = hipLaunchCooperativeKernel((const void*)mk::fwd_megakernel, dim3(grid_blocks), dim3(mk::NT), args, mk::LDS_BYTES, stream);
    if (e != hipSuccess) fprintf(stderr, "cooperative launch failed: %s (grid %d)\n", hipGetErrorString(e), grid_blocks);
}
```

```cpp
#include <hip/hip_runtime.h>
#include <hip/hip_cooperative_groups.h>
#include <cstdio>
namespace cg = cooperative_groups;
__device__ __forceinline__ int opaque_tid() { int t = threadIdx.x; asm volatile("" : "+v"(t)); return t; }
namespace pg8 {
#define PG8_LAS __attribute__((address_space(3)))
typedef unsigned short bf16_t;
typedef short bf16x8 __attribute__((ext_vector_type(8)));
typedef float f32x4 __attribute__((ext_vector_type(4)));
typedef unsigned u32x4 __attribute__((ext_vector_type(4)));
constexpr int BM = 256, BK = 64, HALF = 128, HTB = HALF * BK * 2  , STAGE_BYTES = 8 * HTB, NXCD = 8, WGM = 8;

__host__ __device__ __forceinline__ int lds_byte(int r, int c) { const int st = (r >> 4) * 2 + (c >> 5), rr = r & 15, cc = c & 31, ob = rr * 64 + cc * 2; return st * 1024 + (ob ^ (((ob >> 9) & 1) << 5)); }
__host__ __device__ __forceinline__ void stage_rc(int b, int& R, int& C) { const int st = b / 1024, sb = b % 1024, swz = sb ^ (((sb >> 9) & 1) << 5); R = (st >> 1) * 16 + swz / 64; C = (st & 1) * 32 + (swz % 64) / 2; }
__host__ __device__ __forceinline__ int perm32(int rho) { const int n = rho >> 4, i = rho & 15; return 8 * (i >> 2) + 4 * n + (i & 3); }

struct Unit { int pm, pn; };
struct Gemm { const bf16_t* A; const bf16_t* Bt; int M, N, K; };

struct StaticOrder {
    int nM, nN, nwg, G, c;
    __host__ __device__ void init(int M, int N, int G_, int c_) { nM = M / BM; nN = N / BM; nwg = nM * nN; G = G_; c = c_; }
    __host__ __device__ bool next(int i, Unit& u) const {
        const long L = (long)i * G + c; if (L >= nwg) return false;
        int wgid = (int)L; { const int q = nwg / NXCD, r = nwg % NXCD, xcd = wgid % NXCD, off = wgid / NXCD; wgid = (xcd < r ? xcd * (q + 1) : r * (q + 1) + (xcd - r) * q) + off; }
        const int nig = WGM * nN, gid = wgid / nig, fm = gid * WGM, gsz = (nM - fm) < WGM ? (nM - fm) : WGM;
        u.pm = fm + ((wgid % nig) % gsz); u.pn = (wgid % nig) / gsz; return true;
    }
    __device__ __forceinline__ void a_ready(const Unit&) const {}
    __device__ __forceinline__ void done(const Unit&) const {}
};
typedef __bf16 bf16v2_t __attribute__((ext_vector_type(2)));
typedef float f32v2_t __attribute__((ext_vector_type(2)));
__device__ __forceinline__ unsigned cvt_pk_bf16(float lo, float hi) { f32v2_t v = {lo, hi}; bf16v2_t r = __builtin_convertvector(v, bf16v2_t); return __builtin_bit_cast(unsigned, r); }
typedef float f32x2 __attribute__((ext_vector_type(2)));
template <class Epi, class Sched, bool STAMP = false>
__device__ __forceinline__ void gemm_phase(PG8_LAS unsigned char* lds, const Gemm g, const Sched& S, const Epi& E, unsigned long long* stamps) {
    const int tid = opaque_tid(), wid = __builtin_amdgcn_readfirstlane(tid >> 6), lane = tid & 63, wr = wid >> 2, wc = wid & 3, fr = lane & 15, fq = lane >> 4;
    const int K = g.K, nt = K / BK;
    int ts_lo = 0, ts_hi = 0, nts = 0; const unsigned long long rt_entry = STAMP ? (unsigned long long)wall_clock64() : 0ull;
#define PG8_STAMP() do { if (STAMP && wid == 0 && nts < 64) { const unsigned long long _c = (unsigned long long)clock64(); \
        ts_lo = (lane == nts) ? (int)(unsigned)_c : ts_lo; ts_hi = (lane == nts) ? (int)(unsigned)(_c >> 32) : ts_hi; ++nts; } } while (0)
    PG8_STAMP();
    unsigned voffA[2], voffB[2];
#pragma unroll
    for (int i = 0; i < 2; ++i) { int R, C; stage_rc(tid * 16 + i * 8192, R, C); const int Rb = Epi::PERM ? ((R & ~31) + perm32(R & 31)) : R;
        voffA[i] = (unsigned)(R * K + C) * 2u; voffB[i] = (unsigned)(Rb * K + C) * 2u; }
    const size_t kstep = (size_t)(BK * 2);
    const size_t hstep = (size_t)HALF * K * 2;
    const size_t tstep = 2 * hstep;
    const unsigned ldsw = (unsigned)wid * 1024u;
    const int aoff = lds_byte(wr * 64 + fr, fq * 8), boff = lds_byte(wc * 32 + fr, fq * 8);
#define PG8_SA(b, h) (((b) * 2 + (h)) * HTB)
#define PG8_SB(b, h) ((4 + (b) * 2 + (h)) * HTB)
#define PG8_STAGE(bufoff, gbase, voff) do { _Pragma("unroll") for (int _i = 0; _i < 2; ++_i) \
        __builtin_amdgcn_global_load_lds((const unsigned*)((const char*)(gbase) + (voff)[_i]), (PG8_LAS unsigned*)(lds + (bufoff) + ldsw + _i * 8192), 16, 0, 0); } while (0)
#define PG8_LDA(dst, b, h) do { _Pragma("unroll") for (int m = 0; m < 4; ++m) _Pragma("unroll") for (int k = 0; k < 2; ++k) dst[m][k] = *(const PG8_LAS bf16x8*)(lds + PG8_SA(b, h) + aoff + m * 2048 + k * 1024); } while (0)
#define PG8_LDB(dst, b, h) do { _Pragma("unroll") for (int n = 0; n < 2; ++n) _Pragma("unroll") for (int k = 0; k < 2; ++k) dst[n][k] = *(const PG8_LAS bf16x8*)(lds + PG8_SB(b, h) + boff + n * 2048 + k * 1024); } while (0)
#define PG8_MMA(ai, bj, At, Bt) do { __builtin_amdgcn_s_setprio(1); _Pragma("unroll") for (int m = 0; m < 4; ++m) _Pragma("unroll") for (int n = 0; n < 2; ++n) _Pragma("unroll") for (int k = 0; k < 2; ++k) \
        acc[ai][bj][m][n] = __builtin_amdgcn_mfma_f32_16x16x32_bf16(Bt[n][k], At[m][k], acc[ai][bj][m][n], 0, 0, 0); __builtin_amdgcn_s_setprio(0); } while (0)
#define PG8_WAIT_V(n) asm volatile("s_waitcnt vmcnt(" #n ")" ::: "memory")
#define PG8_WAIT_L(n) asm volatile("s_waitcnt lgkmcnt(" #n ")" ::: "memory")
#define PG8_BAR __builtin_amdgcn_s_barrier()
#define PG8_SCHED __builtin_amdgcn_sched_barrier(0)
    Unit cur, nxt; int ui = 0;
    if (!S.next(0, cur)) return;
    f32x4 acc[2][2][4][2];
#pragma unroll
    for (int a = 0; a < 2; ++a)
#pragma unroll
        for (int b = 0; b < 2; ++b)
#pragma unroll
            for (int m = 0; m < 4; ++m)
#pragma unroll
                for (int n = 0; n < 2; ++n) acc[a][b][m][n] = (f32x4){0.f, 0.f, 0.f, 0.f};
    bf16x8 At[4][2], B0[2][2], B1[2][2];
    const char* cA = (const char*)g.A + (size_t)cur.pm * tstep; const char* cB = (const char*)g.Bt + (size_t)cur.pn * tstep;
    S.a_ready(cur);
    PG8_STAGE(PG8_SB(0, 0), cB, voffB); PG8_STAGE(PG8_SA(0, 0), cA, voffA); PG8_STAGE(PG8_SB(0, 1), cB + hstep, voffB); PG8_STAGE(PG8_SA(0, 1), cA + hstep, voffA);
    if (wr == 1) PG8_BAR;
    PG8_WAIT_V(4); PG8_BAR;
    PG8_STAGE(PG8_SB(1, 0), cB + kstep, voffB); PG8_STAGE(PG8_SA(1, 0), cA + kstep, voffA); PG8_STAGE(PG8_SB(1, 1), cB + hstep + kstep, voffB);
    PG8_WAIT_V(6); PG8_BAR;
    PG8_STAMP();
    for (;;) {
        const bool has_next = S.next(ui + 1, nxt);
        const char* nA = has_next ? (const char*)g.A + (size_t)nxt.pm * tstep : cA; const char* nB = has_next ? (const char*)g.Bt + (size_t)nxt.pn * tstep : cB;
        for (int t = 0; t < nt; t += 2) {
            const bool last = (t == nt - 2);
            const char* a1 = cA + (size_t)(t + 1) * kstep;
            const char* a2 = last ? nA : cA + (size_t)(t + 2) * kstep; const char* b2 = last ? nB : cB + (size_t)(t + 2) * kstep;
            const char* a3 = a2 + kstep; const char* b3 = b2 + kstep;
            if (last && has_next) S.a_ready(nxt);
            PG8_LDB(B0, 0, 0); PG8_SCHED; PG8_LDA(At, 0, 0); PG8_STAGE(PG8_SA(1, 1), a1 + hstep, voffA);
            PG8_WAIT_L(8); PG8_BAR; PG8_WAIT_L(0); PG8_MMA(0, 0, At, B0); PG8_BAR; PG8_SCHED;
            PG8_LDB(B1, 0, 1); PG8_STAGE(PG8_SB(0, 0), b2, voffB);
            PG8_BAR; PG8_WAIT_L(0); PG8_MMA(0, 1, At, B1); PG8_BAR;
            PG8_LDA(At, 0, 1); PG8_STAGE(PG8_SA(0, 0), a2, voffA);
            PG8_BAR; PG8_WAIT_L(0); PG8_MMA(1, 0, At, B0); PG8_BAR; PG8_SCHED;
            PG8_STAGE(PG8_SB(0, 1), b2 + hstep, voffB);
            PG8_WAIT_V(6); PG8_BAR; PG8_MMA(1, 1, At, B1); PG8_BAR;
            PG8_LDB(B0, 1, 0); PG8_SCHED; PG8_LDA(At, 1, 0); PG8_STAGE(PG8_SA(0, 1), a2 + hstep, voffA);
            PG8_WAIT_L(8); PG8_BAR; PG8_WAIT_L(0); PG8_MMA(0, 0, At, B0); PG8_BAR; PG8_SCHED;
            PG8_LDB(B1, 1, 1); PG8_STAGE(PG8_SB(1, 0), b3, voffB);
            PG8_BAR; PG8_WAIT_L(0); PG8_MMA(0, 1, At, B1); PG8_BAR;
            PG8_LDA(At, 1, 1); PG8_STAGE(PG8_SA(1, 0), a3, voffA);
            PG8_BAR; PG8_WAIT_L(0); PG8_MMA(1, 0, At, B0); PG8_BAR; PG8_SCHED;
            PG8_STAGE(PG8_SB(1, 1), b3 + hstep, voffB);
            PG8_WAIT_V(6); PG8_BAR; PG8_MMA(1, 1, At, B1); PG8_BAR;
        }
        PG8_STAMP();
        if constexpr (!Epi::AFTER_DRAIN) { E(acc, cur, wr, wc, fr, fq); S.done(cur); }
        PG8_STAMP();
        if (!has_next) break;
#pragma unroll
        for (int a = 0; a < 2; ++a)
#pragma unroll
            for (int b = 0; b < 2; ++b)
#pragma unroll
                for (int m = 0; m < 4; ++m)
#pragma unroll
                    for (int n = 0; n < 2; ++n) acc[a][b][m][n] = (f32x4){0.f, 0.f, 0.f, 0.f};
        cur = nxt; cA = nA; cB = nB; ++ui;
    }
    PG8_WAIT_V(0);
    if (wr == 0) PG8_BAR;
    PG8_BAR;
    if constexpr (Epi::AFTER_DRAIN) { E.fused(acc, cur, wr, wc, fr, fq, lds, wid, lane); S.done(cur); }
    PG8_STAMP();
    if (STAMP && wid == 0) { stamps[lane] = lane < nts ? (((unsigned long long)(unsigned)ts_hi << 32) | (unsigned)ts_lo) : 0ull;
        if (lane == 62) stamps[62] = rt_entry; if (lane == 63) stamps[63] = (unsigned long long)wall_clock64(); }
#undef PG8_STAMP
#undef PG8_SA
#undef PG8_SB
#undef PG8_STAGE
#undef PG8_LDA
#undef PG8_LDB
#undef PG8_MMA
#undef PG8_WAIT_V
#undef PG8_WAIT_L
#undef PG8_BAR
#undef PG8_SCHED
}
}

namespace mk {
using pg8::bf16_t; using pg8::bf16x8; using pg8::f32x4; using pg8::u32x4; using pg8::Unit;
#define LAS __attribute__((address_space(3)))
typedef unsigned u32x2 __attribute__((ext_vector_type(2)));
typedef _Float16 f16;

constexpr int D = 1024, NB = 8, SEQ = 4096, CTX = 256, DIN = 8224, NPAD = 8448, DFF = 2816;
constexpr int BP = 4;
constexpr int NPASS = NB / BP;
constexpr int ML = BP * SEQ;
constexpr int MC = BP * CTX;
constexpr int MP = ML + MC;
constexpr float EPS = 1e-6f;
constexpr int NT = 512;
constexpr int LDS_XB = 158208;
constexpr int LDS_BYTES = LDS_XB + 16;

constexpr size_t SZ_WIN = (size_t)NPAD * D * 2, SZ_WOUT = (size_t)D * 2048 * 2, SZ_WGU = (size_t)2 * DFF * D * 2, SZ_WD = (size_t)D * DFF * 2;
constexpr size_t OFF_WIN = 0, OFF_WOUT = OFF_WIN + SZ_WIN, OFF_WGU = OFF_WOUT + SZ_WOUT, OFF_WD = OFF_WGU + SZ_WGU;
constexpr size_t OFF_MOD = OFF_WD + SZ_WD;
constexpr size_t OFF_LB = OFF_MOD + 9 * 6144 * 4;
constexpr size_t OFF_BAR = OFF_LB + 2048 * 4;
constexpr size_t BAR_BYTES = 16384;
constexpr size_t OFF_Q = OFF_BAR + BAR_BYTES;
constexpr size_t OFF_FR = OFF_Q + (size_t)MP * 1024 * 2;
constexpr size_t OFF_V = OFF_FR + (size_t)MP * 2048 * 2;
constexpr size_t OFF_DT = OFF_V + (size_t)MP * 1024 * 2;
constexpr size_t OFF_G = OFF_DT + (size_t)MP * 32 * 4;
constexpr size_t OFF_Z = OFF_G + (size_t)ML * 1024 * 2;
constexpr size_t OFF_XC = OFF_Z + (size_t)ML * 1024 * 2;
constexpr size_t OFF_X1 = OFF_XC + (size_t)MP * 2048 * 2;
constexpr size_t OFF_U = OFF_X1;
constexpr size_t OFF_XR = OFF_X1 + (size_t)MP * 1024 * 2;
constexpr size_t OFF_OH = OFF_X1;
constexpr size_t OFF_OS = OFF_X1 + (size_t)2 * ML * 1024 * 2;
constexpr size_t OFF_H1A = OFF_X1 + (size_t)4 * ML * 1024 * 2;
constexpr size_t WS_END = OFF_H1A + (size_t)ML * 1024 * 4;
static_assert(WS_END <= 536870912ull, "workspace budget (4 x largest tensor)");
constexpr size_t OFF_A2 = OFF_Q;
constexpr size_t OFF_H1B = OFF_X1;
constexpr size_t OFF_ACT = OFF_Q;
constexpr size_t OFF_U2 = OFF_ACT + (size_t)2 * ML * DFF * 2;
static_assert(OFF_U2 + (size_t)2 * ML * 1024 * 2 <= OFF_X1, "FFN buffers must end before h1 of pass 1");
static_assert((size_t)ML * 2048 * 2 <= (size_t)MP * 1024 * 2 + (size_t)MP * 2048 * 2, "A2 overlay");
static_assert((size_t)MP * 1024 * 2 + (size_t)MP * 2048 * 2 <= (size_t)4 * ML * 1024 * 2, "U+XR in X1");

struct Params {
    const float *x, *c, *ctx, *c_ctx, *w_ada, *b_ada, *norm_mix, *w_in, *conv_w, *conv_b, *a_log, *dt_bias, *ssd_d, *ssd_norm,
                *lb_raw, *hgrn_norm, *w_out, *norm_ffn, *w_gate, *w_up, *w_down, *final_norm;
    float* out; unsigned char* ws;
};

__device__ __forceinline__ float bf2f(unsigned short b) { return __uint_as_float(((unsigned)b) << 16); }
__device__ __forceinline__ float bflo(unsigned w) { return __uint_as_float(w << 16); }
__device__ __forceinline__ float bfhi(unsigned w) { return __uint_as_float(w & 0xffff0000u); }
__device__ __forceinline__ float h_lo(unsigned w) { return (float)__builtin_bit_cast(f16, (unsigned short)(w & 0xffffu)); }
__device__ __forceinline__ float h_hi(unsigned w) { return (float)__builtin_bit_cast(f16, (unsigned short)(w >> 16)); }
__device__ __forceinline__ unsigned pk2(float lo, float hi) { return pg8::cvt_pk_bf16(lo, hi); }
__device__ __forceinline__ unsigned short f2bf(float f) { return (unsigned short)(pk2(f, 0.f) & 0xffffu); }
__device__ __forceinline__ float siluf(float v) { return v * __builtin_amdgcn_rcpf(1.0f + __expf(-v)); }
__device__ __forceinline__ float wave_sum(float v) {
#pragma unroll
    for (int o = 1; o < 64; o <<= 1) v += __shfl_xor(v, o);
    return v;
}

__device__ __forceinline__ void p0_transpose_item(const float* W, int K, int N, bf16_t* WT, int k0, int n0, int drow0, LAS float* scr, int lane) {
#pragma unroll 8
    for (int i = 0; i < 32; ++i) { const int kk = 2 * i + (lane >> 5); scr[kk * 33 + (lane & 31)] = W[(size_t)(k0 + kk) * N + n0 + (lane & 31)]; }
    asm volatile("s_waitcnt vmcnt(0) lgkmcnt(0)" ::: "memory");
    const int c = lane & 7;
#pragma unroll
    for (int j = 0; j < 4; ++j) { const int n = (lane >> 3) + 8 * j; const LAS float* s = scr + (8 * c) * 33 + n;
        u32x4 o; o.x = pk2(s[0 * 33], s[1 * 33]); o.y = pk2(s[2 * 33], s[3 * 33]); o.z = pk2(s[4 * 33], s[5 * 33]); o.w = pk2(s[6 * 33], s[7 * 33]);
        *(u32x4*)(WT + (size_t)(drow0 + n) * K + k0 + 8 * c) = o; }
    asm volatile("s_waitcnt lgkmcnt(0)" ::: "memory");
}

__device__ __forceinline__ void phase_prep(const Params& P, LAS unsigned char* lds) {
    const int tid = opaque_tid(), lane = tid & 63, wave = tid >> 6;
    unsigned char* ws = P.ws;
    float* mod = (float*)(ws + OFF_MOD);
    LAS float* cs = (LAS float*)(lds + 18432);
    if (blockIdx.x < 96) {
        for (int e = tid; e < 9 * 1024; e += NT) { const float cv = (e < 8192) ? P.c[e] : P.c_ctx[e - 8192]; cs[e] = siluf(cv); }
        __syncthreads();
    }
    for (int item = blockIdx.x; item < 96; item += gridDim.x) {
        const int col = item * 64 + lane;
        float acc[9];
#pragma unroll
        for (int r = 0; r < 9; ++r) acc[r] = 0.f;
#pragma unroll 4
        for (int kk = 0; kk < 128; ++kk) {
            const int k = wave * 128 + kk;
            const float wv = P.w_ada[(size_t)k * 6144 + col];
#pragma unroll
            for (int r = 0; r < 9; ++r) acc[r] += cs[r * 1024 + k] * wv;
        }
        LAS float* red = (LAS float*)lds;
#pragma unroll
        for (int r = 0; r < 9; ++r) red[(wave * 9 + r) * 64 + lane] = acc[r];
        __syncthreads();
        for (int e = tid; e < 9 * 64; e += NT) { const int r = e >> 6, l = e & 63; float s = 0.f;
#pragma unroll
            for (int w = 0; w < 8; ++w) s += red[(w * 9 + r) * 64 + l];
            mod[r * 6144 + item * 64 + l] = s + P.b_ada[item * 64 + l]; }
        __syncthreads();
    }
    float* lbv = (float*)(ws + OFF_LB);
    for (int j = blockIdx.x * NT + tid; j < 2048; j += gridDim.x * NT) { const float r0 = P.lb_raw[j], r1 = P.lb_raw[2048 + j]; lbv[j] = 1.0f / (1.0f + __expf(r1 - r0)); }
    { u32x4* z = (u32x4*)(ws + OFF_WIN + (size_t)DIN * D * 2); const int n16 = (NPAD - DIN) * D * 2 / 16;
      for (int j = blockIdx.x * NT + tid; j < n16; j += gridDim.x * NT) z[j] = (u32x4){0u, 0u, 0u, 0u}; }
    LAS float* scr = (LAS float*)(lds + 55296 + wave * 8704);
    bf16_t* WinT = (bf16_t*)(ws + OFF_WIN); bf16_t* WoutT = (bf16_t*)(ws + OFF_WOUT); bf16_t* WguT = (bf16_t*)(ws + OFF_WGU); bf16_t* WdT = (bf16_t*)(ws + OFF_WD);
    constexpr int I_IN = (D / 64) * (DIN / 32), I_OUT = (2048 / 64) * (D / 32), I_G = (D / 64) * (DFF / 32), I_D = (DFF / 64) * (D / 32);
    constexpr int NITEMS = I_IN + I_OUT + 2 * I_G + I_D;
    const int gw = blockIdx.x * 8 + wave, NGW = gridDim.x * 8;
    for (int it = gw; it < NITEMS; it += NGW) {
        int r = it;
        if (r < I_IN) { const int nblk = DIN / 32, kb = r / nblk, nb = r % nblk; p0_transpose_item(P.w_in, D, DIN, WinT, 64 * kb, 32 * nb, 32 * nb, scr, lane); continue; } r -= I_IN;
        if (r < I_OUT) { const int nblk = D / 32, kb = r / nblk, nb = r % nblk; p0_transpose_item(P.w_out, 2048, D, WoutT, 64 * kb, 32 * nb, 32 * nb, scr, lane); continue; } r -= I_OUT;
        if (r < I_G) { const int nblk = DFF / 32, kb = r / nblk, nb = r % nblk, n0 = 32 * nb; p0_transpose_item(P.w_gate, D, DFF, WguT, 64 * kb, n0, (n0 >> 7) * 256 + (n0 & 127), scr, lane); continue; } r -= I_G;
        if (r < I_G) { const int nblk = DFF / 32, kb = r / nblk, nb = r % nblk, n0 = 32 * nb; p0_transpose_item(P.w_up, D, DFF, WguT, 64 * kb, n0, (n0 >> 7) * 256 + 128 + (n0 & 127), scr, lane); continue; } r -= I_G;
        { const int nblk = D / 32, kb = r / nblk, nb = r % nblk; p0_transpose_item(P.w_down, DFF, D, WdT, 64 * kb, 32 * nb, 32 * nb, scr, lane); }
    }
}

template <int MODE>
__device__ __forceinline__ void phase_norm(const Params& P, int pass) {
    const int tid_ = opaque_tid(); const int lane = tid_ & 63, wave = tid_ >> 6;
    const float* mod = (const float*)(P.ws + OFF_MOD);
    const int nrows = MODE == 0 ? MP : 2 * ML;
    bf16_t* outp = (bf16_t*)(P.ws + (MODE == 0 ? OFF_U : OFF_U2));
    const float* nw = MODE == 0 ? P.norm_mix : P.norm_ffn;
    for (int r = blockIdx.x * 8 + wave; r < nrows; r += gridDim.x * 8) {
        const float* src; int mrow;
        if (MODE == 0) {
            if (r < ML) { src = P.x + ((size_t)pass * ML + r) * D; mrow = pass * BP + (r >> 12); }
            else { const int rc = r - ML; src = P.ctx + ((size_t)pass * MC + rc) * D; mrow = 8; }
        } else { src = (r < ML) ? (const float*)(P.ws + OFF_H1A) + (size_t)r * D : (const float*)(P.ws + OFF_H1B) + (size_t)(r - ML) * D; mrow = r >> 12; }
        const float* sh = mod + mrow * 6144 + (MODE == 0 ? 0 : 3072); const float* sc = sh + 1024;
        f32x4 v[4]; float ss = 0.f;
#pragma unroll
        for (int j = 0; j < 4; ++j) { v[j] = *(const f32x4*)(src + 256 * j + 4 * lane); ss += (v[j].x * v[j].x + v[j].y * v[j].y) + (v[j].z * v[j].z + v[j].w * v[j].w); }
        const float rstd = rsqrtf(wave_sum(ss) * (1.0f / D) + EPS);
#pragma unroll
        for (int j = 0; j < 4; ++j) { const int c0 = 256 * j + 4 * lane;
            const f32x4 w = *(const f32x4*)(nw + c0), s1 = *(const f32x4*)(sc + c0), s0 = *(const f32x4*)(sh + c0);
            const f32x4 o = (v[j] * rstd * w) * (1.0f + s1) + s0;
            u32x2 pk; pk.x = pk2(o.x, o.y); pk.y = pk2(o.z, o.w);
            *(u32x2*)(outp + (size_t)r * D + c0) = pk; }
    }
}

__device__ __forceinline__ void phase_final_norm(const Params& P, int pass) {
    const int tid_ = opaque_tid(); const int lane = tid_ & 63, wave = tid_ >> 6;
    for (int r = blockIdx.x * 8 + wave; r < 2 * ML; r += gridDim.x * 8) {
        float* row = P.out + (size_t)r * D;
        f32x4 v[4]; float ss = 0.f;
#pragma unroll
        for (int j = 0; j < 4; ++j) { v[j] = *(const f32x4*)(row + 256 * j + 4 * lane); ss += (v[j].x * v[j].x + v[j].y * v[j].y) + (v[j].z * v[j].z + v[j].w * v[j].w); }
        const float rstd = rsqrtf(wave_sum(ss) * (1.0f / D) + EPS);
#pragma unroll
        for (int j = 0; j < 4; ++j) { const int c0 = 256 * j + 4 * lane; const f32x4 w = *(const f32x4*)(P.final_norm + c0);
            *(f32x4*)(row + c0) = v[j] * rstd * w; }
    }
}

struct EpiIn {
    static constexpr bool PERM = true, AFTER_DRAIN = false;
    unsigned char* ws; const float* dt_bias;
    __device__ __forceinline__ void operator()(const f32x4 (&acc)[2][2][4][2], const Unit& u, int wr, int wc, int fr, int fq) const {
        const int pn = u.pn; const bool lat = u.pm < (ML / 256);
        int kind, ld, cofs; size_t off;
        float scale = 1.0f;
        if (pn < 4) { kind = lat ? 0 : 4; off = OFF_Q; ld = 1024; cofs = 0; scale = 0.08838834764831845f; }
        else if (pn < 12) { kind = 2; off = OFF_FR; ld = 2048; cofs = 1024; }
        else if (pn < 16) { kind = 1; off = OFF_V; ld = 1024; cofs = 3072; }
        else if (pn < 20) { kind = lat ? 0 : 4; off = OFF_G; ld = 1024; cofs = 4096; }
        else if (pn < 24) { kind = lat ? 0 : 4; off = OFF_Z; ld = 1024; cofs = 5120; }
        else if (pn < 32) { kind = 1; off = OFF_XR; ld = 2048; cofs = 6144; }
        else { kind = 3; off = OFF_DT; ld = 32; cofs = 8192; }
        if (kind == 4) return;
        const int row0 = u.pm * 256 + wr * 64 + fr;
        if (kind == 3) {
            if (wc != 0) return;
            float* DT = (float*)(ws + off);
            const f32x4 b0 = *(const f32x4*)(dt_bias + 8 * fq), b1 = *(const f32x4*)(dt_bias + 8 * fq + 4);
#pragma unroll
            for (int ai = 0; ai < 2; ++ai)
#pragma unroll
                for (int m = 0; m < 4; ++m) { const int row = row0 + ai * 128 + m * 16;
                    f32x4 v0 = acc[ai][0][m][0] + b0, v1 = acc[ai][0][m][1] + b1;
#pragma unroll
                    for (int j = 0; j < 4; ++j) { v0[j] = v0[j] > 20.f ? v0[j] : log1pf(__expf(v0[j])); v1[j] = v1[j] > 20.f ? v1[j] : log1pf(__expf(v1[j])); }
                    *(f32x4*)(DT + (size_t)row * 32 + 8 * fq) = v0; *(f32x4*)(DT + (size_t)row * 32 + 8 * fq + 4) = v1; }
            return;
        }
        unsigned short* O = (unsigned short*)(ws + off);
        const int col0 = pn * 256 - cofs + wc * 32 + 8 * fq;
#pragma unroll
        for (int ai = 0; ai < 2; ++ai)
#pragma unroll
            for (int m = 0; m < 4; ++m) { unsigned short* rowp = O + (size_t)(row0 + ai * 128 + m * 16) * ld + col0;
#pragma unroll
                for (int bj = 0; bj < 2; ++bj) { f32x4 v0 = acc[ai][bj][m][0], v1 = acc[ai][bj][m][1]; u32x4 w;
                    if (kind == 0) {
#pragma unroll
                        for (int j = 0; j < 4; ++j) { v0[j] = siluf(v0[j]) * scale; v1[j] = siluf(v1[j]) * scale; } }
                    if (kind == 2) {
                        typedef f16 h2 __attribute__((ext_vector_type(2)));
                        const float* lbp = (const float*)(ws + OFF_LB) + col0 + bj * 128;
                        const f32x4 l0 = *(const f32x4*)lbp, l1 = *(const f32x4*)(lbp + 4);
#pragma unroll
                        for (int j = 0; j < 4; ++j) { const float x0 = fminf(fmaxf(v0[j], -30.f), 30.f), x1 = fminf(fmaxf(v1[j], -30.f), 30.f);
                            v0[j] = (1.0f - l0[j]) * __builtin_amdgcn_rcpf(1.0f + __expf(x0)); v1[j] = (1.0f - l1[j]) * __builtin_amdgcn_rcpf(1.0f + __expf(x1)); }
                        h2 a = {(f16)v0[0], (f16)v0[1]}, b = {(f16)v0[2], (f16)v0[3]}, c = {(f16)v1[0], (f16)v1[1]}, d = {(f16)v1[2], (f16)v1[3]};
                        w.x = __builtin_bit_cast(unsigned, a); w.y = __builtin_bit_cast(unsigned, b); w.z = __builtin_bit_cast(unsigned, c); w.w = __builtin_bit_cast(unsigned, d);
                    } else { w.x = pk2(v0[0], v0[1]); w.y = pk2(v0[2], v0[3]); w.z = pk2(v1[0], v1[1]); w.w = pk2(v1[2], v1[3]); }
                    *(u32x4*)(rowp + bj * 128) = w; } }
    }
};
struct EpiOut {
    static constexpr bool PERM = false, AFTER_DRAIN = false;
    const float* x; const float* mod; float* H1; int pass;
    __device__ __forceinline__ void operator()(const f32x4 (&acc)[2][2][4][2], const Unit& u, int wr, int wc, int fr, int fq) const {
        const int row0 = u.pm * 256 + wr * 64 + fr, col0 = u.pn * 256 + wc * 32 + 4 * fq;
        const float* g1 = mod + (size_t)(pass * BP + (u.pm >> 4)) * 6144 + 2048;
        f32x4 gv[2][2];
#pragma unroll
        for (int bj = 0; bj < 2; ++bj)
#pragma unroll
            for (int n = 0; n < 2; ++n) gv[bj][n] = *(const f32x4*)(g1 + col0 + bj * 128 + n * 16);
#pragma unroll
        for (int ai = 0; ai < 2; ++ai)
#pragma unroll
            for (int m = 0; m < 4; ++m) { const int row = row0 + ai * 128 + m * 16; const float* xr = x + ((size_t)pass * ML + row) * D + col0; float* hr = H1 + (size_t)row * D + col0;
#pragma unroll
                for (int bj = 0; bj < 2; ++bj)
#pragma unroll
                    for (int n = 0; n < 2; ++n) *(f32x4*)(hr + bj * 128 + n * 16) = *(const f32x4*)(xr + bj * 128 + n * 16) + gv[bj][n] * acc[ai][bj][m][n]; }
    }
};
struct EpiGU {
    static constexpr bool PERM = true, AFTER_DRAIN = false;
    bf16_t* ACT;
    __device__ __forceinline__ void operator()(const f32x4 (&acc)[2][2][4][2], const Unit& u, int wr, int wc, int fr, int fq) const {
        const int row0 = u.pm * 256 + wr * 64 + fr, col0 = u.pn * 128 + wc * 32 + 8 * fq;
#pragma unroll
        for (int ai = 0; ai < 2; ++ai)
#pragma unroll
            for (int m = 0; m < 4; ++m) { bf16_t* rowp = ACT + (size_t)(row0 + ai * 128 + m * 16) * DFF + col0;
                f32x4 g0 = acc[ai][0][m][0], g1 = acc[ai][0][m][1]; const f32x4 u0 = acc[ai][1][m][0], u1 = acc[ai][1][m][1];
#pragma unroll
                for (int j = 0; j < 4; ++j) { g0[j] = siluf(g0[j]) * u0[j]; g1[j] = siluf(g1[j]) * u1[j]; }
                u32x4 w; w.x = pk2(g0[0], g0[1]); w.y = pk2(g0[2], g0[3]); w.z = pk2(g1[0], g1[1]); w.w = pk2(g1[2], g1[3]);
                *(u32x4*)rowp = w; }
    }
};
struct EpiDown {
    static constexpr bool PERM = false, AFTER_DRAIN = false;
    const float* H1a; const float* H1b; const float* mod; float* out;
    __device__ __forceinline__ void operator()(const f32x4 (&acc)[2][2][4][2], const Unit& u, int wr, int wc, int fr, int fq) const {
        const int row0 = u.pm * 256 + wr * 64 + fr, col0 = u.pn * 256 + wc * 32 + 4 * fq;
        const float* g2 = mod + (size_t)(u.pm >> 4) * 6144 + 5120;
        const float* H1 = (u.pm < ML / 256) ? H1a : H1b - (size_t)ML * D;
        f32x4 gv[2][2];
#pragma unroll
        for (int bj = 0; bj < 2; ++bj)
#pragma unroll
            for (int n = 0; n < 2; ++n) gv[bj][n] = *(const f32x4*)(g2 + col0 + bj * 128 + n * 16);
#pragma unroll
        for (int ai = 0; ai < 2; ++ai)
#pragma unroll
            for (int m = 0; m < 4; ++m) { const int row = row0 + ai * 128 + m * 16; const float* hr = H1 + (size_t)row * D + col0; float* orow = out + (size_t)row * D + col0;
#pragma unroll
                for (int bj = 0; bj < 2; ++bj)
#pragma unroll
                    for (int n = 0; n < 2; ++n) *(f32x4*)(orow + bj * 128 + n * 16) = *(const f32x4*)(hr + bj * 128 + n * 16) + gv[bj][n] * acc[ai][bj][m][n]; }
    }
};

__device__ __forceinline__ void phase_conv(const Params& P) {
    const bf16_t* XR = (const bf16_t*)(P.ws + OFF_XR); bf16_t* XC = (bf16_t*)(P.ws + OFF_XC);
    constexpr int SEGL = 32, NSEG = MP / SEGL, NITEM = NSEG * 256;
    for (int it = blockIdx.x * NT + opaque_tid(); it < NITEM; it += gridDim.x * NT) {
        const int seg = it >> 8, cg8 = (it & 255) * 8, r0 = seg * SEGL;
        int L0, L1;
        if (r0 < ML) { L0 = r0 & ~63; L1 = L0 + 64; } else { const int rc = r0 - ML; L0 = ML + (rc & ~255); L1 = L0 + 256; }
        float w[5][8], bias[8];
#pragma unroll
        for (int k = 0; k < 5; ++k) { const f32x4 a = *(const f32x4*)(P.conv_w + k * 2048 + cg8), b = *(const f32x4*)(P.conv_w + k * 2048 + cg8 + 4);
            w[k][0] = a.x; w[k][1] = a.y; w[k][2] = a.z; w[k][3] = a.w; w[k][4] = b.x; w[k][5] = b.y; w[k][6] = b.z; w[k][7] = b.w; }
        { const f32x4 a = *(const f32x4*)(P.conv_b + cg8), b = *(const f32x4*)(P.conv_b + cg8 + 4);
          bias[0] = a.x; bias[1] = a.y; bias[2] = a.z; bias[3] = a.w; bias[4] = b.x; bias[5] = b.y; bias[6] = b.z; bias[7] = b.w; }
        u32x4 win[5];
        const u32x4 zero4 = {0u, 0u, 0u, 0u};
#pragma unroll
        for (int k = 0; k < 4; ++k) { const int r = r0 - 2 + k; win[k] = (r >= L0 && r < L1) ? *(const u32x4*)(XR + (size_t)r * 2048 + cg8) : zero4; }
        for (int t = 0; t < SEGL; ++t) {
            const int r = r0 + t + 2; win[4] = (r >= L0 && r < L1) ? *(const u32x4*)(XR + (size_t)r * 2048 + cg8) : zero4;
            float o[8];
#pragma unroll
            for (int e = 0; e < 8; ++e) o[e] = bias[e];
#pragma unroll
            for (int k = 0; k < 5; ++k) {
                o[0] += w[k][0] * bflo(win[k].x); o[1] += w[k][1] * bfhi(win[k].x); o[2] += w[k][2] * bflo(win[k].y); o[3] += w[k][3] * bfhi(win[k].y);
                o[4] += w[k][4] * bflo(win[k].z); o[5] += w[k][5] * bfhi(win[k].z); o[6] += w[k][6] * bflo(win[k].w); o[7] += w[k][7] * bfhi(win[k].w); }
            u32x4 pk; pk.x = pk2(siluf(o[0]), siluf(o[1])); pk.y = pk2(siluf(o[2]), siluf(o[3])); pk.z = pk2(siluf(o[4]), siluf(o[5])); pk.w = pk2(siluf(o[6]), siluf(o[7]));
            *(u32x4*)(XC + (size_t)(r0 + t) * 2048 + cg8) = pk;
            win[0] = win[1]; win[1] = win[2]; win[2] = win[3]; win[3] = win[4];
        }
    }
}

constexpr int L_AQ = 0  , L_AK = 34816  , L_KET = 69632  , L_VVT = 106496  , L_SC = 124928, L_ST = 134144, L_SEG = 151552, L_DEC = 155648  , L_CUM = 156672  , L_DTV = 157184  , L_EE = 157696  , L_SCAN_END = 158208;
constexpr int SZ_AQ = 17408;
constexpr int SZ_KET = 18432, SZ_VVT = 9216, SZ_DEC = 512, SZ_CUM = 256;
constexpr int PA = 272, PB = 144;

#define MFMA16(a, b, c) __builtin_amdgcn_mfma_f32_16x16x32_bf16((a), (b), (c), 0, 0, 0)

template <bool SSD>
__device__ __forceinline__ void scan_item(const Params& P, LAS unsigned char* lds, int pass, int it) {
    const int tid = opaque_tid(), lane = tid & 63, wave = __builtin_amdgcn_readfirstlane(tid >> 6);
    const int l15 = lane & 15, lq = lane >> 4;
    unsigned char* ws = P.ws;
    int bl, dir, head, vh = 0;
    if (!SSD) { bl = it >> 5; dir = (it >> 4) & 1; head = (it >> 1) & 7; vh = it & 1; }
    else { bl = it >> 5; dir = (it >> 4) & 1; head = it & 15; }
    auto chunk_base = [&](int step) -> int {
        if (step < 4) { const int c = dir ? 3 - step : step; return ML + bl * CTX + c * 64; }
        const int c = dir ? 63 - (step - 4) : step - 4; return bl * SEQ + c * 64; };

    if (wave >= 4) {
        const int ptid = tid - 256, pw = wave - 4;
        const int f4 = ptid & 31, seg = ptid >> 5;
        const int v4 = ptid & 15, tq = ptid >> 4;
        const unsigned short *srcA, *srcB, *srcV; int ldA, ldB, ldV;
        if (!SSD) { srcA = (const unsigned short*)(ws + OFF_Q) + head * 128 + f4 * 4; ldA = 1024;
                    srcB = (const unsigned short*)(ws + OFF_FR) + dir * 1024 + head * 128 + f4 * 4; ldB = 2048;
                    srcV = (const unsigned short*)(ws + OFF_V) + head * 128 + vh * 64 + v4 * 4; ldV = 1024; }
        else { const int g = head >> 2;
               srcA = (const unsigned short*)(ws + OFF_XC) + 1536 + g * 128 + f4 * 4; ldA = 2048;
               srcB = (const unsigned short*)(ws + OFF_XC) + 1024 + g * 128 + f4 * 4; ldB = 2048;
               srcV = (const unsigned short*)(ws + OFF_XC) + head * 64 + v4 * 4; ldV = 2048; }
        const float* DT = (const float*)(ws + OFF_DT) + dir * 16 + head;
        float a_neg = 0.f;
        if (SSD) a_neg = -__expf(P.a_log[dir * 16 + head]);
        u32x2 ra[8], rb[8], rv[4]; float rdt = 0.f;
        auto load_ab = [&](int step) { const int base = chunk_base(step);
#pragma unroll
            for (int ii = 0; ii < 8; ++ii) { const int i = seg * 8 + ii; const int row = base + (dir ? 63 - i : i);
                ra[ii] = *(const u32x2*)(srcA + (size_t)row * ldA); rb[ii] = *(const u32x2*)(srcB + (size_t)row * ldB); } };
        auto load_v = [&](int step) { const int base = chunk_base(step);
#pragma unroll
            for (int ii = 0; ii < 4; ++ii) { const int i = tq * 4 + ii; const int row = base + (dir ? 63 - i : i); rv[ii] = *(const u32x2*)(srcV + (size_t)row * ldV); } };
        auto load_dt = [&](int step) { if (pw == 0) { const int row = chunk_base(step) + (dir ? 63 - lane : lane); rdt = DT[(size_t)row * 32]; } };
        float cumv[8][4], kk[8][4], qq[8][4];
        load_ab(0); load_v(0); if (SSD) load_dt(0);
        for (int n = -1; n < 68; ++n) {
            if (n == 67) { __syncthreads(); __syncthreads(); continue; }
            const int q = (n + 1) & 1;
            LAS unsigned char* KETq = lds + L_KET + q * SZ_KET; LAS unsigned char* VVTq = lds + L_VVT + q * SZ_VVT;
            if (!SSD) {
                float run[4] = {1.f, 1.f, 1.f, 1.f};
#pragma unroll
                for (int ii = 0; ii < 8; ++ii) {
                    kk[ii][0] = h_lo(rb[ii].x); kk[ii][1] = h_hi(rb[ii].x); kk[ii][2] = h_lo(rb[ii].y); kk[ii][3] = h_hi(rb[ii].y);
                    qq[ii][0] = bflo(ra[ii].x); qq[ii][1] = bfhi(ra[ii].x); qq[ii][2] = bflo(ra[ii].y); qq[ii][3] = bfhi(ra[ii].y);
#pragma unroll
                    for (int c = 0; c < 4; ++c) { run[c] *= 1.0f - kk[ii][c]; cumv[ii][c] = run[c]; }
                }
                *(LAS f32x4*)(lds + L_SEG + (seg * 128 + f4 * 4) * 4) = (f32x4){run[0], run[1], run[2], run[3]};
#pragma unroll
                for (int c = 0; c < 4; ++c) {
                    const unsigned w0 = (c < 2) ? rv[0].x : rv[0].y, w1 = (c < 2) ? rv[1].x : rv[1].y, w2 = (c < 2) ? rv[2].x : rv[2].y, w3 = (c < 2) ? rv[3].x : rv[3].y;
                    const unsigned sh = (c & 1) * 16;
                    u32x2 o; o.x = ((w0 >> sh) & 0xffffu) | (((w1 >> sh) & 0xffffu) << 16); o.y = ((w2 >> sh) & 0xffffu) | (((w3 >> sh) & 0xffffu) << 16);
                    *(LAS u32x2*)(VVTq + (v4 * 4 + c) * PB + tq * 8) = o; }
                if (n + 2 < 68) { load_ab(n + 2); load_v(n + 2); }
            } else {
                if (pw == 0) {
                    float c = rdt * a_neg;
#pragma unroll
                    for (int o = 1; o < 64; o <<= 1) { const float t = __shfl_up(c, o); if (lane >= o) c += t; }
                    const float tot = __shfl(c, 63);
                    *(LAS float*)(lds + L_CUM + q * SZ_CUM + lane * 4) = c; *(LAS float*)(lds + L_DTV + q * SZ_CUM + lane * 4) = rdt;
                    *(LAS float*)(lds + L_EE + q * SZ_CUM + lane * 4) = __expf(tot - c);
                    if (lane == 0) *(LAS float*)(lds + L_SEG) = __expf(tot);
                    if (n + 2 < 68) load_dt(n + 2);
                }
            }
            __syncthreads();
            if (!SSD) {
                float offs[4] = {1.f, 1.f, 1.f, 1.f}, tot[4] = {1.f, 1.f, 1.f, 1.f};
#pragma unroll
                for (int s = 0; s < 8; ++s) { const f32x4 t = *(const LAS f32x4*)(lds + L_SEG + (s * 128 + f4 * 4) * 4);
#pragma unroll
                    for (int c = 0; c < 4; ++c) { tot[c] *= t[c]; if (s < seg) offs[c] *= t[c]; } }
                float ke[8][4], inv[4];
#pragma unroll
                for (int c = 0; c < 4; ++c) inv[c] = __builtin_amdgcn_rcpf(offs[c] * cumv[7][c]);
#pragma unroll
                for (int ii = 7; ii >= 0; --ii) { const int i = seg * 8 + ii; float aq[4], ak[4];
#pragma unroll
                    for (int c = 0; c < 4; ++c) { const float eq = offs[c] * cumv[ii][c]; const float ki = kk[ii][c] * inv[c];
                        aq[c] = qq[ii][c] * eq; ak[c] = ki; ke[ii][c] = ki * tot[c]; inv[c] *= 1.0f - kk[ii][c]; }
                    *(LAS u32x2*)(lds + L_AQ + q * SZ_AQ + i * PA + f4 * 8) = (u32x2){pk2(aq[0], aq[1]), pk2(aq[2], aq[3])};
                    *(LAS u32x2*)(lds + L_AK + q * SZ_AQ + i * PA + f4 * 8) = (u32x2){pk2(ak[0], ak[1]), pk2(ak[2], ak[3])}; }
#pragma unroll
                for (int c = 0; c < 4; ++c)
                    *(LAS u32x4*)(KETq + (f4 * 4 + c) * PB + seg * 16) = (u32x4){pk2(ke[0][c], ke[1][c]), pk2(ke[2][c], ke[3][c]), pk2(ke[4][c], ke[5][c]), pk2(ke[6][c], ke[7][c])};
                if (seg == 0) *(LAS f32x4*)(lds + L_DEC + q * SZ_DEC + f4 * 16) = (f32x4){tot[0], tot[1], tot[2], tot[3]};
            } else {
                const LAS float* EE = (const LAS float*)(lds + L_EE + q * SZ_CUM); const LAS float* DTV = (const LAS float*)(lds + L_DTV + q * SZ_CUM);
                if (ptid == 0) *(LAS float*)(lds + L_DEC + q * SZ_DEC) = *(const LAS float*)(lds + L_SEG);
                float ke[8][4];
#pragma unroll
                for (int ii = 0; ii < 8; ++ii) { const int i = seg * 8 + ii; const float ee = EE[i];
                    *(LAS u32x2*)(lds + L_AQ + q * SZ_AQ + i * PA + f4 * 8) = ra[ii];
                    *(LAS u32x2*)(lds + L_AK + q * SZ_AQ + i * PA + f4 * 8) = rb[ii];
                    ke[ii][0] = bflo(rb[ii].x) * ee; ke[ii][1] = bfhi(rb[ii].x) * ee; ke[ii][2] = bflo(rb[ii].y) * ee; ke[ii][3] = bfhi(rb[ii].y) * ee; }
#pragma unroll
                for (int c = 0; c < 4; ++c)
                    *(LAS u32x4*)(KETq + (f4 * 4 + c) * PB + seg * 16) = (u32x4){pk2(ke[0][c], ke[1][c]), pk2(ke[2][c], ke[3][c]), pk2(ke[4][c], ke[5][c]), pk2(ke[6][c], ke[7][c])};
                float xv[4][4];
#pragma unroll
                for (int ii = 0; ii < 4; ++ii) { const float d = DTV[tq * 4 + ii];
                    xv[ii][0] = bflo(rv[ii].x) * d; xv[ii][1] = bfhi(rv[ii].x) * d; xv[ii][2] = bflo(rv[ii].y) * d; xv[ii][3] = bfhi(rv[ii].y) * d; }
#pragma unroll
                for (int c = 0; c < 4; ++c) *(LAS u32x2*)(VVTq + (v4 * 4 + c) * PB + tq * 8) = (u32x2){pk2(xv[0][c], xv[1][c]), pk2(xv[2][c], xv[3][c])};
                if (n + 2 < 68) { load_ab(n + 2); load_v(n + 2); }
            }
            __syncthreads();
        }
    } else {
        unsigned short* Oout = SSD ? (unsigned short*)(ws + OFF_OS) + (size_t)dir * ML * 1024 + head * 64
                                   : (unsigned short*)(ws + OFF_OH) + (size_t)dir * ML * 1024 + head * 128 + vh * 64;
        f32x4 sacc[2][4];
#pragma unroll
        for (int a = 0; a < 2; ++a)
#pragma unroll
            for (int t = 0; t < 4; ++t) sacc[a][t] = (f32x4){0.f, 0.f, 0.f, 0.f};
        const int ti = wave;
        bf16x8 vv[4][2];
        for (int n = -1; n < 68; ++n) {
            if (n < 0) { __syncthreads(); __syncthreads(); continue; }
            const int p = n & 1;
            if (n >= 1) {
                const int pp = p ^ 1;
                const LAS unsigned char* KETp = lds + L_KET + pp * SZ_KET;
#pragma unroll
                for (int a = 0; a < 2; ++a) { const int f0 = wave * 32 + a * 16;
                    f32x4 dv;
                    if (!SSD) dv = *(const LAS f32x4*)(lds + L_DEC + pp * SZ_DEC + (f0 + lq * 4) * 4);
                    else { const float d = *(const LAS float*)(lds + L_DEC + pp * SZ_DEC); dv = (f32x4){d, d, d, d}; }
                    bf16x8 ak[2];
#pragma unroll
                    for (int k = 0; k < 2; ++k) ak[k] = *(const LAS bf16x8*)(KETp + (f0 + l15) * PB + k * 64 + lq * 16);
#pragma unroll
                    for (int tv = 0; tv < 4; ++tv) { f32x4 s = sacc[a][tv] * dv;
#pragma unroll
                        for (int k = 0; k < 2; ++k) s = MFMA16(ak[k], vv[tv][k], s);
                        sacc[a][tv] = s;
                        u32x2 w; w.x = pk2(s[0], s[1]); w.y = pk2(s[2], s[3]);
                        *(LAS u32x2*)(lds + L_ST + (tv * 16 + l15) * PA + (f0 + lq * 4) * 2) = w; } }
            }
            __syncthreads();
            const bool isctx = n < 4;
            const int base = chunk_base(n);
            const LAS float* CUM = (const LAS float*)(lds + L_CUM + p * SZ_CUM);
            const LAS unsigned char* VVTp = lds + L_VVT + p * SZ_VVT;
            const LAS unsigned char* AQp = lds + L_AQ + p * SZ_AQ; const LAS unsigned char* AKp = lds + L_AK + p * SZ_AQ;
#pragma unroll
            for (int tv = 0; tv < 4; ++tv)
#pragma unroll
                for (int k = 0; k < 2; ++k) vv[tv][k] = *(const LAS bf16x8*)(VVTp + (tv * 16 + l15) * PB + k * 64 + lq * 16);
            if (!isctx) {
                bf16x8 bq[4];
#pragma unroll
                for (int k = 0; k < 4; ++k) bq[k] = *(const LAS bf16x8*)(AQp + (ti * 16 + l15) * PA + k * 64 + lq * 16);
                const int i = ti * 16 + l15;
                float ci = 0.f; if (SSD) ci = CUM[i];
#pragma unroll
                for (int tj = 0; tj < 4; ++tj) { const int j0 = tj * 16 + lq * 4;
                    u32x2 w = {0u, 0u};
                    if (tj <= ti) {
                        f32x4 a = {0.f, 0.f, 0.f, 0.f};
#pragma unroll
                        for (int k = 0; k < 4; ++k) { const bf16x8 ak = *(const LAS bf16x8*)(AKp + (tj * 16 + l15) * PA + k * 64 + lq * 16); a = MFMA16(ak, bq[k], a); }
#pragma unroll
                        for (int jj = 0; jj < 4; ++jj) { const int j = j0 + jj; float v = a[jj];
                            if (SSD) v *= __expf(fminf(ci - CUM[j], 0.f));
                            a[jj] = (j <= i) ? v : 0.f; }
                        w.x = pk2(a[0], a[1]); w.y = pk2(a[2], a[3]);
                    }
                    *(LAS u32x2*)(lds + L_SC + i * PB + j0 * 2) = w; }
                asm volatile("" ::: "memory"); __builtin_amdgcn_wave_barrier(); asm volatile("" ::: "memory");
                bf16x8 bs[2];
#pragma unroll
                for (int k = 0; k < 2; ++k) bs[k] = *(const LAS bf16x8*)(lds + L_SC + (ti * 16 + l15) * PB + k * 64 + lq * 16);
                const int row = base + (dir ? 63 - i : i);
                float rs = 1.0f; if (SSD) rs = __expf(ci);
#pragma unroll
                for (int tv = 0; tv < 4; ++tv) {
                    f32x4 a1 = {0.f, 0.f, 0.f, 0.f}, a2 = {0.f, 0.f, 0.f, 0.f};
#pragma unroll
                    for (int k = 0; k < 2; ++k) a1 = MFMA16(vv[tv][k], bs[k], a1);
#pragma unroll
                    for (int k = 0; k < 4; ++k) { const bf16x8 as = *(const LAS bf16x8*)(lds + L_ST + (tv * 16 + l15) * PA + k * 64 + lq * 16); a2 = MFMA16(as, bq[k], a2); }
                    const f32x4 o = a1 + a2 * rs;
                    u32x2 w; w.x = pk2(o[0], o[1]); w.y = pk2(o[2], o[3]);
                    *(u32x2*)(Oout + (size_t)row * 1024 + tv * 16 + lq * 4) = w; }
            }
            __syncthreads();
        }
    }
    __syncthreads();
}

__device__ __forceinline__ void phase_scan(const Params& P, LAS unsigned char* lds, int pass) {
    for (int it = blockIdx.x; it < 256; it += gridDim.x) {
        if (it < 128) scan_item<false>(P, lds, pass, it); else scan_item<true>(P, lds, pass, it - 128);
    }
}

__device__ __forceinline__ void unpack8(const u32x4 w, float (&o)[8]) { o[0] = bflo(w.x); o[1] = bfhi(w.x); o[2] = bflo(w.y); o[3] = bfhi(w.y); o[4] = bflo(w.z); o[5] = bfhi(w.z); o[6] = bflo(w.w); o[7] = bfhi(w.w); }
__device__ __forceinline__ void phase_readout(const Params& P) {
    const int tid_ = opaque_tid(); const int lane = tid_ & 63, wave = tid_ >> 6;
    unsigned char* ws = P.ws;
    const bf16_t* OH = (const bf16_t*)(ws + OFF_OH); const bf16_t* OS = (const bf16_t*)(ws + OFF_OS);
    const bf16_t* G = (const bf16_t*)(ws + OFF_G); const bf16_t* Z = (const bf16_t*)(ws + OFF_Z); const bf16_t* XC = (const bf16_t*)(ws + OFF_XC);
    bf16_t* A2 = (bf16_t*)(ws + OFF_A2);
    const int c0 = lane * 16;
    float hw[16], sw[16];
#pragma unroll
    for (int e = 0; e < 16; ++e) { hw[e] = P.hgrn_norm[(c0 + e) & 127]; sw[e] = P.ssd_norm[c0 + e]; }
    const float dsk = P.ssd_d[lane >> 2];
    for (int r = blockIdx.x * 8 + wave; r < ML; r += gridDim.x * 8) {
        float o[16], t[8];
        { const u32x4* p0 = (const u32x4*)(OH + (size_t)r * 1024 + c0); const u32x4* p1 = (const u32x4*)(OH + ((size_t)ML + r) * 1024 + c0); const u32x4* pg = (const u32x4*)(G + (size_t)r * 1024 + c0);
          const u32x4 a0 = p0[0], a1 = p0[1], b0 = p1[0], b1 = p1[1], g0 = pg[0], g1 = pg[1];
          unpack8(a0, t);
#pragma unroll
          for (int e = 0; e < 8; ++e) o[e] = t[e];
          unpack8(a1, t);
#pragma unroll
          for (int e = 0; e < 8; ++e) o[8 + e] = t[e];
          unpack8(b0, t);
#pragma unroll
          for (int e = 0; e < 8; ++e) o[e] += t[e];
          unpack8(b1, t);
#pragma unroll
          for (int e = 0; e < 8; ++e) o[8 + e] += t[e];
          float ss = 0.f;
#pragma unroll
          for (int e = 0; e < 16; ++e) ss += o[e] * o[e];
          ss += __shfl_xor(ss, 1); ss += __shfl_xor(ss, 2); ss += __shfl_xor(ss, 4);
          const float rstd = rsqrtf(ss * (1.0f / 128.0f) + EPS);
          float gg[16]; unpack8(g0, t);
#pragma unroll
          for (int e = 0; e < 8; ++e) gg[e] = t[e];
          unpack8(g1, t);
#pragma unroll
          for (int e = 0; e < 8; ++e) gg[8 + e] = t[e];
#pragma unroll
          for (int e = 0; e < 16; ++e) o[e] = o[e] * rstd * hw[e] * gg[e];
          u32x4 w0, w1; w0.x = pk2(o[0], o[1]); w0.y = pk2(o[2], o[3]); w0.z = pk2(o[4], o[5]); w0.w = pk2(o[6], o[7]);
          w1.x = pk2(o[8], o[9]); w1.y = pk2(o[10], o[11]); w1.z = pk2(o[12], o[13]); w1.w = pk2(o[14], o[15]);
          u32x4* po = (u32x4*)(A2 + (size_t)r * 2048 + c0); po[0] = w0; po[1] = w1; }
        { const u32x4* p0 = (const u32x4*)(OS + (size_t)r * 1024 + c0); const u32x4* p1 = (const u32x4*)(OS + ((size_t)ML + r) * 1024 + c0);
          const u32x4* pz = (const u32x4*)(Z + (size_t)r * 1024 + c0); const u32x4* px = (const u32x4*)(XC + (size_t)r * 2048 + c0);
          const u32x4 a0 = p0[0], a1 = p0[1], b0 = p1[0], b1 = p1[1], z0 = pz[0], z1 = pz[1], x0 = px[0], x1 = px[1];
          unpack8(a0, t);
#pragma unroll
          for (int e = 0; e < 8; ++e) o[e] = t[e];
          unpack8(a1, t);
#pragma unroll
          for (int e = 0; e < 8; ++e) o[8 + e] = t[e];
          unpack8(b0, t);
#pragma unroll
          for (int e = 0; e < 8; ++e) o[e] += t[e];
          unpack8(b1, t);
#pragma unroll
          for (int e = 0; e < 8; ++e) o[8 + e] += t[e];
          unpack8(x0, t);
#pragma unroll
          for (int e = 0; e < 8; ++e) o[e] += dsk * t[e];
          unpack8(x1, t);
#pragma unroll
          for (int e = 0; e < 8; ++e) o[8 + e] += dsk * t[e];
          unpack8(z0, t);
#pragma unroll
          for (int e = 0; e < 8; ++e) o[e] *= t[e];
          unpack8(z1, t);
#pragma unroll
          for (int e = 0; e < 8; ++e) o[8 + e] *= t[e];
          float ss = 0.f;
#pragma unroll
          for (int e = 0; e < 16; ++e) ss += o[e] * o[e];
          ss += __shfl_xor(ss, 1); ss += __shfl_xor(ss, 2); ss += __shfl_xor(ss, 4); ss += __shfl_xor(ss, 8);
          const float rstd = rsqrtf(ss * (1.0f / 256.0f) + EPS);
#pragma unroll
          for (int e = 0; e < 16; ++e) o[e] = o[e] * rstd * sw[e];
          u32x4 w0, w1; w0.x = pk2(o[0], o[1]); w0.y = pk2(o[2], o[3]); w0.z = pk2(o[4], o[5]); w0.w = pk2(o[6], o[7]);
          w1.x = pk2(o[8], o[9]); w1.y = pk2(o[10], o[11]); w1.z = pk2(o[12], o[13]); w1.w = pk2(o[14], o[15]);
          u32x4* po = (u32x4*)(A2 + (size_t)r * 2048 + 1024 + c0); po[0] = w0; po[1] = w1; }
    }
}

__device__ __forceinline__ void grid_barrier(unsigned* ctr, unsigned target) {
    __builtin_amdgcn_fence(__ATOMIC_RELEASE, "agent");
    __syncthreads();
    if (threadIdx.x == 0) {
        __hip_atomic_fetch_add(ctr, 1u, __ATOMIC_RELAXED, __HIP_MEMORY_SCOPE_AGENT);
        while (__hip_atomic_load(ctr, __ATOMIC_RELAXED, __HIP_MEMORY_SCOPE_AGENT) < target) __builtin_amdgcn_s_sleep(2);
    }
    __syncthreads();
    __builtin_amdgcn_fence(__ATOMIC_ACQUIRE, "agent");
}
#define XB_TMO      128
#define XB_XCNT(j)  (256  + 64 * (j))
#define XB_XSUB(j)  (1280 + 64 * (j))
#define XB_XGEN(j)  (2304 + 64 * (j))
#define XB_TOP      3328
#define XB_TOPGEN   3392
#define XCD_BAR_WORDS 3456
#define XB_SPIN_CAP (1u << 22)

__device__ __forceinline__ unsigned xb_ld(unsigned* p)              { return __hip_atomic_load(p, __ATOMIC_RELAXED, __HIP_MEMORY_SCOPE_AGENT); }
__device__ __forceinline__ unsigned xb_add(unsigned* p, unsigned v) { return __hip_atomic_fetch_add(p, v, __ATOMIC_RELAXED, __HIP_MEMORY_SCOPE_AGENT); }
__device__ __forceinline__ unsigned xb_xcc_id() { return (unsigned)__builtin_amdgcn_s_getreg((3 << 11) | 20) & 0xFu; }
#define XB_SPIN(cond, bar) do { unsigned _sp = 0; while (cond) { __builtin_amdgcn_s_sleep(1); \
    if ((++_sp & 255u) == 0u) { if (xb_ld(&(bar)[XB_TMO])) break; if (_sp > XB_SPIN_CAP) { atomicAdd(&(bar)[XB_TMO], 1u); break; } } } } while (0)

struct XcdBarrier {
    unsigned* bar; unsigned x;
    volatile LAS unsigned* st;
};

__device__ __forceinline__ XcdBarrier xcd_barrier_post(unsigned* bar, volatile LAS unsigned* st) {
    XcdBarrier b; b.bar = bar; b.x = xb_xcc_id(); b.st = st;
    if (threadIdx.x == 0) (void)xb_add(&bar[XB_XCNT(b.x)], 1u);
    return b;
}
__device__ __forceinline__ void xcd_barrier_complete(unsigned* bar, unsigned x, unsigned& nloc, unsigned& nx) {
    const unsigned G = gridDim.x * gridDim.y * gridDim.z;
    unsigned sum, cnt, mine, sp = 0u;
    for (;;) {
        sum = 0u; cnt = 0u; mine = 0u;
#pragma unroll
        for (unsigned j = 0; j < 16; ++j) { const unsigned c = xb_ld(&bar[XB_XCNT(j)]); sum += c; cnt += (c > 0u) ? 1u : 0u; mine = (j == x) ? c : mine; }
        if (sum == G) break;
        __builtin_amdgcn_s_sleep(1);
        if ((++sp & 255u) == 0u) { if (xb_ld(&bar[XB_TMO])) break; if (sp > XB_SPIN_CAP) { atomicAdd(&bar[XB_TMO], 1u); break; } }
    }
    nloc = mine > 0u ? mine : 1u; nx = cnt > 0u ? cnt : 1u;
}

__device__ __forceinline__ void xcd_barrier(const XcdBarrier& b) {
    asm volatile("s_waitcnt vmcnt(0)" ::: "memory");
    __syncthreads();
    if (threadIdx.x == 0) {
        unsigned* bar = b.bar;
        __builtin_amdgcn_s_waitcnt(0);
        unsigned nloc = b.st[0], nx = b.st[1];
        if (nloc == 0u) { xcd_barrier_complete(bar, b.x, nloc, nx); b.st[0] = nloc; b.st[1] = nx; }
        const unsigned old = xb_add(&bar[XB_XSUB(b.x)], 1u);
        const unsigned gen = old / nloc;
        if (old + 1u == (gen + 1u) * nloc) {
            __builtin_amdgcn_fence(__ATOMIC_RELEASE, "agent");
            asm volatile("s_waitcnt vmcnt(0)" ::: "memory");
            const unsigned og = xb_add(&bar[XB_TOP], 1u);
            const unsigned tg = og / nx;
            if (og + 1u == (tg + 1u) * nx) xb_add(&bar[XB_TOPGEN], 1u);
            else XB_SPIN(xb_ld(&bar[XB_TOPGEN]) == tg, bar);
            __builtin_amdgcn_fence(__ATOMIC_ACQUIRE, "agent");
            xb_add(&bar[XB_XGEN(b.x)], 1u);
            asm volatile("s_waitcnt vmcnt(0)" ::: "memory");
        } else {
            XB_SPIN(xb_ld(&bar[XB_XGEN(b.x)]) == gen, bar);
            __builtin_amdgcn_fence(__ATOMIC_ACQUIRE, "agent");
            asm volatile("s_waitcnt vmcnt(0)" ::: "memory");
        }
    }
    __syncthreads();
}

#ifndef MK_PH_LO
#define MK_PH_LO 0
#endif
__global__ void __launch_bounds__(NT, 2) fwd_megakernel(Params P, int ph_lo, int ph_hi) {
    extern __shared__ __attribute__((aligned(16))) unsigned char lds_raw[];
    LAS unsigned char* lds = (LAS unsigned char*)lds_raw;
    cg::grid_group grid = cg::this_grid();
    unsigned char* ws = P.ws;
    const float* mod = (const float*)(ws + OFF_MOD);
    int ph = 0; unsigned nbar = 0; unsigned* barw = (unsigned*)(ws + OFF_BAR);
#if !defined(MK_OWN_BARRIER)
    if (threadIdx.x < 4) ((LAS unsigned*)(lds + LDS_XB))[threadIdx.x] = 0u;
    __syncthreads();
    XcdBarrier xbar = xcd_barrier_post(barw, (volatile LAS unsigned*)(lds + LDS_XB));
#endif
#if defined(MK_OWN_BARRIER)
    grid.sync();
#endif
#ifndef MK_DUP
#define MK_DUP 0
#endif
#define REPS(bit) for (int rep_ = 0; rep_ < ((MK_DUP & (bit)) ? 2 : 1); ++rep_)
#ifndef MK_MASK
#define MK_MASK 0xffff
#endif
#define PHASE_BEGIN() (ph >= ph_lo && ph < ph_hi)
#if defined(MK_OWN_BARRIER)
#define PHASE_END() do { ++ph; if (ph > ph_lo && ph < ph_hi) { ++nbar; grid_barrier(barw, nbar * gridDim.x); } } while (0)
#else
#define PHASE_END() do { ++ph; if (ph > ph_lo && ph < ph_hi) { if (ph == 1) grid.sync(); else xcd_barrier(xbar); } } while (0)
#endif
    if ((MK_MASK & 1) && PHASE_BEGIN()) REPS(1) phase_prep(P, lds);
    PHASE_END();
    for (int pass = 0; pass < NPASS; ++pass) {
        if ((MK_MASK & 2) && PHASE_BEGIN()) REPS(2) phase_norm<0>(P, pass);
        PHASE_END();
        if ((MK_MASK & 4) && PHASE_BEGIN()) REPS(4) {
            pg8::Gemm g{(const bf16_t*)(ws + OFF_U), (const bf16_t*)(ws + OFF_WIN), MP, NPAD, D}; pg8::StaticOrder S; S.init(MP, NPAD, gridDim.x, blockIdx.x);
            EpiIn E{ws, P.dt_bias};
            pg8::gemm_phase<EpiIn, pg8::StaticOrder>(lds, g, S, E, nullptr);
        }
        PHASE_END();
        if ((MK_MASK & 8) && PHASE_BEGIN()) REPS(8) phase_conv(P);
        PHASE_END();
        if ((MK_MASK & 16) && PHASE_BEGIN()) REPS(16) phase_scan(P, lds, pass);
        PHASE_END();
        if ((MK_MASK & 32) && PHASE_BEGIN()) REPS(32) phase_readout(P);
        PHASE_END();
        if ((MK_MASK & 64) && PHASE_BEGIN()) REPS(64) {
            pg8::Gemm g{(const bf16_t*)(ws + OFF_A2), (const bf16_t*)(ws + OFF_WOUT), ML, D, 2048}; pg8::StaticOrder S; S.init(ML, D, gridDim.x, blockIdx.x);
            EpiOut E{P.x, mod, (float*)(ws + (pass == 0 ? OFF_H1A : OFF_H1B)), pass};
            pg8::gemm_phase<EpiOut, pg8::StaticOrder>(lds, g, S, E, nullptr);
        }
        if (pass + 1 < NPASS) ++ph; else PHASE_END();
    }
    if ((MK_MASK & 128) && PHASE_BEGIN()) REPS(128) phase_norm<1>(P, 0);
    PHASE_END();
    if ((MK_MASK & 256) && PHASE_BEGIN()) REPS(256) {
        pg8::Gemm g{(const bf16_t*)(ws + OFF_U2), (const bf16_t*)(ws + OFF_WGU), 2 * ML, 2 * DFF, D}; pg8::StaticOrder S; S.init(2 * ML, 2 * DFF, gridDim.x, blockIdx.x);
        EpiGU E{(bf16_t*)(ws + OFF_ACT)};
        pg8::gemm_phase<EpiGU, pg8::StaticOrder>(lds, g, S, E, nullptr);
    }
    PHASE_END();
    if ((MK_MASK & 512) && PHASE_BEGIN()) REPS(512) {
        pg8::Gemm g{(const bf16_t*)(ws + OFF_ACT), (const bf16_t*)(ws + OFF_WD), 2 * ML, D, DFF}; pg8::StaticOrder S; S.init(2 * ML, D, gridDim.x, blockIdx.x);
        EpiDown E{(const float*)(ws + OFF_H1A), (const float*)(ws + OFF_H1B), mod, P.out};
        pg8::gemm_phase<EpiDown, pg8::StaticOrder>(lds, g, S, E, nullptr);
    }
    PHASE_END();
    if ((MK_MASK & 1024) && PHASE_BEGIN()) phase_final_norm(P, 0);
}
}

extern "C" void kernel_launch(void* const* d_in, const int* in_sizes, int n_in, void* d_out, int out_size, void* d_ws, size_t ws_size, hipStream_t stream) {
    static int grid_blocks = 0;
    if (grid_blocks == 0) {
        if (n_in != 22 || ws_size < mk::WS_END) { fprintf(stderr, "kernel_launch: unexpected n_in %d or ws_size %zu (< %zu)\n", n_in, ws_size, (size_t)mk::WS_END); }
        int dev = 0, cus = 0, per_cu = 0;
        hipGetDevice(&dev);
        hipDeviceGetAttribute(&cus, hipDeviceAttributeMultiprocessorCount, dev);
        if (hipFuncSetAttribute((const void*)mk::fwd_megakernel, hipFuncAttributeMaxDynamicSharedMemorySize, mk::LDS_BYTES) != hipSuccess) fprintf(stderr, "kernel_launch: hipFuncSetAttribute failed\n");
        hipOccupancyMaxActiveBlocksPerMultiprocessor(&per_cu, (const void*)mk::fwd_megakernel, mk::NT, mk::LDS_BYTES);
        if (per_cu < 1) { fprintf(stderr, "kernel_launch: occupancy query returned %d\n", per_cu); per_cu = 1; }
        grid_blocks = cus * 1;
        (void)hipGetLastError();
    }
#ifdef MK_ZERO_WS
    (void)hipMemsetAsync((char*)d_ws + mk::OFF_Q, 0, mk::WS_END - mk::OFF_Q, stream);
#endif
    (void)hipMemsetAsync((char*)d_ws + mk::OFF_BAR, 0, mk::BAR_BYTES, stream);
    mk::Params p{};
    const float** pp = (const float**)&p;
    for (int i = 0; i < 22; ++i) pp[i] = (const float*)d_in[i];
    p.out = (float*)d_out; p.ws = (unsigned char*)d_ws;
    int ph_lo = 0, ph_hi = 1000;
    void* args[] = {&p, &ph_lo, &ph_hi};
    hipError_t e = hipLaunchCooperativeKernel((const void*)mk::fwd_megakernel, dim3(grid_blocks), dim3(mk::NT), args, mk::LDS_BYTES, stream);
    if (e != hipSuccess) fprintf(stderr, "cooperative launch failed: %s (grid %d)\n", hipGetErrorString(e), grid_blocks);
}
```

```cpp
#include <hip/hip_runtime.h>
#include <hip/hip_cooperative_groups.h>
#include <cstdio>
namespace cg = cooperative_groups;
__device__ __forceinline__ int opaque_tid() { int t = threadIdx.x; asm volatile("" : "+v"(t)); return t; }
namespace pg8 {
#define PG8_LAS __attribute__((address_space(3)))
typedef unsigned short bf16_t;
typedef short bf16x8 __attribute__((ext_vector_type(8)));
typedef float f32x4 __attribute__((ext_vector_type(4)));
typedef unsigned u32x4 __attribute__((ext_vector_type(4)));
constexpr int BM = 256, BK = 64, HALF = 128, HTB = HALF * BK * 2  , STAGE_BYTES = 8 * HTB, NXCD = 8, WGM = 8;

__host__ __device__ __forceinline__ int lds_byte(int r, int c) { const int st = (r >> 4) * 2 + (c >> 5), rr = r & 15, cc = c & 31, ob = rr * 64 + cc * 2; return st * 1024 + (ob ^ (((ob >> 9) & 1) << 5)); }
__host__ __device__ __forceinline__ void stage_rc(int b, int& R, int& C) { const int st = b / 1024, sb = b % 1024, swz = sb ^ (((sb >> 9) & 1) << 5); R = (st >> 1) * 16 + swz / 64; C = (st & 1) * 32 + (swz % 64) / 2; }
__host__ __device__ __forceinline__ int perm32(int rho) { const int n = rho >> 4, i = rho & 15; return 8 * (i >> 2) + 4 * n + (i & 3); }

struct Unit { int pm, pn; };
struct Gemm { const bf16_t* A; const bf16_t* Bt; int M, N, K; };

struct StaticOrder {
    int nM, nN, nwg, G, c;
    __host__ __device__ void init(int M, int N, int G_, int c_) { nM = M / BM; nN = N / BM; nwg = nM * nN; G = G_; c = c_; }
    __host__ __device__ bool next(int i, Unit& u) const {
        const long L = (long)i * G + c; if (L >= nwg) return false;
        int wgid = (int)L; { const int q = nwg / NXCD, r = nwg % NXCD, xcd = wgid % NXCD, off = wgid / NXCD; wgid = (xcd < r ? xcd * (q + 1) : r * (q + 1) + (xcd - r) * q) + off; }
        const int nig = WGM * nN, gid = wgid / nig, fm = gid * WGM, gsz = (nM - fm) < WGM ? (nM - fm) : WGM;
        u.pm = fm + ((wgid % nig) % gsz); u.pn = (wgid % nig) / gsz; return true;
    }
    __device__ __forceinline__ void a_ready(const Unit&) const {}
    __device__ __forceinline__ void done(const Unit&) const {}
};
typedef __bf16 bf16v2_t __attribute__((ext_vector_type(2)));
typedef float f32v2_t __attribute__((ext_vector_type(2)));
__device__ __forceinline__ unsigned cvt_pk_bf16(float lo, float hi) { f32v2_t v = {lo, hi}; bf16v2_t r = __builtin_convertvector(v, bf16v2_t); return __builtin_bit_cast(unsigned, r); }
typedef float f32x2 __attribute__((ext_vector_type(2)));
template <class Epi, class Sched, bool STAMP = false>
__device__ __forceinline__ void gemm_phase(PG8_LAS unsigned char* lds, const Gemm g, const Sched& S, const Epi& E, unsigned long long* stamps) {
    const int tid = opaque_tid(), wid = __builtin_amdgcn_readfirstlane(tid >> 6), lane = tid & 63, wr = wid >> 2, wc = wid & 3, fr = lane & 15, fq = lane >> 4;
    const int K = g.K, nt = K / BK;
    int ts_lo = 0, ts_hi = 0, nts = 0; const unsigned long long rt_entry = STAMP ? (unsigned long long)wall_clock64() : 0ull;
#define PG8_STAMP() do { if (STAMP && wid == 0 && nts < 64) { const unsigned long long _c = (unsigned long long)clock64(); \
        ts_lo = (lane == nts) ? (int)(unsigned)_c : ts_lo; ts_hi = (lane == nts) ? (int)(unsigned)(_c >> 32) : ts_hi; ++nts; } } while (0)
    PG8_STAMP();
    unsigned voffA[2], voffB[2];
#pragma unroll
    for (int i = 0; i < 2; ++i) { int R, C; stage_rc(tid * 16 + i * 8192, R, C); const int Rb = Epi::PERM ? ((R & ~31) + perm32(R & 31)) : R;
        voffA[i] = (unsigned)(R * K + C) * 2u; voffB[i] = (unsigned)(Rb * K + C) * 2u; }
    const size_t kstep = (size_t)(BK * 2);
    const size_t hstep = (size_t)HALF * K * 2;
    const size_t tstep = 2 * hstep;
    const unsigned ldsw = (unsigned)wid * 1024u;
    const int aoff = lds_byte(wr * 64 + fr, fq * 8), boff = lds_byte(wc * 32 + fr, fq * 8);
#define PG8_SA(b, h) (((b) * 2 + (h)) * HTB)
#define PG8_SB(b, h) ((4 + (b) * 2 + (h)) * HTB)
#define PG8_STAGE(bufoff, gbase, voff) do { _Pragma("unroll") for (int _i = 0; _i < 2; ++_i) \
        __builtin_amdgcn_global_load_lds((const unsigned*)((const char*)(gbase) + (voff)[_i]), (PG8_LAS unsigned*)(lds + (bufoff) + ldsw + _i * 8192), 16, 0, 0); } while (0)
#define PG8_LDA(dst, b, h) do { _Pragma("unroll") for (int m = 0; m < 4; ++m) _Pragma("unroll") for (int k = 0; k < 2; ++k) dst[m][k] = *(const PG8_LAS bf16x8*)(lds + PG8_SA(b, h) + aoff + m * 2048 + k * 1024); } while (0)
#define PG8_LDB(dst, b, h) do { _Pragma("unroll") for (int n = 0; n < 2; ++n) _Pragma("unroll") for (int k = 0; k < 2; ++k) dst[n][k] = *(const PG8_LAS bf16x8*)(lds + PG8_SB(b, h) + boff + n * 2048 + k * 1024); } while (0)
#define PG8_MMA(ai, bj, At, Bt) do { __builtin_amdgcn_s_setprio(1); _Pragma("unroll") for (int m = 0; m < 4; ++m) _Pragma("unroll") for (int n = 0; n < 2; ++n) _Pragma("unroll") for (int k = 0; k < 2; ++k) \
        acc[ai][bj][m][n] = __builtin_amdgcn_mfma_f32_16x16x32_bf16(Bt[n][k], At[m][k], acc[ai][bj][m][n], 0, 0, 0); __builtin_amdgcn_s_setprio(0); } while (0)
#define PG8_WAIT_V(n) asm volatile("s_waitcnt vmcnt(" #n ")" ::: "memory")
#define PG8_WAIT_L(n) asm volatile("s_waitcnt lgkmcnt(" #n ")" ::: "memory")
#define PG8_BAR __builtin_amdgcn_s_barrier()
#define PG8_SCHED __builtin_amdgcn_sched_barrier(0)
    Unit cur, nxt; int ui = 0;
    if (!S.next(0, cur)) return;
    f32x4 acc[2][2][4][2];
#pragma unroll
    for (int a = 0; a < 2; ++a)
#pragma unroll
        for (int b = 0; b < 2; ++b)
#pragma unroll
            for (int m = 0; m < 4; ++m)
#pragma unroll
                for (int n = 0; n < 2; ++n) acc[a][b][m][n] = (f32x4){0.f, 0.f, 0.f, 0.f};
    bf16x8 At[4][2], B0[2][2], B1[2][2];
    const char* cA = (const char*)g.A + (size_t)cur.pm * tstep; const char* cB = (const char*)g.Bt + (size_t)cur.pn * tstep;
    S.a_ready(cur);
    PG8_STAGE(PG8_SB(0, 0), cB, voffB); PG8_STAGE(PG8_SA(0, 0), cA, voffA); PG8_STAGE(PG8_SB(0, 1), cB + hstep, voffB); PG8_STAGE(PG8_SA(0, 1), cA + hstep, voffA);
    if (wr == 1) PG8_BAR;
    PG8_WAIT_V(4); PG8_BAR;
    PG8_STAGE(PG8_SB(1, 0), cB + kstep, voffB); PG8_STAGE(PG8_SA(1, 0), cA + kstep, voffA); PG8_STAGE(PG8_SB(1, 1), cB + hstep + kstep, voffB);
    PG8_WAIT_V(6); PG8_BAR;
    PG8_STAMP();
    for (;;) {
        const bool has_next = S.next(ui + 1, nxt);
        const char* nA = has_next ? (const char*)g.A + (size_t)nxt.pm * tstep : cA; const char* nB = has_next ? (const char*)g.Bt + (size_t)nxt.pn * tstep : cB;
        for (int t = 0; t < nt; t += 2) {
            const bool last = (t == nt - 2);
            const char* a1 = cA + (size_t)(t + 1) * kstep;
            const char* a2 = last ? nA : cA + (size_t)(t + 2) * kstep; const char* b2 = last ? nB : cB + (size_t)(t + 2) * kstep;
            const char* a3 = a2 + kstep; const char* b3 = b2 + kstep;
            if (last && has_next) S.a_ready(nxt);
            PG8_LDB(B0, 0, 0); PG8_SCHED; PG8_LDA(At, 0, 0); PG8_STAGE(PG8_SA(1, 1), a1 + hstep, voffA);
            PG8_WAIT_L(8); PG8_BAR; PG8_WAIT_L(0); PG8_MMA(0, 0, At, B0); PG8_BAR; PG8_SCHED;
            PG8_LDB(B1, 0, 1); PG8_STAGE(PG8_SB(0, 0), b2, voffB);
            PG8_BAR; PG8_WAIT_L(0); PG8_MMA(0, 1, At, B1); PG8_BAR;
            PG8_LDA(At, 0, 1); PG8_STAGE(PG8_SA(0, 0), a2, voffA);
            PG8_BAR; PG8_WAIT_L(0); PG8_MMA(1, 0, At, B0); PG8_BAR; PG8_SCHED;
            PG8_STAGE(PG8_SB(0, 1), b2 + hstep, voffB);
            PG8_WAIT_V(6); PG8_BAR; PG8_MMA(1, 1, At, B1); PG8_BAR;
            PG8_LDB(B0, 1, 0); PG8_SCHED; PG8_LDA(At, 1, 0); PG8_STAGE(PG8_SA(0, 1), a2 + hstep, voffA);
            PG8_WAIT_L(8); PG8_BAR; PG8_WAIT_L(0); PG8_MMA(0, 0, At, B0); PG8_BAR; PG8_SCHED;
            PG8_LDB(B1, 1, 1); PG8_STAGE(PG8_SB(1, 0), b3, voffB);
            PG8_BAR; PG8_WAIT_L(0); PG8_MMA(0, 1, At, B1); PG8_BAR;
            PG8_LDA(At, 1, 1); PG8_STAGE(PG8_SA(1, 0), a3, voffA);
            PG8_BAR; PG8_WAIT_L(0); PG8_MMA(1, 0, At, B0); PG8_BAR; PG8_SCHED;
            PG8_STAGE(PG8_SB(1, 1), b3 + hstep, voffB);
            PG8_WAIT_V(6); PG8_BAR; PG8_MMA(1, 1, At, B1); PG8_BAR;
        }
        PG8_STAMP();
        if constexpr (!Epi::AFTER_DRAIN) { E(acc, cur, wr, wc, fr, fq); S.done(cur); }
        PG8_STAMP();
        if (!has_next) break;
#pragma unroll
        for (int a = 0; a < 2; ++a)
#pragma unroll
            for (int b = 0; b < 2; ++b)
#pragma unroll
                for (int m = 0; m < 4; ++m)
#pragma unroll
                    for (int n = 0; n < 2; ++n) acc[a][b][m][n] = (f32x4){0.f, 0.f, 0.f, 0.f};
        cur = nxt; cA = nA; cB = nB; ++ui;
    }
    PG8_WAIT_V(0);
    if (wr == 0) PG8_BAR;
    PG8_BAR;
    if constexpr (Epi::AFTER_DRAIN) { E.fused(acc, cur, wr, wc, fr, fq, lds, wid, lane); S.done(cur); }
    PG8_STAMP();
    if (STAMP && wid == 0) { stamps[lane] = lane < nts ? (((unsigned long long)(unsigned)ts_hi << 32) | (unsigned)ts_lo) : 0ull;
        if (lane == 62) stamps[62] = rt_entry; if (lane == 63) stamps[63] = (unsigned long long)wall_clock64(); }
#undef PG8_STAMP
#undef PG8_SA
#undef PG8_SB
#undef PG8_STAGE
#undef PG8_LDA
#undef PG8_LDB
#undef PG8_MMA
#undef PG8_WAIT_V
#undef PG8_WAIT_L
#undef PG8_BAR
#undef PG8_SCHED
}
}

namespace mk {
using pg8::bf16_t; using pg8::bf16x8; using pg8::f32x4; using pg8::u32x4; using pg8::Unit;
#define LAS __attribute__((address_space(3)))
typedef unsigned u32x2 __attribute__((ext_vector_type(2)));
typedef _Float16 f16;

constexpr int D = 1024, NB = 8, SEQ = 4096, CTX = 256, DIN = 8224, NPAD = 8448, DFF = 2816;
constexpr int BP = 4;
constexpr int NPASS = NB / BP;
constexpr int ML = BP * SEQ;
constexpr int MC = BP * CTX;
constexpr int MP = ML + MC;
constexpr float EPS = 1e-6f;
constexpr int NT = 512;
constexpr int LDS_XB = 158208;
constexpr int LDS_BYTES = LDS_XB + 16;

constexpr size_t SZ_WIN = (size_t)NPAD * D * 2, SZ_WOUT = (size_t)D * 2048 * 2, SZ_WGU = (size_t)2 * DFF * D * 2, SZ_WD = (size_t)D * DFF * 2;
constexpr size_t OFF_WIN = 0, OFF_WOUT = OFF_WIN + SZ_WIN, OFF_WGU = OFF_WOUT + SZ_WOUT, OFF_WD = OFF_WGU + SZ_WGU;
constexpr size_t OFF_MOD = OFF_WD + SZ_WD;
constexpr size_t OFF_LB = OFF_MOD + 9 * 6144 * 4;
constexpr size_t OFF_BAR = OFF_LB + 2048 * 4;
constexpr size_t BAR_BYTES = 16384;
constexpr size_t OFF_Q = OFF_BAR + BAR_BYTES;
constexpr size_t OFF_FR = OFF_Q + (size_t)MP * 1024 * 2;
constexpr size_t OFF_V = OFF_FR + (size_t)MP * 2048 * 2;
constexpr size_t OFF_DT = OFF_V + (size_t)MP * 1024 * 2;
constexpr size_t OFF_G = OFF_DT + (size_t)MP * 32 * 4;
constexpr size_t OFF_Z = OFF_G + (size_t)ML * 1024 * 2;
constexpr size_t OFF_XC = OFF_Z + (size_t)ML * 1024 * 2;
constexpr size_t OFF_X1 = OFF_XC + (size_t)MP * 2048 * 2;
constexpr size_t OFF_U = OFF_X1;
constexpr size_t OFF_XR = OFF_X1 + (size_t)MP * 1024 * 2;
constexpr size_t OFF_OH = OFF_X1;
constexpr size_t OFF_OS = OFF_X1 + (size_t)2 * ML * 1024 * 2;
constexpr size_t OFF_H1A = OFF_X1 + (size_t)4 * ML * 1024 * 2;
constexpr size_t WS_END = OFF_H1A + (size_t)ML * 1024 * 4;
static_assert(WS_END <= 536870912ull, "workspace budget (4 x largest tensor)");
constexpr size_t OFF_A2 = OFF_Q;
constexpr size_t OFF_H1B = OFF_X1;
constexpr size_t OFF_ACT = OFF_Q;
constexpr size_t OFF_U2 = OFF_ACT + (size_t)2 * ML * DFF * 2;
static_assert(OFF_U2 + (size_t)2 * ML * 1024 * 2 <= OFF_X1, "FFN buffers must end before h1 of pass 1");
static_assert((size_t)ML * 2048 * 2 <= (size_t)MP * 1024 * 2 + (size_t)MP * 2048 * 2, "A2 overlay");
static_assert((size_t)MP * 1024 * 2 + (size_t)MP * 2048 * 2 <= (size_t)4 * ML * 1024 * 2, "U+XR in X1");

struct Params {
    const float *x, *c, *ctx, *c_ctx, *w_ada, *b_ada, *norm_mix, *w_in, *conv_w, *conv_b, *a_log, *dt_bias, *ssd_d, *ssd_norm,
                *lb_raw, *hgrn_norm, *w_out, *norm_ffn, *w_gate, *w_up, *w_down, *final_norm;
    float* out; unsigned char* ws;
};

__device__ __forceinline__ float bf2f(unsigned short b) { return __uint_as_float(((unsigned)b) << 16); }
__device__ __forceinline__ float bflo(unsigned w) { return __uint_as_float(w << 16); }
__device__ __forceinline__ float bfhi(unsigned w) { return __uint_as_float(w & 0xffff0000u); }
__device__ __forceinline__ float h_lo(unsigned w) { return (float)__builtin_bit_cast(f16, (unsigned short)(w & 0xffffu)); }
__device__ __forceinline__ float h_hi(unsigned w) { return (float)__builtin_bit_cast(f16, (unsigned short)(w >> 16)); }
__device__ __forceinline__ unsigned pk2(float lo, float hi) { return pg8::cvt_pk_bf16(lo, hi); }
__device__ __forceinline__ unsigned short f2bf(float f) { return (unsigned short)(pk2(f, 0.f) & 0xffffu); }
__device__ __forceinline__ float siluf(float v) { return v * __builtin_amdgcn_rcpf(1.0f + __expf(-v)); }
__device__ __forceinline__ float wave_sum(float v) {
#pragma unroll
    for (int o = 1; o < 64; o <<= 1) v += __shfl_xor(v, o);
    return v;
}

__device__ __forceinline__ void p0_transpose_item(const float* W, int K, int N, bf16_t* WT, int k0, int n0, int drow0, LAS float* scr, int lane) {
#pragma unroll 8
    for (int i = 0; i < 32; ++i) { const int kk = 2 * i + (lane >> 5); scr[kk * 33 + (lane & 31)] = W[(size_t)(k0 + kk) * N + n0 + (lane & 31)]; }
    asm volatile("s_waitcnt vmcnt(0) lgkmcnt(0)" ::: "memory");
    const int c = lane & 7;
#pragma unroll
    for (int j = 0; j < 4; ++j) { const int n = (lane >> 3) + 8 * j; const LAS float* s = scr + (8 * c) * 33 + n;
        u32x4 o; o.x = pk2(s[0 * 33], s[1 * 33]); o.y = pk2(s[2 * 33], s[3 * 33]); o.z = pk2(s[4 * 33], s[5 * 33]); o.w = pk2(s[6 * 33], s[7 * 33]);
        *(u32x4*)(WT + (size_t)(drow0 + n) * K + k0 + 8 * c) = o; }
    asm volatile("s_waitcnt lgkmcnt(0)" ::: "memory");
}

__device__ __forceinline__ void phase_prep(const Params& P, LAS unsigned char* lds) {
    const int tid = opaque_tid(), lane = tid & 63, wave = tid >> 6;
    unsigned char* ws = P.ws;
    float* mod = (float*)(ws + OFF_MOD);
    LAS float* cs = (LAS float*)(lds + 18432);
    if (blockIdx.x < 96) {
        for (int e = tid; e < 9 * 1024; e += NT) { const float cv = (e < 8192) ? P.c[e] : P.c_ctx[e - 8192]; cs[e] = siluf(cv); }
        __syncthreads();
    }
    for (int item = blockIdx.x; item < 96; item += gridDim.x) {
        const int col = item * 64 + lane;
        float acc[9];
#pragma unroll
        for (int r = 0; r < 9; ++r) acc[r] = 0.f;
#pragma unroll 4
        for (int kk = 0; kk < 128; ++kk) {
            const int k = wave * 128 + kk;
            const float wv = P.w_ada[(size_t)k * 6144 + col];
#pragma unroll
            for (int r = 0; r < 9; ++r) acc[r] += cs[r * 1024 + k] * wv;
        }
        LAS float* red = (LAS float*)lds;
#pragma unroll
        for (int r = 0; r < 9; ++r) red[(wave * 9 + r) * 64 + lane] = acc[r];
        __syncthreads();
        for (int e = tid; e < 9 * 64; e += NT) { const int r = e >> 6, l = e & 63; float s = 0.f;
#pragma unroll
            for (int w = 0; w < 8; ++w) s += red[(w * 9 + r) * 64 + l];
            mod[r * 6144 + item * 64 + l] = s + P.b_ada[item * 64 + l]; }
        __syncthreads();
    }
    float* lbv = (float*)(ws + OFF_LB);
    for (int j = blockIdx.x * NT + tid; j < 2048; j += gridDim.x * NT) { const float r0 = P.lb_raw[j], r1 = P.lb_raw[2048 + j]; lbv[j] = 1.0f / (1.0f + __expf(r1 - r0)); }
    { u32x4* z = (u32x4*)(ws + OFF_WIN + (size_t)DIN * D * 2); const int n16 = (NPAD - DIN) * D * 2 / 16;
      for (int j = blockIdx.x * NT + tid; j < n16; j += gridDim.x * NT) z[j] = (u32x4){0u, 0u, 0u, 0u}; }
    LAS float* scr = (LAS float*)(lds + 55296 + wave * 8704);
    bf16_t* WinT = (bf16_t*)(ws + OFF_WIN); bf16_t* WoutT = (bf16_t*)(ws + OFF_WOUT); bf16_t* WguT = (bf16_t*)(ws + OFF_WGU); bf16_t* WdT = (bf16_t*)(ws + OFF_WD);
    constexpr int I_IN = (D / 64) * (DIN / 32), I_OUT = (2048 / 64) * (D / 32), I_G = (D / 64) * (DFF / 32), I_D = (DFF / 64) * (D / 32);
    constexpr int NITEMS = I_IN + I_OUT + 2 * I_G + I_D;
    const int gw = blockIdx.x * 8 + wave, NGW = gridDim.x * 8;
    for (int it = gw; it < NITEMS; it += NGW) {
        int r = it;
        if (r < I_IN) { const int nblk = DIN / 32, kb = r / nblk, nb = r % nblk; p0_transpose_item(P.w_in, D, DIN, WinT, 64 * kb, 32 * nb, 32 * nb, scr, lane); continue; } r -= I_IN;
        if (r < I_OUT) { const int nblk = D / 32, kb = r / nblk, nb = r % nblk; p0_transpose_item(P.w_out, 2048, D, WoutT, 64 * kb, 32 * nb, 32 * nb, scr, lane); continue; } r -= I_OUT;
        if (r < I_G) { const int nblk = DFF / 32, kb = r / nblk, nb = r % nblk, n0 = 32 * nb; p0_transpose_item(P.w_gate, D, DFF, WguT, 64 * kb, n0, (n0 >> 7) * 256 + (n0 & 127), scr, lane); continue; } r -= I_G;
        if (r < I_G) { const int nblk = DFF / 32, kb = r / nblk, nb = r % nblk, n0 = 32 * nb; p0_transpose_item(P.w_up, D, DFF, WguT, 64 * kb, n0, (n0 >> 7) * 256 + 128 + (n0 & 127), scr, lane); continue; } r -= I_G;
        { const int nblk = D / 32, kb = r / nblk, nb = r % nblk; p0_transpose_item(P.w_down, DFF, D, WdT, 64 * kb, 32 * nb, 32 * nb, scr, lane); }
    }
}

template <int MODE>
__device__ __forceinline__ void phase_norm(const Params& P, int pass) {
    const int tid_ = opaque_tid(); const int lane = tid_ & 63, wave = tid_ >> 6;
    const float* mod = (const float*)(P.ws + OFF_MOD);
    const int nrows = MODE == 0 ? MP : 2 * ML;
    bf16_t* outp = (bf16_t*)(P.ws + (MODE == 0 ? OFF_U : OFF_U2));
    const float* nw = MODE == 0 ? P.norm_mix : P.norm_ffn;
    for (int r = blockIdx.x * 8 + wave; r < nrows; r += gridDim.x * 8) {
        const float* src; int mrow;
        if (MODE == 0) {
            if (r < ML) { src = P.x + ((size_t)pass * ML + r) * D; mrow = pass * BP + (r >> 12); }
            else { const int rc = r - ML; src = P.ctx + ((size_t)pass * MC + rc) * D; mrow = 8; }
        } else { src = (r < ML) ? (const float*)(P.ws + OFF_H1A) + (size_t)r * D : (const float*)(P.ws + OFF_H1B) + (size_t)(r - ML) * D; mrow = r >> 12; }
        const float* sh = mod + mrow * 6144 + (MODE == 0 ? 0 : 3072); const float* sc = sh + 1024;
        f32x4 v[4]; float ss = 0.f;
#pragma unroll
        for (int j = 0; j < 4; ++j) { v[j] = *(const f32x4*)(src + 256 * j + 4 * lane); ss += (v[j].x * v[j].x + v[j].y * v[j].y) + (v[j].z * v[j].z + v[j].w * v[j].w); }
        const float rstd = rsqrtf(wave_sum(ss) * (1.0f / D) + EPS);
#pragma unroll
        for (int j = 0; j < 4; ++j) { const int c0 = 256 * j + 4 * lane;
            const f32x4 w = *(const f32x4*)(nw + c0), s1 = *(const f32x4*)(sc + c0), s0 = *(const f32x4*)(sh + c0);
            const f32x4 o = (v[j] * rstd * w) * (1.0f + s1) + s0;
            u32x2 pk; pk.x = pk2(o.x, o.y); pk.y = pk2(o.z, o.w);
            *(u32x2*)(outp + (size_t)r * D + c0) = pk; }
    }
}

__device__ __forceinline__ void phase_final_norm(const Params& P, int pass) {
    const int tid_ = opaque_tid(); const int lane = tid_ & 63, wave = tid_ >> 6;
    for (int r = blockIdx.x * 8 + wave; r < 2 * ML; r += gridDim.x * 8) {
        float* row = P.out + (size_t)r * D;
        f32x4 v[4]; float ss = 0.f;
#pragma unroll
        for (int j = 0; j < 4; ++j) { v[j] = *(const f32x4*)(row + 256 * j + 4 * lane); ss += (v[j].x * v[j].x + v[j].y * v[j].y) + (v[j].z * v[j].z + v[j].w * v[j].w); }
        const float rstd = rsqrtf(wave_sum(ss) * (1.0f / D) + EPS);
#pragma unroll
        for (int j = 0; j < 4; ++j) { const int c0 = 256 * j + 4 * lane; const f32x4 w = *(const f32x4*)(P.final_norm + c0);
            *(f32x4*)(row + c0) = v[j] * rstd * w; }
    }
}

struct EpiIn {
    static constexpr bool PERM = true, AFTER_DRAIN = false;
    unsigned char* ws; const float* dt_bias;
    __device__ __forceinline__ void operator()(const f32x4 (&acc)[2][2][4][2], const Unit& u, int wr, int wc, int fr, int fq) const {
        const int pn = u.pn; const bool lat = u.pm < (ML / 256);
        int kind, ld, cofs; size_t off;
        float scale = 1.0f;
        if (pn < 4) { kind = lat ? 0 : 4; off = OFF_Q; ld = 1024; cofs = 0; scale = 0.08838834764831845f; }
        else if (pn < 12) { kind = 2; off = OFF_FR; ld = 2048; cofs = 1024; }
        else if (pn < 16) { kind = 1; off = OFF_V; ld = 1024; cofs = 3072; }
        else if (pn < 20) { kind = lat ? 1 : 4; off = OFF_G; ld = 1024; cofs = 4096; }
        else if (pn < 24) { kind = lat ? 1 : 4; off = OFF_Z; ld = 1024; cofs = 5120; }
        else if (pn < 32) { kind = 1; off = OFF_XR; ld = 2048; cofs = 6144; }
        else { kind = 3; off = OFF_DT; ld = 32; cofs = 8192; }
        if (kind == 4) return;
        const int row0 = u.pm * 256 + wr * 64 + fr;
        if (kind == 3) {
            if (wc != 0) return;
            float* DT = (float*)(ws + off);
            const f32x4 b0 = *(const f32x4*)(dt_bias + 8 * fq), b1 = *(const f32x4*)(dt_bias + 8 * fq + 4);
#pragma unroll
            for (int ai = 0; ai < 2; ++ai)
#pragma unroll
                for (int m = 0; m < 4; ++m) { const int row = row0 + ai * 128 + m * 16;
                    f32x4 v0 = acc[ai][0][m][0] + b0, v1 = acc[ai][0][m][1] + b1;
#pragma unroll
                    for (int j = 0; j < 4; ++j) { v0[j] = v0[j] > 20.f ? v0[j] : log1pf(__expf(v0[j])); v1[j] = v1[j] > 20.f ? v1[j] : log1pf(__expf(v1[j])); }
                    *(f32x4*)(DT + (size_t)row * 32 + 8 * fq) = v0; *(f32x4*)(DT + (size_t)row * 32 + 8 * fq + 4) = v1; }
            return;
        }
        unsigned short* O = (unsigned short*)(ws + off);
        const int col0 = pn * 256 - cofs + wc * 32 + 8 * fq;
#pragma unroll
        for (int ai = 0; ai < 2; ++ai)
#pragma unroll
            for (int m = 0; m < 4; ++m) { unsigned short* rowp = O + (size_t)(row0 + ai * 128 + m * 16) * ld + col0;
#pragma unroll
                for (int bj = 0; bj < 2; ++bj) { f32x4 v0 = acc[ai][bj][m][0], v1 = acc[ai][bj][m][1]; u32x4 w;
                    if (kind == 0) {
#pragma unroll
                        for (int j = 0; j < 4; ++j) { v0[j] = siluf(v0[j]) * scale; v1[j] = siluf(v1[j]) * scale; } }
                    if (kind == 2) {
                        typedef f16 h2 __attribute__((ext_vector_type(2)));
                        const float* lbp = (const float*)(ws + OFF_LB) + col0 + bj * 128;
                        const f32x4 l0 = *(const f32x4*)lbp, l1 = *(const f32x4*)(lbp + 4);
#pragma unroll
                        for (int j = 0; j < 4; ++j) { const float x0 = fminf(fmaxf(v0[j], -30.f), 30.f), x1 = fminf(fmaxf(v1[j], -30.f), 30.f);
                            v0[j] = (1.0f - l0[j]) * __builtin_amdgcn_rcpf(1.0f + __expf(x0)); v1[j] = (1.0f - l1[j]) * __builtin_amdgcn_rcpf(1.0f + __expf(x1)); }
                        h2 a = {(f16)v0[0], (f16)v0[1]}, b = {(f16)v0[2], (f16)v0[3]}, c = {(f16)v1[0], (f16)v1[1]}, d = {(f16)v1[2], (f16)v1[3]};
                        w.x = __builtin_bit_cast(unsigned, a); w.y = __builtin_bit_cast(unsigned, b); w.z = __builtin_bit_cast(unsigned, c); w.w = __builtin_bit_cast(unsigned, d);
                    } else { w.x = pk2(v0[0], v0[1]); w.y = pk2(v0[2], v0[3]); w.z = pk2(v1[0], v1[1]); w.w = pk2(v1[2], v1[3]); }
                    *(u32x4*)(rowp + bj * 128) = w; } }
    }
};
struct EpiOut {
    static constexpr bool PERM = false, AFTER_DRAIN = false;
    const float* x; const float* mod; float* H1; int pass;
    __device__ __forceinline__ void operator()(const f32x4 (&acc)[2][2][4][2], const Unit& u, int wr, int wc, int fr, int fq) const {
        const int row0 = u.pm * 256 + wr * 64 + fr, col0 = u.pn * 256 + wc * 32 + 4 * fq;
        const float* g1 = mod + (size_t)(pass * BP + (u.pm >> 4)) * 6144 + 2048;
        f32x4 gv[2][2];
#pragma unroll
        for (int bj = 0; bj < 2; ++bj)
#pragma unroll
            for (int n = 0; n < 2; ++n) gv[bj][n] = *(const f32x4*)(g1 + col0 + bj * 128 + n * 16);
#pragma unroll
        for (int ai = 0; ai < 2; ++ai)
#pragma unroll
            for (int m = 0; m < 4; ++m) { const int row = row0 + ai * 128 + m * 16; const float* xr = x + ((size_t)pass * ML + row) * D + col0; float* hr = H1 + (size_t)row * D + col0;
#pragma unroll
                for (int bj = 0; bj < 2; ++bj)
#pragma unroll
                    for (int n = 0; n < 2; ++n) *(f32x4*)(hr + bj * 128 + n * 16) = *(const f32x4*)(xr + bj * 128 + n * 16) + gv[bj][n] * acc[ai][bj][m][n]; }
    }
};
struct EpiGU {
    static constexpr bool PERM = true, AFTER_DRAIN = false;
    bf16_t* ACT;
    __device__ __forceinline__ void operator()(const f32x4 (&acc)[2][2][4][2], const Unit& u, int wr, int wc, int fr, int fq) const {
        const int row0 = u.pm * 256 + wr * 64 + fr, col0 = u.pn * 128 + wc * 32 + 8 * fq;
#pragma unroll
        for (int ai = 0; ai < 2; ++ai)
#pragma unroll
            for (int m = 0; m < 4; ++m) { bf16_t* rowp = ACT + (size_t)(row0 + ai * 128 + m * 16) * DFF + col0;
                f32x4 g0 = acc[ai][0][m][0], g1 = acc[ai][0][m][1]; const f32x4 u0 = acc[ai][1][m][0], u1 = acc[ai][1][m][1];
#pragma unroll
                for (int j = 0; j < 4; ++j) { g0[j] = siluf(g0[j]) * u0[j]; g1[j] = siluf(g1[j]) * u1[j]; }
                u32x4 w; w.x = pk2(g0[0], g0[1]); w.y = pk2(g0[2], g0[3]); w.z = pk2(g1[0], g1[1]); w.w = pk2(g1[2], g1[3]);
                *(u32x4*)rowp = w; }
    }
};
struct EpiDown {
    static constexpr bool PERM = false, AFTER_DRAIN = false;
    const float* H1a; const float* H1b; const float* mod; float* out;
    __device__ __forceinline__ void operator()(const f32x4 (&acc)[2][2][4][2], const Unit& u, int wr, int wc, int fr, int fq) const {
        const int row0 = u.pm * 256 + wr * 64 + fr, col0 = u.pn * 256 + wc * 32 + 4 * fq;
        const float* g2 = mod + (size_t)(u.pm >> 4) * 6144 + 5120;
        const float* H1 = (u.pm < ML / 256) ? H1a : H1b - (size_t)ML * D;
        f32x4 gv[2][2];
#pragma unroll
        for (int bj = 0; bj < 2; ++bj)
#pragma unroll
            for (int n = 0; n < 2; ++n) gv[bj][n] = *(const f32x4*)(g2 + col0 + bj * 128 + n * 16);
#pragma unroll
        for (int ai = 0; ai < 2; ++ai)
#pragma unroll
            for (int m = 0; m < 4; ++m) { const int row = row0 + ai * 128 + m * 16; const float* hr = H1 + (size_t)row * D + col0; float* orow = out + (size_t)row * D + col0;
#pragma unroll
                for (int bj = 0; bj < 2; ++bj)
#pragma unroll
                    for (int n = 0; n < 2; ++n) *(f32x4*)(orow + bj * 128 + n * 16) = *(const f32x4*)(hr + bj * 128 + n * 16) + gv[bj][n] * acc[ai][bj][m][n]; }
    }
};

__device__ __forceinline__ void phase_conv(const Params& P) {
    const bf16_t* XR = (const bf16_t*)(P.ws + OFF_XR); bf16_t* XC = (bf16_t*)(P.ws + OFF_XC);
    constexpr int SEGL = 17, NSEG = MP / SEGL, NITEM = NSEG * 256;
    static_assert(NSEG * SEGL == MP, "segment length must divide the row count");
    for (int it = blockIdx.x * NT + opaque_tid(); it < NITEM; it += gridDim.x * NT) {
        const int seg = it >> 8, cg8 = (it & 255) * 8, r0 = seg * SEGL;
        float w[5][8], bias[8];
#pragma unroll
        for (int k = 0; k < 5; ++k) { const f32x4 a = *(const f32x4*)(P.conv_w + k * 2048 + cg8), b = *(const f32x4*)(P.conv_w + k * 2048 + cg8 + 4);
            w[k][0] = a.x; w[k][1] = a.y; w[k][2] = a.z; w[k][3] = a.w; w[k][4] = b.x; w[k][5] = b.y; w[k][6] = b.z; w[k][7] = b.w; }
        { const f32x4 a = *(const f32x4*)(P.conv_b + cg8), b = *(const f32x4*)(P.conv_b + cg8 + 4);
          bias[0] = a.x; bias[1] = a.y; bias[2] = a.z; bias[3] = a.w; bias[4] = b.x; bias[5] = b.y; bias[6] = b.z; bias[7] = b.w; }
        u32x4 win[SEGL + 4]; int lid[SEGL + 4];
#pragma unroll
        for (int k = 0; k < SEGL + 4; ++k) { const int r = r0 - 2 + k; const bool ok = (r >= 0 && r < MP);
            lid[k] = !ok ? -1 : (r < ML ? (r >> 6) : 4096 + ((r - ML) >> 8));
            win[k] = ok ? *(const u32x4*)(XR + (size_t)r * 2048 + cg8) : (u32x4){0u, 0u, 0u, 0u}; }
#pragma unroll
        for (int t = 0; t < SEGL; ++t) {
            float o[8];
#pragma unroll
            for (int e = 0; e < 8; ++e) o[e] = bias[e];
#pragma unroll
            for (int k = 0; k < 5; ++k) { const float m = (lid[t + k] == lid[t + 2]) ? 1.0f : 0.0f; const u32x4 x = win[t + k];
                o[0] += m * w[k][0] * bflo(x.x); o[1] += m * w[k][1] * bfhi(x.x); o[2] += m * w[k][2] * bflo(x.y); o[3] += m * w[k][3] * bfhi(x.y);
                o[4] += m * w[k][4] * bflo(x.z); o[5] += m * w[k][5] * bfhi(x.z); o[6] += m * w[k][6] * bflo(x.w); o[7] += m * w[k][7] * bfhi(x.w); }
            u32x4 pk; pk.x = pk2(siluf(o[0]), siluf(o[1])); pk.y = pk2(siluf(o[2]), siluf(o[3])); pk.z = pk2(siluf(o[4]), siluf(o[5])); pk.w = pk2(siluf(o[6]), siluf(o[7]));
            *(u32x4*)(XC + (size_t)(r0 + t) * 2048 + cg8) = pk;
        }
    }
}

constexpr int L_AQ = 0  , L_AK = 34816  , L_KET = 69632  , L_VVT = 106496  , L_SC = 124928, L_ST = 134144, L_SEG = 151552, L_DEC = 155648  , L_CUM = 156672  , L_DTV = 157184  , L_EE = 157696  , L_SCAN_END = 158208;
constexpr int SZ_AQ = 17408;
constexpr int SZ_KET = 18432, SZ_VVT = 9216, SZ_DEC = 512, SZ_CUM = 256;
constexpr int PA = 272, PB = 144;

#define MFMA16(a, b, c) __builtin_amdgcn_mfma_f32_16x16x32_bf16((a), (b), (c), 0, 0, 0)

#define SCAN_BAR() do { asm volatile("s_waitcnt lgkmcnt(0)" ::: "memory"); __builtin_amdgcn_s_barrier(); asm volatile("" ::: "memory"); } while (0)
template <bool SSD>
__device__ __forceinline__ void scan_item(const Params& P, LAS unsigned char* lds, int pass, int it) {
    const int tid = opaque_tid(), lane = tid & 63, wave = __builtin_amdgcn_readfirstlane(tid >> 6);
    const int l15 = lane & 15, lq = lane >> 4;
    unsigned char* ws = P.ws;
    int bl, dir, head, vh = 0;
    if (!SSD) { bl = it >> 5; dir = (it >> 4) & 1; head = (it >> 1) & 7; vh = it & 1; }
    else { bl = it >> 5; dir = (it >> 4) & 1; head = it & 15; }
    auto chunk_base = [&](int step) -> int {
        if (step < 4) { const int c = dir ? 3 - step : step; return ML + bl * CTX + c * 64; }
        const int c = dir ? 63 - (step - 4) : step - 4; return bl * SEQ + c * 64; };

    if (wave >= 4) {
        const int ptid = tid - 256, pw = wave - 4;
        const int f4 = ptid & 31, seg = ptid >> 5;
        const int v4 = ptid & 15, tq = ptid >> 4;
        const unsigned short *srcA, *srcB, *srcV; int ldA, ldB, ldV;
        if (!SSD) { srcA = (const unsigned short*)(ws + OFF_Q) + head * 128 + f4 * 4; ldA = 1024;
                    srcB = (const unsigned short*)(ws + OFF_FR) + dir * 1024 + head * 128 + f4 * 4; ldB = 2048;
                    srcV = (const unsigned short*)(ws + OFF_V) + head * 128 + vh * 64 + v4 * 4; ldV = 1024; }
        else { const int g = head >> 2;
               srcA = (const unsigned short*)(ws + OFF_XC) + 1536 + g * 128 + f4 * 4; ldA = 2048;
               srcB = (const unsigned short*)(ws + OFF_XC) + 1024 + g * 128 + f4 * 4; ldB = 2048;
               srcV = (const unsigned short*)(ws + OFF_XC) + head * 64 + v4 * 4; ldV = 2048; }
        const float* DT = (const float*)(ws + OFF_DT) + dir * 16 + head;
        float a_neg = 0.f;
        if (SSD) a_neg = -__expf(P.a_log[dir * 16 + head]);
        u32x2 ra[8], rb[8], rv[4]; float rdt = 0.f;
        auto load_ab = [&](int step) { const int base = chunk_base(step);
#pragma unroll
            for (int ii = 0; ii < 8; ++ii) { const int i = seg * 8 + ii; const int row = base + (dir ? 63 - i : i);
                ra[ii] = *(const u32x2*)(srcA + (size_t)row * ldA); rb[ii] = *(const u32x2*)(srcB + (size_t)row * ldB); } };
        auto load_v = [&](int step) { const int base = chunk_base(step);
#pragma unroll
            for (int ii = 0; ii < 4; ++ii) { const int i = tq * 4 + ii; const int row = base + (dir ? 63 - i : i); rv[ii] = *(const u32x2*)(srcV + (size_t)row * ldV); } };
        auto load_dt = [&](int step) { if (pw == 0) { const int row = chunk_base(step) + (dir ? 63 - lane : lane); rdt = DT[(size_t)row * 32]; } };
        float cumv[8][4], kk[8][4], qq[8][4];
        load_ab(0); load_v(0); if (SSD) load_dt(0);
        for (int n = -1; n < 68; ++n) {
            if (n == 67) { SCAN_BAR(); SCAN_BAR(); continue; }
            const int q = (n + 1) & 1;
            LAS unsigned char* KETq = lds + L_KET + q * SZ_KET; LAS unsigned char* VVTq = lds + L_VVT + q * SZ_VVT;
            if (!SSD) {
                float run[4] = {1.f, 1.f, 1.f, 1.f};
#pragma unroll
                for (int ii = 0; ii < 8; ++ii) {
                    kk[ii][0] = h_lo(rb[ii].x); kk[ii][1] = h_hi(rb[ii].x); kk[ii][2] = h_lo(rb[ii].y); kk[ii][3] = h_hi(rb[ii].y);
                    qq[ii][0] = bflo(ra[ii].x); qq[ii][1] = bfhi(ra[ii].x); qq[ii][2] = bflo(ra[ii].y); qq[ii][3] = bfhi(ra[ii].y);
#pragma unroll
                    for (int c = 0; c < 4; ++c) { run[c] *= 1.0f - kk[ii][c]; cumv[ii][c] = run[c]; }
                }
                *(LAS f32x4*)(lds + L_SEG + (seg * 128 + f4 * 4) * 4) = (f32x4){run[0], run[1], run[2], run[3]};
            } else {
                if (pw == 0) {
                    float c = rdt * a_neg;
#pragma unroll
                    for (int o = 1; o < 64; o <<= 1) { const float t = __shfl_up(c, o); if (lane >= o) c += t; }
                    const float tot = __shfl(c, 63);
                    *(LAS float*)(lds + L_CUM + q * SZ_CUM + lane * 4) = c; *(LAS float*)(lds + L_DTV + q * SZ_CUM + lane * 4) = rdt;
                    *(LAS float*)(lds + L_EE + q * SZ_CUM + lane * 4) = __expf(tot - c);
                    if (lane == 0) *(LAS float*)(lds + L_SEG) = __expf(tot);
                    if (n + 2 < 68) load_dt(n + 2);
                }
            }
            SCAN_BAR();
            if (!SSD) {
#pragma unroll
                for (int c = 0; c < 4; ++c) {
                    const unsigned w0 = (c < 2) ? rv[0].x : rv[0].y, w1 = (c < 2) ? rv[1].x : rv[1].y, w2 = (c < 2) ? rv[2].x : rv[2].y, w3 = (c < 2) ? rv[3].x : rv[3].y;
                    const unsigned sh = (c & 1) * 16;
                    u32x2 o; o.x = ((w0 >> sh) & 0xffffu) | (((w1 >> sh) & 0xffffu) << 16); o.y = ((w2 >> sh) & 0xffffu) | (((w3 >> sh) & 0xffffu) << 16);
                    *(LAS u32x2*)(VVTq + (v4 * 4 + c) * PB + tq * 8) = o; }
                if (n + 2 < 68) { load_ab(n + 2); load_v(n + 2); }
                float offs[4] = {1.f, 1.f, 1.f, 1.f}, tot[4] = {1.f, 1.f, 1.f, 1.f};
#pragma unroll
                for (int s = 0; s < 8; ++s) { const f32x4 t = *(const LAS f32x4*)(lds + L_SEG + (s * 128 + f4 * 4) * 4);
#pragma unroll
                    for (int c = 0; c < 4; ++c) { tot[c] *= t[c]; if (s < seg) offs[c] *= t[c]; } }
                float ke[8][4], inv[4];
#pragma unroll
                for (int c = 0; c < 4; ++c) inv[c] = __builtin_amdgcn_rcpf(offs[c] * cumv[7][c]);
#pragma unroll
                for (int ii = 7; ii >= 0; --ii) { const int i = seg * 8 + ii; float aq[4], ak[4];
#pragma unroll
                    for (int c = 0; c < 4; ++c) { const float eq = offs[c] * cumv[ii][c]; const float ki = kk[ii][c] * inv[c];
                        aq[c] = qq[ii][c] * eq; ak[c] = ki; ke[ii][c] = ki * tot[c]; inv[c] *= 1.0f - kk[ii][c]; }
                    *(LAS u32x2*)(lds + L_AQ + q * SZ_AQ + i * PA + f4 * 8) = (u32x2){pk2(aq[0], aq[1]), pk2(aq[2], aq[3])};
                    *(LAS u32x2*)(lds + L_AK + q * SZ_AQ + i * PA + f4 * 8) = (u32x2){pk2(ak[0], ak[1]), pk2(ak[2], ak[3])}; }
#pragma unroll
                for (int c = 0; c < 4; ++c)
                    *(LAS u32x4*)(KETq + (f4 * 4 + c) * PB + seg * 16) = (u32x4){pk2(ke[0][c], ke[1][c]), pk2(ke[2][c], ke[3][c]), pk2(ke[4][c], ke[5][c]), pk2(ke[6][c], ke[7][c])};
                if (seg == 0) *(LAS f32x4*)(lds + L_DEC + q * SZ_DEC + f4 * 16) = (f32x4){tot[0], tot[1], tot[2], tot[3]};
            } else {
                const LAS float* EE = (const LAS float*)(lds + L_EE + q * SZ_CUM); const LAS float* DTV = (const LAS float*)(lds + L_DTV + q * SZ_CUM);
                if (ptid == 0) *(LAS float*)(lds + L_DEC + q * SZ_DEC) = *(const LAS float*)(lds + L_SEG);
                float ke[8][4];
#pragma unroll
                for (int ii = 0; ii < 8; ++ii) { const int i = seg * 8 + ii; const float ee = EE[i];
                    *(LAS u32x2*)(lds + L_AQ + q * SZ_AQ + i * PA + f4 * 8) = ra[ii];
                    *(LAS u32x2*)(lds + L_AK + q * SZ_AQ + i * PA + f4 * 8) = rb[ii];
                    ke[ii][0] = bflo(rb[ii].x) * ee; ke[ii][1] = bfhi(rb[ii].x) * ee; ke[ii][2] = bflo(rb[ii].y) * ee; ke[ii][3] = bfhi(rb[ii].y) * ee; }
#pragma unroll
                for (int c = 0; c < 4; ++c)
                    *(LAS u32x4*)(KETq + (f4 * 4 + c) * PB + seg * 16) = (u32x4){pk2(ke[0][c], ke[1][c]), pk2(ke[2][c], ke[3][c]), pk2(ke[4][c], ke[5][c]), pk2(ke[6][c], ke[7][c])};
                float xv[4][4];
#pragma unroll
                for (int ii = 0; ii < 4; ++ii) { const float d = DTV[tq * 4 + ii];
                    xv[ii][0] = bflo(rv[ii].x) * d; xv[ii][1] = bfhi(rv[ii].x) * d; xv[ii][2] = bflo(rv[ii].y) * d; xv[ii][3] = bfhi(rv[ii].y) * d; }
#pragma unroll
                for (int c = 0; c < 4; ++c) *(LAS u32x2*)(VVTq + (v4 * 4 + c) * PB + tq * 8) = (u32x2){pk2(xv[0][c], xv[1][c]), pk2(xv[2][c], xv[3][c])};
                if (n + 2 < 68) { load_ab(n + 2); load_v(n + 2); }
            }
            SCAN_BAR();
        }
    } else {
        unsigned short* Oout = SSD ? (unsigned short*)(ws + OFF_OS) + (size_t)dir * ML * 1024 + head * 64
                                   : (unsigned short*)(ws + OFF_OH) + (size_t)dir * ML * 1024 + head * 128 + vh * 64;
        f32x4 sacc[2][4];
#pragma unroll
        for (int a = 0; a < 2; ++a)
#pragma unroll
            for (int t = 0; t < 4; ++t) sacc[a][t] = (f32x4){0.f, 0.f, 0.f, 0.f};
        const int ti = wave;
        bf16x8 vv[4][2];
        for (int n = -1; n < 68; ++n) {
            if (n < 0) { SCAN_BAR(); SCAN_BAR(); continue; }
            const int p = n & 1;
            if (n >= 1) {
                const int pp = p ^ 1;
                const LAS unsigned char* KETp = lds + L_KET + pp * SZ_KET;
#pragma unroll
                for (int a = 0; a < 2; ++a) { const int f0 = wave * 32 + a * 16;
                    f32x4 dv;
                    if (!SSD) dv = *(const LAS f32x4*)(lds + L_DEC + pp * SZ_DEC + (f0 + lq * 4) * 4);
                    else { const float d = *(const LAS float*)(lds + L_DEC + pp * SZ_DEC); dv = (f32x4){d, d, d, d}; }
                    bf16x8 ak[2];
#pragma unroll
                    for (int k = 0; k < 2; ++k) ak[k] = *(const LAS bf16x8*)(KETp + (f0 + l15) * PB + k * 64 + lq * 16);
#pragma unroll
                    for (int tv = 0; tv < 4; ++tv) { f32x4 s = sacc[a][tv] * dv;
#pragma unroll
                        for (int k = 0; k < 2; ++k) s = MFMA16(ak[k], vv[tv][k], s);
                        sacc[a][tv] = s;
                        u32x2 w; w.x = pk2(s[0], s[1]); w.y = pk2(s[2], s[3]);
                        *(LAS u32x2*)(lds + L_ST + (tv * 16 + l15) * PA + (f0 + lq * 4) * 2) = w; } }
            }
            SCAN_BAR();
            const bool isctx = n < 4;
            const int base = chunk_base(n);
            const LAS float* CUM = (const LAS float*)(lds + L_CUM + p * SZ_CUM);
            const LAS unsigned char* VVTp = lds + L_VVT + p * SZ_VVT;
            const LAS unsigned char* AQp = lds + L_AQ + p * SZ_AQ; const LAS unsigned char* AKp = lds + L_AK + p * SZ_AQ;
#pragma unroll
            for (int tv = 0; tv < 4; ++tv)
#pragma unroll
                for (int k = 0; k < 2; ++k) vv[tv][k] = *(const LAS bf16x8*)(VVTp + (tv * 16 + l15) * PB + k * 64 + lq * 16);
            if (!isctx) {
                bf16x8 bq[4];
#pragma unroll
                for (int k = 0; k < 4; ++k) bq[k] = *(const LAS bf16x8*)(AQp + (ti * 16 + l15) * PA + k * 64 + lq * 16);
                const int i = ti * 16 + l15;
                float ci = 0.f; if (SSD) ci = CUM[i];
#pragma unroll
                for (int tj = 0; tj < 4; ++tj) { const int j0 = tj * 16 + lq * 4;
                    u32x2 w = {0u, 0u};
                    if (tj <= ti) {
                        f32x4 a = {0.f, 0.f, 0.f, 0.f};
#pragma unroll
                        for (int k = 0; k < 4; ++k) { const bf16x8 ak = *(const LAS bf16x8*)(AKp + (tj * 16 + l15) * PA + k * 64 + lq * 16); a = MFMA16(ak, bq[k], a); }
#pragma unroll
                        for (int jj = 0; jj < 4; ++jj) { const int j = j0 + jj; float v = a[jj];
                            if (SSD) v *= __expf(fminf(ci - CUM[j], 0.f));
                            a[jj] = (j <= i) ? v : 0.f; }
                        w.x = pk2(a[0], a[1]); w.y = pk2(a[2], a[3]);
                    }
                    *(LAS u32x2*)(lds + L_SC + i * PB + j0 * 2) = w; }
                asm volatile("" ::: "memory"); __builtin_amdgcn_wave_barrier(); asm volatile("" ::: "memory");
                bf16x8 bs[2];
#pragma unroll
                for (int k = 0; k < 2; ++k) bs[k] = *(const LAS bf16x8*)(lds + L_SC + (ti * 16 + l15) * PB + k * 64 + lq * 16);
                const int row = base + (dir ? 63 - i : i);
                float rs = 1.0f; if (SSD) rs = __expf(ci);
#pragma unroll
                for (int tv = 0; tv < 4; ++tv) {
                    f32x4 a1 = {0.f, 0.f, 0.f, 0.f}, a2 = {0.f, 0.f, 0.f, 0.f};
#pragma unroll
                    for (int k = 0; k < 2; ++k) a1 = MFMA16(vv[tv][k], bs[k], a1);
#pragma unroll
                    for (int k = 0; k < 4; ++k) { const bf16x8 as = *(const LAS bf16x8*)(lds + L_ST + (tv * 16 + l15) * PA + k * 64 + lq * 16); a2 = MFMA16(as, bq[k], a2); }
                    const f32x4 o = a1 + a2 * rs;
                    u32x2 w; w.x = pk2(o[0], o[1]); w.y = pk2(o[2], o[3]);
                    *(u32x2*)(Oout + (size_t)row * 1024 + tv * 16 + lq * 4) = w; }
            }
            SCAN_BAR();
        }
    }
    __syncthreads();
}

__device__ __forceinline__ void phase_scan(const Params& P, LAS unsigned char* lds, int pass) {
    for (int it = blockIdx.x; it < 256; it += gridDim.x) {
        if (it < 128) scan_item<false>(P, lds, pass, it); else scan_item<true>(P, lds, pass, it - 128);
    }
}

__device__ __forceinline__ void unpack8(const u32x4 w, float (&o)[8]) { o[0] = bflo(w.x); o[1] = bfhi(w.x); o[2] = bflo(w.y); o[3] = bfhi(w.y); o[4] = bflo(w.z); o[5] = bfhi(w.z); o[6] = bflo(w.w); o[7] = bfhi(w.w); }
__device__ __forceinline__ void phase_readout(const Params& P) {
    const int tid_ = opaque_tid(); const int lane = tid_ & 63, wave = tid_ >> 6;
    unsigned char* ws = P.ws;
    const bf16_t* OH = (const bf16_t*)(ws + OFF_OH); const bf16_t* OS = (const bf16_t*)(ws + OFF_OS);
    const bf16_t* G = (const bf16_t*)(ws + OFF_G); const bf16_t* Z = (const bf16_t*)(ws + OFF_Z); const bf16_t* XC = (const bf16_t*)(ws + OFF_XC);
    bf16_t* A2 = (bf16_t*)(ws + OFF_A2);
    const int c0 = lane * 16;
    float hw[16], sw[16];
#pragma unroll
    for (int e = 0; e < 16; ++e) { hw[e] = P.hgrn_norm[(c0 + e) & 127]; sw[e] = P.ssd_norm[c0 + e]; }
    const float dsk = P.ssd_d[lane >> 2];
    for (int r = blockIdx.x * 8 + wave; r < ML; r += gridDim.x * 8) {
        float o[16], t[8];
        { const u32x4* p0 = (const u32x4*)(OH + (size_t)r * 1024 + c0); const u32x4* p1 = (const u32x4*)(OH + ((size_t)ML + r) * 1024 + c0); const u32x4* pg = (const u32x4*)(G + (size_t)r * 1024 + c0);
          const u32x4 a0 = p0[0], a1 = p0[1], b0 = p1[0], b1 = p1[1], g0 = pg[0], g1 = pg[1];
          unpack8(a0, t);
#pragma unroll
          for (int e = 0; e < 8; ++e) o[e] = t[e];
          unpack8(a1, t);
#pragma unroll
          for (int e = 0; e < 8; ++e) o[8 + e] = t[e];
          unpack8(b0, t);
#pragma unroll
          for (int e = 0; e < 8; ++e) o[e] += t[e];
          unpack8(b1, t);
#pragma unroll
          for (int e = 0; e < 8; ++e) o[8 + e] += t[e];
          float ss = 0.f;
#pragma unroll
          for (int e = 0; e < 16; ++e) ss += o[e] * o[e];
          ss += __shfl_xor(ss, 1); ss += __shfl_xor(ss, 2); ss += __shfl_xor(ss, 4);
          const float rstd = rsqrtf(ss * (1.0f / 128.0f) + EPS);
          float gg[16]; unpack8(g0, t);
#pragma unroll
          for (int e = 0; e < 8; ++e) gg[e] = siluf(t[e]);
          unpack8(g1, t);
#pragma unroll
          for (int e = 0; e < 8; ++e) gg[8 + e] = siluf(t[e]);
#pragma unroll
          for (int e = 0; e < 16; ++e) o[e] = o[e] * rstd * hw[e] * gg[e];
          u32x4 w0, w1; w0.x = pk2(o[0], o[1]); w0.y = pk2(o[2], o[3]); w0.z = pk2(o[4], o[5]); w0.w = pk2(o[6], o[7]);
          w1.x = pk2(o[8], o[9]); w1.y = pk2(o[10], o[11]); w1.z = pk2(o[12], o[13]); w1.w = pk2(o[14], o[15]);
          u32x4* po = (u32x4*)(A2 + (size_t)r * 2048 + c0); po[0] = w0; po[1] = w1; }
        { const u32x4* p0 = (const u32x4*)(OS + (size_t)r * 1024 + c0); const u32x4* p1 = (const u32x4*)(OS + ((size_t)ML + r) * 1024 + c0);
          const u32x4* pz = (const u32x4*)(Z + (size_t)r * 1024 + c0); const u32x4* px = (const u32x4*)(XC + (size_t)r * 2048 + c0);
          const u32x4 a0 = p0[0], a1 = p0[1], b0 = p1[0], b1 = p1[1], z0 = pz[0], z1 = pz[1], x0 = px[0], x1 = px[1];
          unpack8(a0, t);
#pragma unroll
          for (int e = 0; e < 8; ++e) o[e] = t[e];
          unpack8(a1, t);
#pragma unroll
          for (int e = 0; e < 8; ++e) o[8 + e] = t[e];
          unpack8(b0, t);
#pragma unroll
          for (int e = 0; e < 8; ++e) o[e] += t[e];
          unpack8(b1, t);
#pragma unroll
          for (int e = 0; e < 8; ++e) o[8 + e] += t[e];
          unpack8(x0, t);
#pragma unroll
          for (int e = 0; e < 8; ++e) o[e] += dsk * t[e];
          unpack8(x1, t);
#pragma unroll
          for (int e = 0; e < 8; ++e) o[8 + e] += dsk * t[e];
          unpack8(z0, t);
#pragma unroll
          for (int e = 0; e < 8; ++e) o[e] *= siluf(t[e]);
          unpack8(z1, t);
#pragma unroll
          for (int e = 0; e < 8; ++e) o[8 + e] *= siluf(t[e]);
          float ss = 0.f;
#pragma unroll
          for (int e = 0; e < 16; ++e) ss += o[e] * o[e];
          ss += __shfl_xor(ss, 1); ss += __shfl_xor(ss, 2); ss += __shfl_xor(ss, 4); ss += __shfl_xor(ss, 8);
          const float rstd = rsqrtf(ss * (1.0f / 256.0f) + EPS);
#pragma unroll
          for (int e = 0; e < 16; ++e) o[e] = o[e] * rstd * sw[e];
          u32x4 w0, w1; w0.x = pk2(o[0], o[1]); w0.y = pk2(o[2], o[3]); w0.z = pk2(o[4], o[5]); w0.w = pk2(o[6], o[7]);
          w1.x = pk2(o[8], o[9]); w1.y = pk2(o[10], o[11]); w1.z = pk2(o[12], o[13]); w1.w = pk2(o[14], o[15]);
          u32x4* po = (u32x4*)(A2 + (size_t)r * 2048 + 1024 + c0); po[0] = w0; po[1] = w1; }
    }
}

__device__ __forceinline__ void grid_barrier(unsigned* ctr, unsigned target) {
    __builtin_amdgcn_fence(__ATOMIC_RELEASE, "agent");
    __syncthreads();
    if (threadIdx.x == 0) {
        __hip_atomic_fetch_add(ctr, 1u, __ATOMIC_RELAXED, __HIP_MEMORY_SCOPE_AGENT);
        while (__hip_atomic_load(ctr, __ATOMIC_RELAXED, __HIP_MEMORY_SCOPE_AGENT) < target) __builtin_amdgcn_s_sleep(2);
    }
    __syncthreads();
    __builtin_amdgcn_fence(__ATOMIC_ACQUIRE, "agent");
}
#define XB_TMO      128
#define XB_XCNT(j)  (256  + 64 * (j))
#define XB_XSUB(j)  (1280 + 64 * (j))
#define XB_XGEN(j)  (2304 + 64 * (j))
#define XB_TOP      3328
#define XB_TOPGEN   3392
#define XCD_BAR_WORDS 3456
#define XB_SPIN_CAP (1u << 22)

__device__ __forceinline__ unsigned xb_ld(unsigned* p)              { return __hip_atomic_load(p, __ATOMIC_RELAXED, __HIP_MEMORY_SCOPE_AGENT); }
__device__ __forceinline__ unsigned xb_add(unsigned* p, unsigned v) { return __hip_atomic_fetch_add(p, v, __ATOMIC_RELAXED, __HIP_MEMORY_SCOPE_AGENT); }
__device__ __forceinline__ unsigned xb_xcc_id() { return (unsigned)__builtin_amdgcn_s_getreg((3 << 11) | 20) & 0xFu; }
#define XB_SPIN(cond, bar) do { unsigned _sp = 0; while (cond) { __builtin_amdgcn_s_sleep(1); \
    if ((++_sp & 255u) == 0u) { if (xb_ld(&(bar)[XB_TMO])) break; if (_sp > XB_SPIN_CAP) { atomicAdd(&(bar)[XB_TMO], 1u); break; } } } } while (0)

struct XcdBarrier {
    unsigned* bar; unsigned x;
    volatile LAS unsigned* st;
};

__device__ __forceinline__ XcdBarrier xcd_barrier_post(unsigned* bar, volatile LAS unsigned* st) {
    XcdBarrier b; b.bar = bar; b.x = xb_xcc_id(); b.st = st;
    if (threadIdx.x == 0) (void)xb_add(&bar[XB_XCNT(b.x)], 1u);
    return b;
}
__device__ __forceinline__ void xcd_barrier_complete(unsigned* bar, unsigned x, unsigned& nloc, unsigned& nx) {
    const unsigned G = gridDim.x * gridDim.y * gridDim.z;
    unsigned sum, cnt, mine, sp = 0u;
    for (;;) {
        sum = 0u; cnt = 0u; mine = 0u;
#pragma unroll
        for (unsigned j = 0; j < 16; ++j) { const unsigned c = xb_ld(&bar[XB_XCNT(j)]); sum += c; cnt += (c > 0u) ? 1u : 0u; mine = (j == x) ? c : mine; }
        if (sum == G) break;
        __builtin_amdgcn_s_sleep(1);
        if ((++sp & 255u) == 0u) { if (xb_ld(&bar[XB_TMO])) break; if (sp > XB_SPIN_CAP) { atomicAdd(&bar[XB_TMO], 1u); break; } }
    }
    nloc = mine > 0u ? mine : 1u; nx = cnt > 0u ? cnt : 1u;
}

__device__ __forceinline__ void xcd_barrier(const XcdBarrier& b) {
    asm volatile("s_waitcnt vmcnt(0)" ::: "memory");
    __syncthreads();
    if (threadIdx.x == 0) {
        unsigned* bar = b.bar;
        __builtin_amdgcn_s_waitcnt(0);
        unsigned nloc = b.st[0], nx = b.st[1];
        if (nloc == 0u) { xcd_barrier_complete(bar, b.x, nloc, nx); b.st[0] = nloc; b.st[1] = nx; }
        const unsigned old = xb_add(&bar[XB_XSUB(b.x)], 1u);
        const unsigned gen = old / nloc;
        if (old + 1u == (gen + 1u) * nloc) {
            __builtin_amdgcn_fence(__ATOMIC_RELEASE, "agent");
            asm volatile("s_waitcnt vmcnt(0)" ::: "memory");
            const unsigned og = xb_add(&bar[XB_TOP], 1u);
            const unsigned tg = og / nx;
            if (og + 1u == (tg + 1u) * nx) xb_add(&bar[XB_TOPGEN], 1u);
            else XB_SPIN(xb_ld(&bar[XB_TOPGEN]) == tg, bar);
            __builtin_amdgcn_fence(__ATOMIC_ACQUIRE, "agent");
            xb_add(&bar[XB_XGEN(b.x)], 1u);
            asm volatile("s_waitcnt vmcnt(0)" ::: "memory");
        } else {
            XB_SPIN(xb_ld(&bar[XB_XGEN(b.x)]) == gen, bar);
            __builtin_amdgcn_fence(__ATOMIC_ACQUIRE, "agent");
            asm volatile("s_waitcnt vmcnt(0)" ::: "memory");
        }
    }
    __syncthreads();
}

#ifndef MK_PH_LO
#define MK_PH_LO 0
#endif
__global__ void __launch_bounds__(NT, 2) fwd_megakernel(Params P, int ph_lo, int ph_hi) {
    extern __shared__ __attribute__((aligned(16))) unsigned char lds_raw[];
    LAS unsigned char* lds = (LAS unsigned char*)lds_raw;
    cg::grid_group grid = cg::this_grid();
    unsigned char* ws = P.ws;
    const float* mod = (const float*)(ws + OFF_MOD);
    int ph = 0; unsigned nbar = 0; unsigned* barw = (unsigned*)(ws + OFF_BAR);
#if !defined(MK_OWN_BARRIER)
    if (threadIdx.x < 4) ((LAS unsigned*)(lds + LDS_XB))[threadIdx.x] = 0u;
    __syncthreads();
    XcdBarrier xbar = xcd_barrier_post(barw, (volatile LAS unsigned*)(lds + LDS_XB));
#endif
#if defined(MK_OWN_BARRIER)
    grid.sync();
#endif
#ifndef MK_DUP
#define MK_DUP 0
#endif
#define REPS(bit) for (int rep_ = 0; rep_ < ((MK_DUP & (bit)) ? 2 : 1); ++rep_)
#ifndef MK_MASK
#define MK_MASK 0xffff
#endif
#define PHASE_BEGIN() (ph >= ph_lo && ph < ph_hi)
#if defined(MK_OWN_BARRIER)
#define PHASE_END() do { ++ph; if (ph > ph_lo && ph < ph_hi) { ++nbar; grid_barrier(barw, nbar * gridDim.x); } } while (0)
#else
#define PHASE_END() do { ++ph; if (ph > ph_lo && ph < ph_hi) xcd_barrier(xbar); } while (0)
#endif
    if (ph_hi < 0) grid.sync();
    if ((MK_MASK & 1) && PHASE_BEGIN()) REPS(1) phase_prep(P, lds);
    PHASE_END();
    for (int pass = 0; pass < NPASS; ++pass) {
        if ((MK_MASK & 2) && PHASE_BEGIN()) REPS(2) phase_norm<0>(P, pass);
        PHASE_END();
        if ((MK_MASK & 4) && PHASE_BEGIN()) REPS(4) {
            pg8::Gemm g{(const bf16_t*)(ws + OFF_U), (const bf16_t*)(ws + OFF_WIN), MP, NPAD, D}; pg8::StaticOrder S; S.init(MP, NPAD, gridDim.x, blockIdx.x);
            EpiIn E{ws, P.dt_bias};
            pg8::gemm_phase<EpiIn, pg8::StaticOrder>(lds, g, S, E, nullptr);
        }
        PHASE_END();
        if ((MK_MASK & 8) && PHASE_BEGIN()) REPS(8) phase_conv(P);
        PHASE_END();
        if ((MK_MASK & 16) && PHASE_BEGIN()) REPS(16) phase_scan(P, lds, pass);
        PHASE_END();
        if ((MK_MASK & 32) && PHASE_BEGIN()) REPS(32) phase_readout(P);
        PHASE_END();
        if ((MK_MASK & 64) && PHASE_BEGIN()) REPS(64) {
            pg8::Gemm g{(const bf16_t*)(ws + OFF_A2), (const bf16_t*)(ws + OFF_WOUT), ML, D, 2048}; pg8::StaticOrder S; S.init(ML, D, gridDim.x, blockIdx.x);
            EpiOut E{P.x, mod, (float*)(ws + (pass == 0 ? OFF_H1A : OFF_H1B)), pass};
            pg8::gemm_phase<EpiOut, pg8::StaticOrder>(lds, g, S, E, nullptr);
        }
        if (pass + 1 < NPASS) ++ph; else PHASE_END();
    }
    if ((MK_MASK & 128) && PHASE_BEGIN()) REPS(128) phase_norm<1>(P, 0);
    PHASE_END();
    if ((MK_MASK & 256) && PHASE_BEGIN()) REPS(256) {
        pg8::Gemm g{(const bf16_t*)(ws + OFF_U2), (const bf16_t*)(ws + OFF_WGU), 2 * ML, 2 * DFF, D}; pg8::StaticOrder S; S.init(2 * ML, 2 * DFF, gridDim.x, blockIdx.x);
        EpiGU E{(bf16_t*)(ws + OFF_ACT)};
        pg8::gemm_phase<EpiGU, pg8::StaticOrder>(lds, g, S, E, nullptr);
    }
    PHASE_END();
    if ((MK_MASK & 512) && PHASE_BEGIN()) REPS(512) {
        pg8::Gemm g{(const bf16_t*)(ws + OFF_ACT), (const bf16_t*)(ws + OFF_WD), 2 * ML, D, DFF}; pg8::StaticOrder S; S.init(2 * ML, D, gridDim.x, blockIdx.x);
        EpiDown E{(const float*)(ws + OFF_H1A), (const float*)(ws + OFF_H1B), mod, P.out};
        pg8::gemm_phase<EpiDown, pg8::StaticOrder>(lds, g, S, E, nullptr);
    }
    PHASE_END();
    if ((MK_MASK & 1024) && PHASE_BEGIN()) phase_final_norm(P, 0);
}
}

extern "C" void kernel_launch(void* const* d_in, const int* in_sizes, int n_in, void* d_out, int out_size, void* d_ws, size_t ws_size, hipStream_t stream) {
    static int grid_blocks = 0;
    if (grid_blocks == 0) {
        if (n_in != 22 || ws_size < mk::WS_END) { fprintf(stderr, "kernel_launch: unexpected n_in %d or ws_size %zu (< %zu)\n", n_in, ws_size, (size_t)mk::WS_END); }
        int dev = 0, cus = 0, per_cu = 0;
        hipGetDevice(&dev);
        hipDeviceGetAttribute(&cus, hipDeviceAttributeMultiprocessorCount, dev);
        if (hipFuncSetAttribute((const void*)mk::fwd_megakernel, hipFuncAttributeMaxDynamicSharedMemorySize, mk::LDS_BYTES) != hipSuccess) fprintf(stderr, "kernel_launch: hipFuncSetAttribute failed\n");
        hipOccupancyMaxActiveBlocksPerMultiprocessor(&per_cu, (const void*)mk::fwd_megakernel, mk::NT, mk::LDS_BYTES);
        if (per_cu < 1) { fprintf(stderr, "kernel_launch: occupancy query returned %d\n", per_cu); per_cu = 1; }
        grid_blocks = cus * 1;
        (void)hipGetLastError();
    }
#ifdef MK_ZERO_WS
    (void)hipMemsetAsync((char*)d_ws + mk::OFF_Q, 0, mk::WS_END - mk::OFF_Q, stream);
#endif
    (void)hipMemsetAsync((char*)d_ws + mk::OFF_BAR, 0, mk::BAR_BYTES, stream);
    mk::Params p{};
    const float** pp = (const float**)&p;
    for (int i = 0; i < 22; ++i) pp[i] = (const float*)d_in[i];
    p.out = (float*)d_out; p.ws = (unsigned char*)d_ws;
    int ph_lo = 0, ph_hi = 1000;
    void* args[] = {&p, &ph_lo, &ph_hi};
    hipError_t e = hipLaunchCooperativeKernel((const void*)mk::fwd_megakernel, dim3(grid_blocks), dim3(mk::NT), args, mk::LDS_BYTES, stream);
    if (e != hipSuccess) fprintf(stderr, "cooperative launch failed: %s (grid %d)\n", hipGetErrorString(e), grid_blocks);
}
```
